# Optimizing an MI355X kernel written in HIP

```python
import math
import jax, jax.numpy as jnp
from jax import lax
import numpy as np

D_MODEL = 4096
BATCH = 2
SEQ = 8192
DEPTH = 2

HEAD_DIM = 128
MIX_WIDTH = D_MODEL
N_HEADS_A = MIX_WIDTH // HEAD_DIM // 2
N_HEADS_B = MIX_WIDTH // HEAD_DIM - N_HEADS_A
DILATED_PATTERNS = ((128, 1), (512, 4), (2048, 16))
BLK = 128
N_BUCKETS = 32
MAX_DISTANCE = 2048
N_HEADS_C = MIX_WIDTH // HEAD_DIM
Q_LORA = 1024
KV_LORA = 512
QK_NOPE = 128
QK_ROPE = 64
V_DIM = 128
ROPE_THETA = 10000.0
EPS = 1e-6
NEG_INF = -1e30
N_EVEN = (DEPTH + 1) // 2
N_ODD = DEPTH // 2
IN_EVEN = 3 * N_HEADS_A * HEAD_DIM + 3 * N_HEADS_B * HEAD_DIM + MIX_WIDTH + N_HEADS_B
IN_ODD = Q_LORA + KV_LORA + QK_ROPE + MIX_WIDTH

kernel_name = 'hybrid_dilated_fox_mla_adaln'


def rmsnorm(x, g):
    xf = x.astype(jnp.float32)
    y = xf * lax.rsqrt(jnp.mean(xf * xf, axis=-1, keepdims=True) + EPS)
    return (y * g.astype(jnp.float32)).astype(x.dtype)


def t5_bucket(n):
    max_exact = N_BUCKETS // 2
    nf = jnp.maximum(n, 1).astype(jnp.float32)
    large = max_exact + (jnp.log(nf / max_exact) / math.log(MAX_DISTANCE / max_exact)
                         * (N_BUCKETS - max_exact)).astype(jnp.int32)
    large = jnp.minimum(large, N_BUCKETS - 1)
    return jnp.where(n < max_exact, n, large)


def rope(x, positions):
    half = x.shape[-1] // 2
    inv_freq = ROPE_THETA ** (-jnp.arange(half, dtype=jnp.float32) / half)
    ang = positions.astype(jnp.float32)[..., None] * inv_freq
    cos = jnp.cos(ang)[:, :, None, :]
    sin = jnp.sin(ang)[:, :, None, :]
    x1 = x[..., :half].astype(jnp.float32)
    x2 = x[..., half:].astype(jnp.float32)
    return jnp.concatenate([x1 * cos - x2 * sin, x1 * sin + x2 * cos], axis=-1).astype(x.dtype)


def dilated_window_attention(q, k, v, rel_bias, window, dilation):
    B, S, H, Dh = q.shape
    steps = window // dilation
    span = dilation * BLK
    s_pad = -(-S // span) * span
    L = s_pad // dilation
    nb = L // BLK

    def by_residue(t):
        t = jnp.pad(t, ((0, 0), (0, s_pad - S), (0, 0), (0, 0)))
        t = t.reshape(B, L, dilation, H, Dh).transpose(0, 3, 2, 1, 4)
        return t.reshape(B, H, dilation, nb, BLK, Dh)

    def with_prev(t):
        prev = jnp.pad(t, ((0, 0), (0, 0), (0, 0), (1, 0), (0, 0), (0, 0)))[:, :, :, :-1]
        return jnp.concatenate([prev, t], axis=4)

    qr = by_residue(q)
    kb = with_prev(by_residue(k))
    vb = with_prev(by_residue(v))
    s = jnp.einsum('bhrnqd,bhrnkd->bhrnqk', qr, kb).astype(jnp.float32) * (HEAD_DIM ** -0.5)
    i = jnp.arange(BLK)[:, None]
    j = jnp.arange(2 * BLK)[None, :]
    step_dist = i + BLK - j
    band = (step_dist >= 0) & (step_dist <= steps)
    valid = band[None] & ((jnp.arange(nb)[:, None, None] > 0) | (j[None] >= BLK))
    bucket = t5_bucket(jnp.maximum(step_dist, 0) * dilation)
    bias = jnp.moveaxis(rel_bias[bucket].astype(jnp.float32), -1, 0)
    s = s + bias[None, :, None, None]
    s = jnp.where(valid[None, None, None], s, NEG_INF)
    m = jnp.max(s, axis=-1, keepdims=True)
    p = jnp.exp(s - m)
    denom = jnp.sum(p, axis=-1, keepdims=True)
    o = jnp.einsum('bhrnqk,bhrnkd->bhrnqd', (p / denom).astype(v.dtype), vb)
    lse = m[..., 0] + jnp.log(denom[..., 0])
    o = o.reshape(B, H, dilation, L, Dh).transpose(0, 3, 2, 1, 4).reshape(B, s_pad, H, Dh)[:, :S]
    lse = lse.reshape(B, H, dilation, L).transpose(0, 3, 2, 1).reshape(B, s_pad, H)[:, :S]
    return o, lse


def causal_block_attention(q, k, v, scale, log_forget_cum=None):
    B, S, H, Dk = q.shape
    nb = S // BLK
    q_blocks = q.reshape(B, nb, BLK, H, Dk).swapaxes(0, 1)
    k_pos = jnp.arange(S)
    if log_forget_cum is not None:
        F = log_forget_cum.transpose(0, 2, 1)
        F_blocks = F.reshape(B, H, nb, BLK).transpose(2, 0, 1, 3)
        xs = (jnp.arange(nb), q_blocks, F_blocks)
    else:
        xs = (jnp.arange(nb), q_blocks)

    def block(xs_n):
        n, q_blk = xs_n[0], xs_n[1]
        s = jnp.einsum('bqhd,bkhd->bhqk', q_blk, k).astype(jnp.float32) * scale
        if log_forget_cum is not None:
            s = s + (xs_n[2][..., :, None] - F[:, :, None, :])
        q_pos = n * BLK + jnp.arange(BLK)
        s = jnp.where(k_pos[None, :] <= q_pos[:, None], s, NEG_INF)
        p = jax.nn.softmax(s, axis=-1).astype(v.dtype)
        return jnp.einsum('bhqk,bkhd->bqhd', p, v)

    out = lax.map(block, xs)
    return out.swapaxes(0, 1).reshape(B, S, H, v.shape[-1])


def even_mixer(h, rel_bias, w_in, b_f, w_out):
    B, S, _ = h.shape
    wa = N_HEADS_A * HEAD_DIM
    wb = N_HEADS_B * HEAD_DIM
    proj = h @ w_in
    qa, ka, va, qb, kb, vb, z, f_logit = jnp.split(
        proj, list(np.cumsum([wa, wa, wa, wb, wb, wb, MIX_WIDTH])), axis=-1)
    ha = lambda t: t.reshape(B, S, N_HEADS_A, HEAD_DIM)
    hb = lambda t: t.reshape(B, S, N_HEADS_B, HEAD_DIM)
    outs, lses = [], []
    for window, dilation in DILATED_PATTERNS:
        o, l = dilated_window_attention(ha(qa), ha(ka), ha(va), rel_bias, window, dilation)
        outs.append(o)
        lses.append(l)
    mix_w = jax.nn.softmax(jnp.stack(lses, axis=0), axis=0)
    o_a = jnp.einsum('pbsh,pbshd->bshd', mix_w.astype(h.dtype), jnp.stack(outs, axis=0))
    log_f = jax.nn.log_sigmoid(f_logit.astype(jnp.float32) + b_f.astype(jnp.float32))
    F = jnp.cumsum(log_f, axis=1)
    o_b = causal_block_attention(hb(qb), hb(kb), hb(vb), HEAD_DIM ** -0.5, F)
    o = jnp.concatenate([o_a.reshape(B, S, wa), o_b.reshape(B, S, wb)], axis=-1)
    return (o * jax.nn.silu(z)) @ w_out


def odd_mixer(h, positions, w_in, g_q, g_kv, w_qb, w_kvb, w_out):
    B, S, _ = h.shape
    proj = h @ w_in
    cq, ckv, k_r, z = jnp.split(proj, list(np.cumsum([Q_LORA, KV_LORA, QK_ROPE])), axis=-1)
    q = (rmsnorm(cq, g_q) @ w_qb).reshape(B, S, N_HEADS_C, QK_NOPE + QK_ROPE)
    kv = (rmsnorm(ckv, g_kv) @ w_kvb).reshape(B, S, N_HEADS_C, QK_NOPE + V_DIM)
    q_nope, q_rope = q[..., :QK_NOPE], rope(q[..., QK_NOPE:], positions)
    k_nope, v = kv[..., :QK_NOPE], kv[..., QK_NOPE:]
    k_rope = rope(k_r[:, :, None, :], positions)
    q = jnp.concatenate([q_nope, q_rope], axis=-1)
    k = jnp.concatenate([k_nope, jnp.broadcast_to(k_rope, (B, S, N_HEADS_C, QK_ROPE))], axis=-1)
    o = causal_block_attention(q, k, v, (QK_NOPE + QK_ROPE) ** -0.5)
    return (o.reshape(B, S, N_HEADS_C * V_DIM) * jax.nn.silu(z)) @ w_out


def setup_inputs(seed: int = 0) -> dict:
    key = jax.random.key(seed)
    ks = jax.random.split(key, 18)
    nrm = lambda k, shape, s: jax.random.normal(k, shape, jnp.float32) * s
    x = nrm(ks[0], (BATCH, SEQ, D_MODEL), 1.0)
    c = nrm(ks[1], (BATCH, D_MODEL), 1.0)
    positions = (jax.random.randint(ks[2], (BATCH, 1), 0, 4096, dtype=jnp.int32)
                 + jnp.arange(SEQ, dtype=jnp.int32)[None, :])
    g_norm = 1.0 + nrm(ks[3], (DEPTH, D_MODEL), 0.02)
    w_ada = nrm(ks[4], (DEPTH, D_MODEL, 3 * D_MODEL), 0.1 * D_MODEL ** -0.5)
    b_ada = nrm(ks[5], (DEPTH, 3 * D_MODEL), 0.02) + jnp.concatenate(
        [jnp.zeros((2 * D_MODEL,), jnp.float32), jnp.ones((D_MODEL,), jnp.float32)])[None]
    rel_bias = nrm(ks[6], (N_BUCKETS, N_HEADS_A), 0.5)
    w_in_even = nrm(ks[7], (N_EVEN, D_MODEL, IN_EVEN), D_MODEL ** -0.5)
    b_forget = jnp.linspace(1.0, 5.0, N_HEADS_B, dtype=jnp.float32)[None] + nrm(ks[8], (N_EVEN, N_HEADS_B), 0.1)
    w_out_even = nrm(ks[9], (N_EVEN, MIX_WIDTH, D_MODEL), MIX_WIDTH ** -0.5)
    w_in_odd = nrm(ks[10], (N_ODD, D_MODEL, IN_ODD), D_MODEL ** -0.5)
    g_q_lora = 1.0 + nrm(ks[11], (N_ODD, Q_LORA), 0.02)
    g_kv_lora = 1.0 + nrm(ks[12], (N_ODD, KV_LORA), 0.02)
    w_q_b = nrm(ks[13], (N_ODD, Q_LORA, N_HEADS_C * (QK_NOPE + QK_ROPE)), Q_LORA ** -0.5)
    w_kv_b = nrm(ks[14], (N_ODD, KV_LORA, N_HEADS_C * (QK_NOPE + V_DIM)), KV_LORA ** -0.5)
    w_out_odd = nrm(ks[15], (N_ODD, MIX_WIDTH, D_MODEL), MIX_WIDTH ** -0.5)
    g_final = 1.0 + nrm(ks[16], (D_MODEL,), 0.02)
    return {'x': x, 'c': c, 'positions': positions, 'g_norm': g_norm, 'w_ada': w_ada,
            'b_ada': b_ada, 'rel_bias': rel_bias, 'w_in_even': w_in_even, 'b_forget': b_forget,
            'w_out_even': w_out_even, 'w_in_odd': w_in_odd, 'g_q_lora': g_q_lora,
            'g_kv_lora': g_kv_lora, 'w_q_b': w_q_b, 'w_kv_b': w_kv_b, 'w_out_odd': w_out_odd,
            'g_final': g_final}


def reference(x, c, positions, g_norm, w_ada, b_ada, rel_bias, w_in_even, b_forget, w_out_even,
              w_in_odd, g_q_lora, g_kv_lora, w_q_b, w_kv_b, w_out_odd, g_final):
    for layer in range(DEPTH):
        mod = jax.nn.silu(c) @ w_ada[layer] + b_ada[layer]
        shift, scale, gate = jnp.split(mod, 3, axis=-1)
        h = rmsnorm(x, g_norm[layer]) * (1.0 + scale[:, None, :]) + shift[:, None, :]
        i = layer // 2
        if layer % 2 == 0:
            y = even_mixer(h, rel_bias, w_in_even[i], b_forget[i], w_out_even[i])
        else:
            y = odd_mixer(h, positions, w_in_odd[i], g_q_lora[i], g_kv_lora[i],
                          w_q_b[i], w_kv_b[i], w_out_odd[i])
        x = x + gate[:, None, :] * y
    return rmsnorm(x, g_final)
```

```cpp
#include <hip/hip_runtime.h>
#include <cstdio>
#include <cstdint>
#include <cmath>
namespace pg8 {
#define PG8_LAS __attribute__((address_space(3)))
typedef unsigned short bf16_t;
typedef short bf16x8 __attribute__((ext_vector_type(8)));
typedef float f32x4 __attribute__((ext_vector_type(4)));
typedef unsigned u32x4 __attribute__((ext_vector_type(4)));
constexpr int BM = 256, BK = 64, HALF = 128, HTB = HALF * BK * 2  , STAGE_BYTES = 8 * HTB, NXCD = 8, WGM = 8;

__host__ __device__ __forceinline__ int lds_byte(int r, int c) { const int st = (r >> 4) * 2 + (c >> 5), rr = r & 15, cc = c & 31, ob = rr * 64 + cc * 2; return st * 1024 + (ob ^ (((ob >> 9) & 1) << 5)); }
__host__ __device__ __forceinline__ void stage_rc(int b, int& R, int& C) { const int st = b / 1024, sb = b % 1024, swz = sb ^ (((sb >> 9) & 1) << 5); R = (st >> 1) * 16 + swz / 64; C = (st & 1) * 32 + (swz % 64) / 2; }
__host__ __device__ __forceinline__ int perm32(int rho) { const int n = rho >> 4, i = rho & 15; return 8 * (i >> 2) + 4 * n + (i & 3); }

struct Unit { int pm, pn; };
struct Gemm { const bf16_t* A; const bf16_t* Bt; int M, N, K; };

struct StaticOrder {
    int nM, nN, nwg, G, c;
    __host__ __device__ void init(int M, int N, int G_, int c_) { nM = M / BM; nN = N / BM; nwg = nM * nN; G = G_; c = c_; }
    __host__ __device__ bool next(int i, Unit& u) const {
        const long L = (long)i * G + c; if (L >= nwg) return false;
        int wgid = (int)L; { const int q = nwg / NXCD, r = nwg % NXCD, xcd = wgid % NXCD, off = wgid / NXCD; wgid = (xcd < r ? xcd * (q + 1) : r * (q + 1) + (xcd - r) * q) + off; }
        const int nig = WGM * nN, gid = wgid / nig, fm = gid * WGM, gsz = (nM - fm) < WGM ? (nM - fm) : WGM;
        u.pm = fm + ((wgid % nig) % gsz); u.pn = (wgid % nig) / gsz; return true;
    }
    __device__ __forceinline__ void a_ready(const Unit&) const {}
    __device__ __forceinline__ void done(const Unit&) const {}
};

__device__ __forceinline__ unsigned cvt_pk_bf16(float lo, float hi) { unsigned r; asm volatile("v_cvt_pk_bf16_f32 %0, %1, %2" : "=v"(r) : "v"(lo), "v"(hi)); return r; }
typedef float f32x2 __attribute__((ext_vector_type(2)));
__device__ __forceinline__ f32x2 gelu_pk(f32x2 v) {
    const f32x2 av = __builtin_elementwise_abs(v), d = av * 0.2316418882f + 1.0f;
    f32x2 t; t.x = __builtin_amdgcn_rcpf(d.x); t.y = __builtin_amdgcn_rcpf(d.y);
    f32x2 q = t * 0.5307027145f + (-0.7265760135f); q = q * t + 0.7107068705f; q = q * t + (-0.142248368f); q = q * t + 0.127414796f; q = q * t;
    const f32x2 s = (v * v) * (-0.72134752044f);
    f32x2 e; e.x = __builtin_amdgcn_exp2f(s.x); e.y = __builtin_amdgcn_exp2f(s.y);
    const f32x2 m = v * (q * e), r = v - m;
    f32x2 o; o.x = v.x < 0.f ? m.x : r.x; o.y = v.y < 0.f ? m.y : r.y; return o;
}

template <int ACT  > struct EpiBf16 {
    static constexpr bool PERM = true, AFTER_DRAIN = false; static_assert(ACT == 0 || ACT == 1, "EpiBf16: ACT is 0 (none) or 1 (gelu_pk)");
    bf16_t* O; int ldc; const float* bias; int split_cols; size_t split_stride; float scale0;
    __device__ __forceinline__ void operator()(const f32x4 (&acc)[2][2][4][2], const Unit& u, int wr, int wc, int fr, int fq) const {
        const int row0 = u.pm * BM + wr * 64 + fr; int colt = u.pn * BM; bf16_t* base = O;
        float sc = 1.f; if (split_cols) { const int t = colt / split_cols; base += (size_t)t * split_stride; colt -= t * split_cols; if (t == 0) sc = scale0; }
        const int col0 = colt + wc * 32 + 8 * fq, bcol0 = u.pn * BM + wc * 32 + 8 * fq;
        f32x4 bv[2][2];
#pragma unroll
        for (int bj = 0; bj < 2; ++bj)
#pragma unroll
            for (int n = 0; n < 2; ++n) bv[bj][n] = bias ? *(const f32x4*)(bias + bcol0 + bj * HALF + 4 * n) : (f32x4){0.f, 0.f, 0.f, 0.f};
#pragma unroll
        for (int ai = 0; ai < 2; ++ai)
#pragma unroll
            for (int m = 0; m < 4; ++m) { bf16_t* rowp = base + (size_t)(row0 + ai * HALF + m * 16) * ldc + col0;
#pragma unroll
                for (int bj = 0; bj < 2; ++bj) { f32x4 v0 = acc[ai][bj][m][0] + bv[bj][0], v1 = acc[ai][bj][m][1] + bv[bj][1];
                    if (ACT == 1) { f32x2 a = gelu_pk((f32x2){v0[0], v0[1]}), b = gelu_pk((f32x2){v0[2], v0[3]}), c = gelu_pk((f32x2){v1[0], v1[1]}), d = gelu_pk((f32x2){v1[2], v1[3]});
                        v0 = (f32x4){a.x, a.y, b.x, b.y}; v1 = (f32x4){c.x, c.y, d.x, d.y}; }
                    v0 = v0 * sc; v1 = v1 * sc; u32x4 w; w.x = cvt_pk_bf16(v0[0], v0[1]); w.y = cvt_pk_bf16(v0[2], v0[3]); w.z = cvt_pk_bf16(v1[0], v1[1]); w.w = cvt_pk_bf16(v1[2], v1[3]);
                    *(u32x4*)(rowp + bj * HALF) = w; } }
    }
};
struct EpiQRope {
    static constexpr bool PERM = true, AFTER_DRAIN = false;
    bf16_t* O; int ldc; const float* cs; int rope_col0;
    __device__ __forceinline__ void operator()(const f32x4 (&acc)[2][2][4][2], const Unit& u, int wr, int wc, int fr, int fq) const {
        const int row0 = u.pm * BM + wr * 64 + fr; const int colt = u.pn * BM;
        const int col0 = colt + wc * 32 + 8 * fq;
        const bool rope = colt >= rope_col0;
        const int j0 = ((wc & 1) * 32 + 8 * fq) >> 1;
#pragma unroll
        for (int ai = 0; ai < 2; ++ai)
#pragma unroll
            for (int m = 0; m < 4; ++m) { const int row = row0 + ai * HALF + m * 16; bf16_t* rowp = O + (size_t)row * ldc + col0;
                f32x4 c = (f32x4){1.f, 1.f, 1.f, 1.f}, s = (f32x4){0.f, 0.f, 0.f, 0.f};
                if (rope) { c = *(const f32x4*)(cs + (size_t)row * 64 + j0); s = *(const f32x4*)(cs + (size_t)row * 64 + 32 + j0); }
#pragma unroll
                for (int bj = 0; bj < 2; ++bj) { const f32x4 v0 = acc[ai][bj][m][0], v1 = acc[ai][bj][m][1];
                    u32x4 w;
                    w.x = cvt_pk_bf16(v0[0] * c[0] - v0[1] * s[0], v0[0] * s[0] + v0[1] * c[0]);
                    w.y = cvt_pk_bf16(v0[2] * c[1] - v0[3] * s[1], v0[2] * s[1] + v0[3] * c[1]);
                    w.z = cvt_pk_bf16(v1[0] * c[2] - v1[1] * s[2], v1[0] * s[2] + v1[1] * c[2]);
                    w.w = cvt_pk_bf16(v1[2] * c[3] - v1[3] * s[3], v1[2] * s[3] + v1[3] * c[3]);
                    *(u32x4*)(rowp + bj * HALF) = w; } }
    }
};
struct EpiResGate {
    static constexpr bool PERM = false, AFTER_DRAIN = false;
    const float* base; float* out; int ldc; const float* gate; int gate_stride; int rows_per_batch;
    __device__ __forceinline__ void operator()(const f32x4 (&acc)[2][2][4][2], const Unit& u, int wr, int wc, int fr, int fq) const {
        const int col0 = u.pn * BM + wc * 32 + 4 * fq; const int b = (u.pm * BM) / rows_per_batch;
        f32x4 gv[2][2];
#pragma unroll
        for (int bj = 0; bj < 2; ++bj)
#pragma unroll
            for (int n = 0; n < 2; ++n) gv[bj][n] = *(const f32x4*)(gate + (size_t)b * gate_stride + col0 + bj * HALF + n * 16);
#pragma unroll
        for (int ai = 0; ai < 2; ++ai)
#pragma unroll
            for (int m = 0; m < 4; ++m) { const size_t off = (size_t)(u.pm * BM + ai * HALF + wr * 64 + m * 16 + fr) * ldc + col0;
#pragma unroll
                for (int bj = 0; bj < 2; ++bj)
#pragma unroll
                    for (int n = 0; n < 2; ++n) { const f32x4 bs = *(const f32x4*)(base + off + bj * HALF + n * 16);
                        *(f32x4*)(out + off + bj * HALF + n * 16) = bs + gv[bj][n] * acc[ai][bj][m][n]; }
                if (m & 1) asm volatile("" ::: "memory"); }
    }
};

template <class Epi, class Sched, bool ALIGN_EPI = false, bool SP2 = false>
__device__ __forceinline__ void gemm_phase(PG8_LAS unsigned char* lds, const Gemm g, const Sched& S, const Epi& E) {
    const int tid = threadIdx.x, wid = __builtin_amdgcn_readfirstlane(tid >> 6), lane = tid & 63, wr = wid >> 2, wc = wid & 3, fr = lane & 15, fq = lane >> 4;
    const int K = g.K, nt = K / BK;
    unsigned voffA[2], voffB[2];
#pragma unroll
    for (int i = 0; i < 2; ++i) { int R, C; stage_rc(tid * 16 + i * 8192, R, C); const int Rb = Epi::PERM ? ((R & ~31) + perm32(R & 31)) : R;
        voffA[i] = (unsigned)(R * K + C) * 2u; voffB[i] = (unsigned)(Rb * K + C) * 2u; }
    const size_t kstep = (size_t)(BK * 2);
    const size_t hstep = (size_t)HALF * K * 2;
    const size_t tstep = 2 * hstep;
    const unsigned ldsw = (unsigned)wid * 1024u;
    const int aoff = lds_byte(wr * 64 + fr, fq * 8), boff = lds_byte(wc * 32 + fr, fq * 8);
#define PG8_SA(b, h) (((b) * 2 + (h)) * HTB)
#define PG8_SB(b, h) ((4 + (b) * 2 + (h)) * HTB)
#define PG8_STAGE(bufoff, gbase, voff) do { _Pragma("unroll") for (int _i = 0; _i < 2; ++_i) \
        __builtin_amdgcn_global_load_lds((const unsigned*)((const char*)(gbase) + (voff)[_i]), (PG8_LAS unsigned*)(lds + (bufoff) + ldsw + _i * 8192), 16, 0, 0); } while (0)
#define PG8_LDA(dst, b, h) do { _Pragma("unroll") for (int m = 0; m < 4; ++m) _Pragma("unroll") for (int k = 0; k < 2; ++k) dst[m][k] = *(const PG8_LAS bf16x8*)(lds + PG8_SA(b, h) + aoff + m * 2048 + k * 1024); } while (0)
#define PG8_LDB(dst, b, h) do { _Pragma("unroll") for (int n = 0; n < 2; ++n) _Pragma("unroll") for (int k = 0; k < 2; ++k) dst[n][k] = *(const PG8_LAS bf16x8*)(lds + PG8_SB(b, h) + boff + n * 2048 + k * 1024); } while (0)
#define PG8_MMA(ai, bj, At, Bt) do { __builtin_amdgcn_s_setprio(1); _Pragma("unroll") for (int m = 0; m < 4; ++m) _Pragma("unroll") for (int n = 0; n < 2; ++n) _Pragma("unroll") for (int k = 0; k < 2; ++k) \
        acc[ai][bj][m][n] = __builtin_amdgcn_mfma_f32_16x16x32_bf16(Bt[n][k], At[m][k], acc[ai][bj][m][n], 0, 0, 0); __builtin_amdgcn_s_setprio(0); } while (0)
#define PG8_WAIT_V(n) asm volatile("s_waitcnt vmcnt(" #n ")" ::: "memory")
#define PG8_WAIT_L(n) asm volatile("s_waitcnt lgkmcnt(" #n ")" ::: "memory")
#define PG8_BAR __builtin_amdgcn_s_barrier()
#define PG8_SCHED __builtin_amdgcn_sched_barrier(0)
    Unit cur, nxt; int ui = 0;
    if (!S.next(0, cur)) return;
    f32x4 acc[2][2][4][2];
#pragma unroll
    for (int a = 0; a < 2; ++a)
#pragma unroll
        for (int b = 0; b < 2; ++b)
#pragma unroll
            for (int m = 0; m < 4; ++m)
#pragma unroll
                for (int n = 0; n < 2; ++n) acc[a][b][m][n] = (f32x4){0.f, 0.f, 0.f, 0.f};
    bf16x8 At[4][2], B0[2][2], B1[2][2];
    const char* cA = (const char*)g.A + (size_t)cur.pm * tstep; const char* cB = (const char*)g.Bt + (size_t)cur.pn * tstep;
    S.a_ready(cur);
    if constexpr (SP2) {
        PG8_STAGE(PG8_SB(0, 0), cB, voffB); PG8_STAGE(PG8_SB(0, 1), cB + hstep, voffB); PG8_STAGE(PG8_SA(0, 0), cA, voffA); PG8_STAGE(PG8_SA(0, 1), cA + hstep, voffA);
        if (wr == 1) PG8_BAR;
        PG8_WAIT_V(2); PG8_BAR;
        PG8_STAGE(PG8_SB(1, 0), cB + kstep, voffB); PG8_STAGE(PG8_SA(1, 0), cA + kstep, voffA); PG8_STAGE(PG8_SB(1, 1), cB + hstep + kstep, voffB);
        PG8_WAIT_V(6); PG8_BAR;
    } else {
        PG8_STAGE(PG8_SB(0, 0), cB, voffB); PG8_STAGE(PG8_SA(0, 0), cA, voffA); PG8_STAGE(PG8_SB(0, 1), cB + hstep, voffB); PG8_STAGE(PG8_SA(0, 1), cA + hstep, voffA);
        if (wr == 1) PG8_BAR;
        PG8_WAIT_V(4); PG8_BAR;
        PG8_STAGE(PG8_SB(1, 0), cB + kstep, voffB); PG8_STAGE(PG8_SA(1, 0), cA + kstep, voffA); PG8_STAGE(PG8_SB(1, 1), cB + hstep + kstep, voffB);
        PG8_WAIT_V(6); PG8_BAR;
    }
    for (;;) {
        const bool has_next = S.next(ui + 1, nxt);
        const char* nA = has_next ? (const char*)g.A + (size_t)nxt.pm * tstep : cA; const char* nB = has_next ? (const char*)g.Bt + (size_t)nxt.pn * tstep : cB;
        for (int t = 0; t < nt; t += 2) {
            const bool last = (t == nt - 2);
            const char* a1 = cA + (size_t)(t + 1) * kstep;
            const char* a2 = last ? nA : cA + (size_t)(t + 2) * kstep; const char* b2 = last ? nB : cB + (size_t)(t + 2) * kstep;
            const char* a3 = a2 + kstep; const char* b3 = b2 + kstep;
            if (last && has_next) S.a_ready(nxt);
            if constexpr (SP2) {
            PG8_LDB(B0, 0, 0); PG8_LDB(B1, 0, 1); PG8_SCHED; PG8_LDA(At, 0, 0); PG8_STAGE(PG8_SA(1, 1), a1 + hstep, voffA);
            PG8_WAIT_V(8); PG8_WAIT_L(0); PG8_BAR; PG8_MMA(0, 0, At, B0); PG8_MMA(0, 1, At, B1); PG8_BAR; PG8_SCHED;
            PG8_LDA(At, 0, 1); PG8_STAGE(PG8_SB(0, 0), b2, voffB); PG8_STAGE(PG8_SB(0, 1), b2 + hstep, voffB); PG8_STAGE(PG8_SA(0, 0), a2, voffA);
            PG8_WAIT_V(8); PG8_WAIT_L(0); PG8_BAR; PG8_MMA(1, 0, At, B0); PG8_MMA(1, 1, At, B1); PG8_BAR; PG8_SCHED;
            PG8_LDB(B0, 1, 0); PG8_LDB(B1, 1, 1); PG8_SCHED; PG8_LDA(At, 1, 0); PG8_STAGE(PG8_SA(0, 1), a2 + hstep, voffA);
            PG8_WAIT_V(8); PG8_WAIT_L(0); PG8_BAR; PG8_MMA(0, 0, At, B0); PG8_MMA(0, 1, At, B1); PG8_BAR; PG8_SCHED;
            PG8_LDA(At, 1, 1); PG8_STAGE(PG8_SB(1, 0), b3, voffB); PG8_STAGE(PG8_SB(1, 1), b3 + hstep, voffB); PG8_STAGE(PG8_SA(1, 0), a3, voffA);
            PG8_WAIT_V(8); PG8_WAIT_L(0); PG8_BAR; PG8_MMA(1, 0, At, B0); PG8_MMA(1, 1, At, B1); PG8_BAR; PG8_SCHED;
            } else {
            PG8_LDB(B0, 0, 0); PG8_SCHED; PG8_LDA(At, 0, 0); PG8_STAGE(PG8_SA(1, 1), a1 + hstep, voffA);
            PG8_WAIT_L(8); PG8_BAR; PG8_WAIT_L(0); PG8_MMA(0, 0, At, B0); PG8_BAR; PG8_SCHED;
            PG8_LDB(B1, 0, 1); PG8_STAGE(PG8_SB(0, 0), b2, voffB);
            PG8_BAR; PG8_WAIT_L(0); PG8_MMA(0, 1, At, B1); PG8_BAR;
            PG8_LDA(At, 0, 1); PG8_STAGE(PG8_SA(0, 0), a2, voffA);
            PG8_BAR; PG8_WAIT_L(0); PG8_MMA(1, 0, At, B0); PG8_BAR; PG8_SCHED;
            PG8_STAGE(PG8_SB(0, 1), b2 + hstep, voffB);
            PG8_WAIT_V(6); PG8_BAR; PG8_MMA(1, 1, At, B1); PG8_BAR;
            PG8_LDB(B0, 1, 0); PG8_SCHED; PG8_LDA(At, 1, 0); PG8_STAGE(PG8_SA(0, 1), a2 + hstep, voffA);
            PG8_WAIT_L(8); PG8_BAR; PG8_WAIT_L(0); PG8_MMA(0, 0, At, B0); PG8_BAR; PG8_SCHED;
            PG8_LDB(B1, 1, 1); PG8_STAGE(PG8_SB(1, 0), b3, voffB);
            PG8_BAR; PG8_WAIT_L(0); PG8_MMA(0, 1, At, B1); PG8_BAR;
            PG8_LDA(At, 1, 1); PG8_STAGE(PG8_SA(1, 0), a3, voffA);
            PG8_BAR; PG8_WAIT_L(0); PG8_MMA(1, 0, At, B0); PG8_BAR; PG8_SCHED;
            PG8_STAGE(PG8_SB(1, 1), b3 + hstep, voffB);
            PG8_WAIT_V(6); PG8_BAR; PG8_MMA(1, 1, At, B1); PG8_BAR;
            }
        }
        if constexpr (ALIGN_EPI) { if (wr == 0) PG8_BAR; }
        if constexpr (!Epi::AFTER_DRAIN) { E(acc, cur, wr, wc, fr, fq); S.done(cur); }
        if (!has_next) break;
#pragma unroll
        for (int a = 0; a < 2; ++a)
#pragma unroll
            for (int b = 0; b < 2; ++b)
#pragma unroll
                for (int m = 0; m < 4; ++m)
#pragma unroll
                    for (int n = 0; n < 2; ++n) acc[a][b][m][n] = (f32x4){0.f, 0.f, 0.f, 0.f};
        cur = nxt; cA = nA; cB = nB; ++ui;
        if constexpr (ALIGN_EPI) { if (wr == 1) PG8_BAR; }
    }
    PG8_WAIT_V(0);
    if constexpr (!ALIGN_EPI) { if (wr == 0) PG8_BAR; }
    PG8_BAR;
    if constexpr (Epi::AFTER_DRAIN) { E.fused(acc, cur, wr, wc, fr, fq, lds, wid, lane); S.done(cur); }
#undef PG8_SA
#undef PG8_SB
#undef PG8_STAGE
#undef PG8_LDA
#undef PG8_LDB
#undef PG8_MMA
#undef PG8_WAIT_V
#undef PG8_WAIT_L
#undef PG8_BAR
#undef PG8_SCHED
}
}
namespace at {
typedef unsigned short bf16_t;
typedef short bf16x8 __attribute__((ext_vector_type(8)));
typedef short s16x4 __attribute__((ext_vector_type(4)));
typedef float f32x16 __attribute__((ext_vector_type(16)));
typedef float f32x4 __attribute__((ext_vector_type(4)));
typedef unsigned u32x4 __attribute__((ext_vector_type(4)));
enum { K_DIL = 0, K_FOX = 1, K_MLA = 2 };
constexpr int NW = 8, QBLK = 32, KVBLK = 64, QB = NW * QBLK, D = 128;
constexpr int SHM_V = KVBLK * D * 2, SHM_K = KVBLK * D * 2, KR_ROW = 144, SHM_KR = KVBLK * KR_ROW;
constexpr int OFF_V = 0, OFF_K = 2 * SHM_V, OFF_KR = OFF_K + 2 * SHM_K, OFF_WS = OFF_KR + 2 * SHM_KR, OFF_BIAS = OFF_WS + NW * 64 * 4, BIAS_BYTES = 32768, LDS_BYTES = OFF_BIAS + BIAS_BYTES;
constexpr int DIL_W = 129, TBL_N = 640, TBL_TOP = 383;
template <int KIND> struct Cfg;
template <> struct Cfg<K_DIL> { static constexpr float SCALE = 0.08838834764831845f; static constexpr int NQ = 8; static constexpr bool SK = true; };
template <> struct Cfg<K_FOX> { static constexpr float SCALE = 0.08838834764831845f; static constexpr int NQ = 8; static constexpr bool SK = false; };
template <> struct Cfg<K_MLA> { static constexpr float SCALE = 0.07216878364870322f; static constexpr int NQ = 12; static constexpr bool SK = false; };
constexpr float THR = 8.f;

#define KSWZ(row, colB) ((row) * 256 + ((colB) ^ (((row) & 7) << 4)))
#define SBAR() __builtin_amdgcn_sched_barrier(0)
__device__ __forceinline__ int v_st(int k, int c) { const int kk = (k & ~0xC) | ((k & 4) << 1) | ((k & 8) >> 1); return ((kk >> 3) * 4 + (c >> 5)) * 512 + ((kk & 7) * 32 + (c & 31)) * 2; }
__device__ __forceinline__ int v_rd_base(int lane) { return ((lane & 3) << 3) | (((lane >> 2) & 3) << 6) | (((lane >> 4) & 1) << 5) | (((lane >> 5) & 1) << 8); }
constexpr int v_rd_off(int d0, int ks, int half) { return d0 * 512 + ks * 4096 + half * 2048; }
__device__ __forceinline__ int crow(int r, int hi) { return (r & 3) + 8 * (r >> 2) + 4 * hi; }
__device__ __forceinline__ unsigned cvtpk(float lo, float hi) { unsigned r; asm volatile("v_cvt_pk_bf16_f32 %0, %1, %2" : "=v"(r) : "v"(lo), "v"(hi)); return r; }
__device__ __forceinline__ bf16x8 ld8(const bf16_t* p) { return *reinterpret_cast<const bf16x8*>(p); }
__device__ __forceinline__ float bf2f(unsigned short h) { return __uint_as_float(((unsigned)h) << 16); }
__device__ __forceinline__ void mask_tile(f32x16& p0, f32x16& p1, int dq, unsigned W) {
    const float NEG = -__builtin_inff();
#pragma unroll
    for (int r = 0; r < 16; ++r) {
        const int c = (r & 3) + 8 * (r >> 2);
        if ((unsigned)(dq - c) >= W) p0[r] = NEG;
        if ((unsigned)(dq - c - 32) >= W) p1[r] = NEG;
    }
}
template <int KIND>
__device__ __forceinline__ void partialSM(f32x16& p0, f32x16& p1, float& m_reg, float& mn, float& alpha) {
    constexpr float SCALE = Cfg<KIND>::SCALE;
    float pmax = p0[0]; for (int r = 1; r < 16; ++r) pmax = fmaxf(pmax, p0[r]); for (int r = 0; r < 16; ++r) pmax = fmaxf(pmax, p1[r]);
    { auto rr = __builtin_amdgcn_permlane32_swap(__float_as_uint(pmax), __float_as_uint(pmax), false, false);
      pmax = fmaxf(__uint_as_float(rr[0]), __uint_as_float(rr[1])); }
    constexpr float C2 = 1.4426950408889634f * SCALE;
    if (__builtin_expect(__all((pmax - m_reg) * SCALE <= THR), 1)) { mn = m_reg; alpha = 1.f; }
    else { mn = fmaxf(m_reg, pmax); alpha = __builtin_amdgcn_exp2f((m_reg - mn) * C2); m_reg = mn; }
    const float mnL = -mn * C2;
    for (int r = 0; r < 16; ++r) p0[r] = fmaf(p0[r], C2, mnL); for (int r = 0; r < 16; ++r) p1[r] = fmaf(p1[r], C2, mnL);
    for (int r = 0; r < 16; ++r) p0[r] = __builtin_amdgcn_exp2f(p0[r]);
}
__device__ __forceinline__ void finishSM(f32x16& p0, f32x16& p1, float alpha, float& l_reg, bf16x8& pa0, bf16x8& pa1, bf16x8& pa2, bf16x8& pa3) {
    for (int r = 0; r < 16; ++r) p1[r] = __builtin_amdgcn_exp2f(p1[r]);
    float ps = 0; for (int r = 0; r < 16; ++r) ps += p0[r]; for (int r = 0; r < 16; ++r) ps += p1[r];
    { auto rr = __builtin_amdgcn_permlane32_swap(__float_as_uint(ps), __float_as_uint(ps), false, false);
      ps = __uint_as_float(rr[0]) + __uint_as_float(rr[1]); }
    l_reg = l_reg * alpha + ps;
#define PK4(P, B_, OUT) do { unsigned a0 = cvtpk(P[B_+0], P[B_+1]), a1 = cvtpk(P[B_+2], P[B_+3]);                          \
        unsigned b0 = cvtpk(P[B_+4], P[B_+5]), b1 = cvtpk(P[B_+6], P[B_+7]);                                             \
        auto r0 = __builtin_amdgcn_permlane32_swap(a0, b0, false, false); auto r1 = __builtin_amdgcn_permlane32_swap(a1, b1, false, false); \
        u32x4 w = {r0[0], r1[0], r0[1], r1[1]}; OUT = *reinterpret_cast<bf16x8*>(&w); } while (0)
    PK4(p0, 0, pa0); PK4(p0, 8, pa1); PK4(p1, 0, pa2); PK4(p1, 8, pa3);
#undef PK4
}
template <int KIND, int KB>
__device__ __forceinline__ void qkt(f32x16& p0, f32x16& p1, const char* lds, int r32, int hi, const bf16x8* qr, bool act, int bofs) {
    constexpr bool SK = Cfg<KIND>::SK;
    if (SK && !act) { const float NEG = -__builtin_inff();
#pragma unroll
        for (int r = 0; r < 16; ++r) { p0[r] = NEG; p1[r] = NEG; } return; }
    if constexpr (KIND == K_FOX) { const float* bp = reinterpret_cast<const float*>(lds + OFF_BIAS) + bofs;
#pragma unroll
        for (int g = 0; g < 4; ++g) { const f32x4 a = *reinterpret_cast<const f32x4*>(bp + 8 * g), b = *reinterpret_cast<const f32x4*>(bp + 32 + 8 * g);
            p0[4 * g] = a[0]; p0[4 * g + 1] = a[1]; p0[4 * g + 2] = a[2]; p0[4 * g + 3] = a[3]; p1[4 * g] = b[0]; p1[4 * g + 1] = b[1]; p1[4 * g + 2] = b[2]; p1[4 * g + 3] = b[3]; } }
    else if constexpr (KIND == K_DIL) { const float* bp = reinterpret_cast<const float*>(lds + OFF_BIAS) + bofs;
#pragma unroll
        for (int r = 0; r < 16; ++r) { const int c = (r & 3) + 8 * (r >> 2); p0[r] = bp[c]; p1[r] = bp[c + 32]; } }
    else { p0 = f32x16{}; p1 = f32x16{}; }
    const char* K_lds = lds + OFF_K;
    const char* kb[4];
#pragma unroll
    for (int dd = 0; dd < 4; ++dd) kb[dd] = K_lds + KB * SHM_K + KSWZ(r32, (dd * 16 + hi * 8) * 2);
#pragma unroll
    for (int d0 = 0; d0 < 8; ++d0) { const char* a = kb[d0 & 3] + (d0 >> 2) * 128;
        bf16x8 b0 = *reinterpret_cast<const bf16x8*>(a);
        bf16x8 b1 = *reinterpret_cast<const bf16x8*>(a + 32 * 256);
        p0 = __builtin_amdgcn_mfma_f32_32x32x16_bf16(b0, qr[d0], p0, 0, 0, 0);
        p1 = __builtin_amdgcn_mfma_f32_32x32x16_bf16(b1, qr[d0], p1, 0, 0, 0); }
    if constexpr (KIND == K_MLA) {
        const char* krb = lds + OFF_KR + KB * SHM_KR + r32 * KR_ROW + hi * 16;
#pragma unroll
        for (int d0 = 0; d0 < 4; ++d0) { const char* a = krb + d0 * 32;
            bf16x8 b0 = *reinterpret_cast<const bf16x8*>(a);
            bf16x8 b1 = *reinterpret_cast<const bf16x8*>(a + 32 * KR_ROW);
            const bf16x8 qf = *reinterpret_cast<const bf16x8*>(lds + OFF_BIAS + bofs + d0 * 1024);
            p0 = __builtin_amdgcn_mfma_f32_32x32x16_bf16(b0, qf, p0, 0, 0, 0);
            p1 = __builtin_amdgcn_mfma_f32_32x32x16_bf16(b1, qf, p1, 0, 0, 0); } }
}
template <int VB, bool SK>
__device__ __forceinline__ void pv_tile(f32x16* o, int vb0, bf16x8 pa0, bf16x8 pa1, bf16x8 pa2, bf16x8 pa3, bool act) {
    if (SK && !act) return;
#define TRRD(dst, off) asm volatile("ds_read_b64_tr_b16 %0, %1 offset:%2" : "=&v"(dst) : "v"(vb0), "i"(off) : "memory")
#define PV_D0(d0) do { s16x4 l0, l1, l2, l3, h0, h1, h2, h3; constexpr int b_ = OFF_V + VB * SHM_V + v_rd_off(d0, 0, 0);   \
        TRRD(l0, b_); TRRD(h0, b_ + 2048); TRRD(l1, b_ + 4096); TRRD(h1, b_ + 6144); TRRD(l2, b_ + 8192); TRRD(h2, b_ + 10240); TRRD(l3, b_ + 12288); TRRD(h3, b_ + 14336); \
        asm volatile("s_waitcnt lgkmcnt(0)" ::: "memory"); SBAR();   \
        o[d0] = __builtin_amdgcn_mfma_f32_32x32x16_bf16(pa0, (bf16x8){l0[0], l0[1], l0[2], l0[3], h0[0], h0[1], h0[2], h0[3]}, o[d0], 0, 0, 0);   \
        o[d0] = __builtin_amdgcn_mfma_f32_32x32x16_bf16(pa1, (bf16x8){l1[0], l1[1], l1[2], l1[3], h1[0], h1[1], h1[2], h1[3]}, o[d0], 0, 0, 0);   \
        o[d0] = __builtin_amdgcn_mfma_f32_32x32x16_bf16(pa2, (bf16x8){l2[0], l2[1], l2[2], l2[3], h2[0], h2[1], h2[2], h2[3]}, o[d0], 0, 0, 0);   \
        o[d0] = __builtin_amdgcn_mfma_f32_32x32x16_bf16(pa3, (bf16x8){l3[0], l3[1], l3[2], l3[3], h3[0], h3[1], h3[2], h3[3]}, o[d0], 0, 0, 0); } while (0)
    PV_D0(0); PV_D0(1); PV_D0(2); PV_D0(3);
#undef PV_D0
#undef TRRD
}

struct Ref { const bf16_t* Q; const bf16_t* K; const bf16_t* V; const bf16_t* Qr; const bf16_t* Kr; int qs, ks; int P0; bf16_t* O; int os; const bf16_t* Z; int zs; float* LSE; int ls; };
template <int KIND> struct Seam { bf16x8 qr[Cfg<KIND>::NQ]; bf16x8 st_v0, st_v1, st_k0, st_k1, st_kr; };
__device__ __forceinline__ int swa_jlo(int P0, int W) { const int lowk = P0 - W + 1; return lowk > 0 ? lowk / KVBLK : 0; }
#define VMW() asm volatile("s_waitcnt vmcnt(0)" ::: "memory")
#define VMWN(n) asm volatile("s_waitcnt vmcnt(%0)" :: "i"(n) : "memory")
#define SLOAD_H(R, k0, TO, TID) do { const bf16_t* vb_ = (R).V + (size_t)(k0) * (R).ks; const bf16_t* kb_ = (R).K + (size_t)(k0) * (R).ks;                         \
                            S.st_v0 = ld8(vb_ + (TO)); S.st_v1 = ld8(vb_ + (size_t)32 * (R).ks + (TO)); S.st_k0 = ld8(kb_ + (TO)); S.st_k1 = ld8(kb_ + (size_t)32 * (R).ks + (TO)); \
                            if constexpr (KIND == K_MLA) S.st_kr = ld8((R).Kr + (size_t)(k0) * 64 + (TID) * 8); } while (0)
#define SWRITE_HK(bf) do { *(bf16x8*)(K_lds + (bf) * SHM_K + kws) = S.st_k0; *(bf16x8*)(K_lds + (bf) * SHM_K + kws + 32 * 256) = S.st_k1;                 \
                           if constexpr (KIND == K_MLA) *(bf16x8*)(KR_lds + (bf) * SHM_KR + krws) = S.st_kr; } while (0)
#define SWRITE_HV(bf) do { *(bf16x8*)(V_lds + (bf) * SHM_V + vst0) = S.st_v0; *(bf16x8*)(V_lds + (bf) * SHM_V + vst1) = S.st_v1; } while (0)
#define SWRITE_H(bf) do { SWRITE_HV(bf); SWRITE_HK(bf); } while (0)
#define QLOAD(R, R32, HI) do { const bf16_t* qb_ = (R).Q + (size_t)(wid * QBLK) * (R).qs; const unsigned qo_ = (unsigned)((R32) * (R).qs + (HI) * 8);                             \
                      _Pragma("unroll") for (int d0 = 0; d0 < 8; ++d0) S.qr[d0] = ld8(qb_ + qo_ + d0 * 16); } while (0)
#define QLOAD_R(R, R32, HI) do { if constexpr (KIND == K_MLA) { const bf16_t* qb_ = (R).Qr + (size_t)(wid * QBLK) * (R).qs; const unsigned qo_ = (unsigned)((R32) * (R).qs + (HI) * 8);     \
                      _Pragma("unroll") for (int d0 = 0; d0 < 4; ++d0) S.qr[8 + d0] = ld8(qb_ + qo_ + d0 * 16); } } while (0)
template <int KIND>
__device__ __forceinline__ void attn_prime(const Ref& cur, int W, char* lds, Seam<KIND>& S) {
    const int tid = threadIdx.x, wid = __builtin_amdgcn_readfirstlane(tid >> 6), lane = tid & 63, r32 = lane & 31, hi = lane >> 5;
    const int sr = tid >> 4, sc = (tid & 15) * 8, kws = KSWZ(sr, sc * 2), krws = (tid >> 3) * KR_ROW + (tid & 7) * 16;
    char* K_lds = lds + OFF_K; char* KR_lds = lds + OFF_KR; (void)KR_lds; (void)krws;
    const int kb0 = swa_jlo(cur.P0, W) * KVBLK; const unsigned toff = (unsigned)(sr * cur.ks + sc);
    QLOAD(cur, r32, hi); QLOAD_R(cur, r32, hi);
    SLOAD_H(cur, kb0, toff, tid); VMW(); SWRITE_HK(0);
    __syncthreads();
}
template <int KIND>
__device__ __forceinline__ void attn_block(const Ref& cur, const Ref& nxt, int skv, int W, char* lds, Seam<KIND>& S) {
    constexpr bool SK = Cfg<KIND>::SK; constexpr float SCALE = Cfg<KIND>::SCALE; constexpr int NQL = Cfg<KIND>::NQ;
    const int tid = threadIdx.x, wid = __builtin_amdgcn_readfirstlane(tid >> 6), lane = tid & 63, r32 = lane & 31, hi = lane >> 5;
    const int j_lo = swa_jlo(cur.P0, W);
    int j_hi = (cur.P0 + QB - 1) / KVBLK + 1; if (j_hi > skv / KVBLK) j_hi = skv / KVBLK;
    const int NT = j_hi - j_lo;
    const int kbn = swa_jlo(nxt.P0, W) * KVBLK;
    const int qlo = cur.P0 + wid * QBLK, qm = qlo + r32 - 4 * hi;
    char* V_lds = lds + OFF_V; char* K_lds = lds + OFF_K; char* KR_lds = lds + OFF_KR; (void)KR_lds;
    float* ws = (float*)(lds + OFF_WS) + wid * 64; float* li_l = ws, * al_l = ws + 32;
    float m_reg = -1e30f, l_reg = 0; f32x16 o[4] = {};
    const int sr = tid >> 4, sc = (tid & 15) * 8, vst0 = v_st(sr, sc), vst1 = v_st(32 + sr, sc), kws = KSWZ(sr, sc * 2);
    const int krws = (tid >> 3) * KR_ROW + (tid & 7) * 16; (void)krws;
    const int vb0 = (int)(uintptr_t)V_lds + v_rd_base(lane);
    const unsigned toff = (unsigned)(sr * cur.ks + sc);
    const int qrofs = wid * 4096 + lane * 16;
#define RESC(a) do { if (__any((a) < 1.f)) { if (hi == 0) al_l[r32] = (a); asm volatile("s_waitcnt lgkmcnt(0)" ::: "memory");              \
                     for (int d_ = 0; d_ < 4; ++d_) for (int r = 0; r < 16; ++r) o[d_][r] *= al_l[crow(r, hi)]; } } while (0)
#define KBASE(t) ((j_lo + (t)) * KVBLK)
#define ACT(t) (KBASE(t) <= qlo + QBLK - 1 && KBASE(t) + KVBLK - 1 >= qlo - W + 1)
#define BOFS(t) (KIND == K_FOX ? KBASE(t) + 4 * hi : (KIND == K_DIL ? TBL_TOP - (qm - KBASE(t)) : qrofs))
#define MASKT(P0_, P1_, t) do { if constexpr (KIND != K_DIL) { const int kb_ = KBASE(t); if ((!SK || ACT(t)) && (kb_ + KVBLK - 1 > qlo || kb_ <= qlo + QBLK - 1 - W)) mask_tile(P0_, P1_, qm - kb_, (unsigned)W); } } while (0)
#define SEAM_K0() do { VMWN(NQL); SWRITE_HK(0); SBAR(); } while (0)
    f32x16 pA0, pA1, pB0, pB1; float mnA, mnB, alA, alB; bf16x8 pa0, pa1, pa2, pa3;
    if constexpr (KIND == K_MLA) {
#pragma unroll
        for (int d0 = 0; d0 < 4; ++d0) *(bf16x8*)(lds + OFF_BIAS + qrofs + d0 * 1024) = S.qr[8 + d0]; }
    SWRITE_HV(0); SBAR();
    if (NT > 1) { SLOAD_H(cur, KBASE(1), toff, tid); }
    SBAR(); qkt<KIND, 0>(pA0, pA1, lds, r32, hi, S.qr, ACT(0), BOFS(0));
    MASKT(pA0, pA1, 0); partialSM<KIND>(pA0, pA1, m_reg, mnA, alA);
    if (NT > 1) { VMW(); SWRITE_H(1); }
    __syncthreads();
#define HALF_STEP(PX0, PX1, mnX, alX, PY0, PY1, alY, t, KB, VB, SB) do {                                                      \
        SBAR(); qkt<KIND, KB>(PX0, PX1, lds, r32, hi, S.qr, ACT(t), BOFS(t));                                                 \
        finishSM(PY0, PY1, alY, l_reg, pa0, pa1, pa2, pa3); SBAR();                                                           \
        if ((t) + 1 < NT) { SLOAD_H(cur, KBASE((t) + 1), toff, tid); SBAR(); }                                                           \
        pv_tile<VB, SK>(o, vb0, pa0, pa1, pa2, pa3, ACT((t) - 1)); MASKT(PX0, PX1, (t)); partialSM<KIND>(PX0, PX1, m_reg, mnX, alX);                          \
        __syncthreads();                                                                                                      \
        if ((t) + 1 < NT) { VMW(); SWRITE_H(SB); }                                                                            \
        RESC(alX); __syncthreads(); } while (0)
    for (int t = 1; t + 1 < NT; t += 2) {
        HALF_STEP(pB0, pB1, mnB, alB, pA0, pA1, alA, t, 1, 0, 0);
        HALF_STEP(pA0, pA1, mnA, alA, pB0, pB1, alB, t + 1, 0, 1, 1);
    }
    const bool even = (NT & 1) == 0;
    if (even) { SBAR(); qkt<KIND, 1>(pB0, pB1, lds, r32, hi, S.qr, ACT(NT - 1), BOFS(NT - 1)); SBAR(); }
    int tid_t = tid; asm volatile("" : "+v"(tid_t));
    const int r32t = tid_t & 31, hit = (tid_t >> 5) & 1; const unsigned toffn = (unsigned)((tid_t >> 4) * nxt.ks + (tid_t & 15) * 8);
    SLOAD_H(nxt, kbn, toffn, tid_t); SBAR();
    QLOAD(nxt, r32t, hit);
    SBAR();
    finishSM(pA0, pA1, alA, l_reg, pa0, pa1, pa2, pa3); SBAR();
    pv_tile<0, SK>(o, vb0, pa0, pa1, pa2, pa3, ACT(even ? NT - 2 : NT - 1));
    if (even) { MASKT(pB0, pB1, NT - 1); partialSM<KIND>(pB0, pB1, m_reg, mnB, alB); __syncthreads(); RESC(alB);
        finishSM(pB0, pB1, alB, l_reg, pa0, pa1, pa2, pa3); SBAR(); pv_tile<1, SK>(o, vb0, pa0, pa1, pa2, pa3, ACT(NT - 1)); }
    SBAR(); QLOAD_R(nxt, r32t, hit); SBAR(); SEAM_K0();
    if (hit == 0) li_l[r32t] = l_reg; asm volatile("s_waitcnt lgkmcnt(0)" ::: "memory");
    if constexpr (KIND == K_DIL) { if (hit == 0) cur.LSE[(size_t)(wid * QBLK + r32t) * cur.ls] = m_reg * SCALE + logf(l_reg); }
    float rli[16];
#pragma unroll
    for (int r = 0; r < 16; ++r) rli[r] = __builtin_amdgcn_rcpf(li_l[crow(r, hit)]);
    bf16_t* Ow = cur.O + (size_t)(wid * QBLK) * cur.os; const unsigned ooff = (unsigned)(4 * hit * cur.os + r32t);
    const bf16_t* Zw = cur.Z + (size_t)(wid * QBLK) * cur.zs; const unsigned zoff = (unsigned)(4 * hit * cur.zs + r32t); (void)Zw; (void)zoff;
#pragma unroll
    for (int r = 0; r < 16; ++r) { const int cr = (r & 3) + 8 * (r >> 2);
#pragma unroll
        for (int d0 = 0; d0 < 4; ++d0) { float v = o[d0][r] * rli[r];
            if constexpr (KIND != K_DIL) { const float z = bf2f(*(Zw + (size_t)cr * cur.zs + zoff + d0 * 32)); v = v * z / (1.f + __expf(-z)); }
            const float vn = __shfl_xor(v, 1);
            if ((r32t & 1) == 0) *(unsigned*)(Ow + (size_t)cr * cur.os + ooff + d0 * 32) = cvtpk(v, vn); } }
    __syncthreads();
#undef RESC
#undef KBASE
#undef ACT
#undef BOFS
#undef MASKT
#undef SEAM_K0
#undef HALF_STEP
}
#undef VMW
#undef VMWN
#undef SLOAD_H
#undef SWRITE_HK
#undef SWRITE_HV
#undef SWRITE_H
#undef QLOAD
#undef QLOAD_R
#undef KSWZ
}

#define GAS __attribute__((address_space(1)))
#define LAS __attribute__((address_space(3)))
typedef unsigned short bf16;
typedef unsigned v4u __attribute__((ext_vector_type(4)));
typedef float f32x4 __attribute__((ext_vector_type(4)));
typedef short bf16x8 __attribute__((ext_vector_type(8)));
typedef GAS unsigned gu32;
typedef GAS unsigned long long gu64;
#define RLX_AGENT __ATOMIC_RELAXED, __HIP_MEMORY_SCOPE_AGENT
#define LDS_WAIT() asm volatile("s_waitcnt lgkmcnt(0)" ::: "memory")
#define VM_WAIT() asm volatile("s_waitcnt vmcnt(0)" ::: "memory")
__device__ __forceinline__ unsigned long long rt() { return __builtin_amdgcn_s_memrealtime(); }
__device__ __forceinline__ unsigned f2bf(float f) { unsigned u = __builtin_bit_cast(unsigned, f); return (u + 0x7fffu + ((u >> 16) & 1u)) >> 16; }
__device__ __forceinline__ unsigned pk2(float lo, float hi) { return f2bf(lo) | (f2bf(hi) << 16); }

#define XB_TMO      128
#define XB_XCNT(j)  (256  + 64 * (j))
#define XB_XSUB(j)  (1280 + 64 * (j))
#define XB_XGEN(j)  (2304 + 64 * (j))
#define XB_TOP      3328
#define XB_TOPGEN   3392
#define XCD_BAR_WORDS 3456
#define XB_SPIN_CAP (1u << 18)

__device__ __forceinline__ unsigned xb_ld(unsigned* p)              { return __hip_atomic_load(p, __ATOMIC_RELAXED, __HIP_MEMORY_SCOPE_AGENT); }
__device__ __forceinline__ unsigned xb_add(unsigned* p, unsigned v) { return __hip_atomic_fetch_add(p, v, __ATOMIC_RELAXED, __HIP_MEMORY_SCOPE_AGENT); }
__device__ __forceinline__ unsigned xb_xcc_id() { return (unsigned)__builtin_amdgcn_s_getreg((3 << 11) | 20) & 0xFu; }
#define XB_SPIN(cond, bar) do { unsigned _sp = 0; while (cond) { __builtin_amdgcn_s_sleep(1); \
    if ((++_sp & 255u) == 0u) { if (xb_ld(&(bar)[XB_TMO])) break; if (_sp > XB_SPIN_CAP) { atomicAdd(&(bar)[XB_TMO], 1u); break; } } } } while (0)

struct XcdBarrier {
    unsigned* bar; unsigned x;
    volatile LAS unsigned* st;
};

__device__ __forceinline__ XcdBarrier xcd_barrier_post(unsigned* bar, volatile LAS unsigned* st) {
    XcdBarrier b; b.bar = bar; b.x = xb_xcc_id(); b.st = st;
    if (threadIdx.x == 0) (void)xb_add(&bar[XB_XCNT(b.x)], 1u);
    return b;
}
__device__ __forceinline__ void xcd_barrier_complete(unsigned* bar, unsigned x, unsigned& nloc, unsigned& nx) {
    const unsigned G = gridDim.x * gridDim.y * gridDim.z;
    unsigned sum, cnt, mine, sp = 0u;
    for (;;) {
        sum = 0u; cnt = 0u; mine = 0u;
#pragma unroll
        for (unsigned j = 0; j < 16; ++j) { const unsigned c = xb_ld(&bar[XB_XCNT(j)]); sum += c; cnt += (c > 0u) ? 1u : 0u; mine = (j == x) ? c : mine; }
        if (sum == G) break;
        __builtin_amdgcn_s_sleep(1);
        if ((++sp & 255u) == 0u) { if (xb_ld(&bar[XB_TMO])) break; if (sp > XB_SPIN_CAP) { atomicAdd(&bar[XB_TMO], 1u); break; } }
    }
    nloc = mine > 0u ? mine : 1u; nx = cnt > 0u ? cnt : 1u;
}

__device__ __forceinline__ void xcd_barrier(const XcdBarrier& b) {
    asm volatile("s_waitcnt vmcnt(0)" ::: "memory");
    __syncthreads();
    if (threadIdx.x == 0) {
        unsigned* bar = b.bar;
        __builtin_amdgcn_s_waitcnt(0);
        unsigned nloc = b.st[0], nx = b.st[1];
        if (nloc == 0u) { xcd_barrier_complete(bar, b.x, nloc, nx); b.st[0] = nloc; b.st[1] = nx; }
        const unsigned old = xb_add(&bar[XB_XSUB(b.x)], 1u);
        const unsigned gen = old / nloc;
        if (old + 1u == (gen + 1u) * nloc) {
            __builtin_amdgcn_fence(__ATOMIC_RELEASE, "agent");
            asm volatile("s_waitcnt vmcnt(0)" ::: "memory");
            const unsigned og = xb_add(&bar[XB_TOP], 1u);
            const unsigned tg = og / nx;
            if (og + 1u == (tg + 1u) * nx) xb_add(&bar[XB_TOPGEN], 1u);
            else XB_SPIN(xb_ld(&bar[XB_TOPGEN]) == tg, bar);
            __builtin_amdgcn_fence(__ATOMIC_ACQUIRE, "agent");
            xb_add(&bar[XB_XGEN(b.x)], 1u);
            asm volatile("s_waitcnt vmcnt(0)" ::: "memory");
        } else {
            XB_SPIN(xb_ld(&bar[XB_XGEN(b.x)]) == gen, bar);
            __builtin_amdgcn_fence(__ATOMIC_ACQUIRE, "agent");
            asm volatile("s_waitcnt vmcnt(0)" ::: "memory");
        }
    }
    __syncthreads();
}

constexpr int BATCH = 2, SEQ = 8192, DM = 4096, M = BATCH * SEQ, HD = 128;
constexpr int NHA = 16, NHB = 16, NHC = 32;
constexpr int IN_EVEN = 16400, IN_ODD = 5696, Q_LORA = 1024, KV_LORA = 512, QK_ROPE = 64;
constexpr int N0 = 16384;
constexpr int C_QA = 0, C_KA = 2048, C_VA = 4096, C_QB = 6144, C_KB = 8192, C_VB = 10240, C_Z0 = 12288;
constexpr int N1 = 5888;
constexpr int C1_Z = 0, C1_CQ = 4096, C1_CKV = 5120, C1_KR = 5632;
constexpr int NQ = 6144;
constexpr int NKV = 8192;
constexpr float EPS = 1e-6f;
constexpr int NWAVES = 8;
#ifndef MK_PER_PHASE
#define MK_PER_PHASE 0
#endif
constexpr int N_PHASES = 13;

constexpr size_t MiB = 1u << 20;
constexpr size_t WS_CTL = 0, CTL_ZERO_BYTES = 1 * MiB;
constexpr size_t WS_MOD = 1 * MiB;
constexpr size_t WS_FLOGIT = 2 * MiB;
constexpr size_t WS_CS = 4 * MiB;
constexpr size_t WS_LSE = 8 * MiB;
constexpr size_t WS_WFT = 12 * MiB;
constexpr size_t WS_BT0 = 16 * MiB;
constexpr size_t WS_WO0 = 144 * MiB;
constexpr size_t WS_BT1 = 176 * MiB;
constexpr size_t WS_WQB = 222 * MiB;
constexpr size_t WS_WKVB = 234 * MiB;
constexpr size_t WS_WO1 = 242 * MiB;
constexpr size_t WS_XN = 274 * MiB;
constexpr size_t WS_PROJ0 = 402 * MiB;
constexpr size_t WS_OP = 914 * MiB;
constexpr size_t WS_G = 1106 * MiB;
constexpr size_t WS_END = 1234 * MiB;
constexpr size_t WS_PROJ1 = 402 * MiB;
constexpr size_t WS_CQN = 586 * MiB;
constexpr size_t WS_CKVN = 618 * MiB;
constexpr size_t WS_KROPE = 634 * MiB;
constexpr size_t WS_QBUF = 636 * MiB;
constexpr size_t WS_KVBUF = 828 * MiB;
static_assert(WS_KVBUF + (size_t)M * NKV * 2 <= WS_G && WS_PROJ1 + (size_t)M * N1 * 2 <= WS_CQN && WS_QBUF + (size_t)M * NQ * 2 <= WS_KVBUF, "d_ws map");
constexpr int CW_BAR = 4096;

constexpr int RING_OFF = 0, RING_BYTES = 131072;
constexpr int LDSCTL_OFF = RING_BYTES, MISC_OFF = LDSCTL_OFF + 320;
constexpr int LDS_BYTES = 147456;
static_assert(MISC_OFF + 128 <= LDS_BYTES && at::LDS_BYTES <= RING_BYTES && pg8::STAGE_BYTES <= RING_BYTES, "LDS map");

struct Args { const void* in[17]; float* out; unsigned char* ws; int ph_lo, ph_hi; };

struct Ctx {
    LAS unsigned char* lds; int tid, lane, wave, vcu, G;
    const Args* A;
    float* out; unsigned char* ws;
};
#define IN_X(F)        ((const float*)(F).A->in[0])
#define IN_C(F)        ((const float*)(F).A->in[1])
#define IN_POS(F)      ((const int*)(F).A->in[2])
#define IN_GNORM(F)    ((const float*)(F).A->in[3])
#define IN_WADA(F)     ((const float*)(F).A->in[4])
#define IN_BADA(F)     ((const float*)(F).A->in[5])
#define IN_RELB(F)     ((const float*)(F).A->in[6])
#define IN_WINE(F)     ((const float*)(F).A->in[7])
#define IN_BF(F)       ((const float*)(F).A->in[8])
#define IN_WOE(F)      ((const float*)(F).A->in[9])
#define IN_WINO(F)     ((const float*)(F).A->in[10])
#define IN_GQ(F)       ((const float*)(F).A->in[11])
#define IN_GKV(F)      ((const float*)(F).A->in[12])
#define IN_WQB(F)      ((const float*)(F).A->in[13])
#define IN_WKVB(F)     ((const float*)(F).A->in[14])
#define IN_WOO(F)      ((const float*)(F).A->in[15])
#define IN_GFIN(F)     ((const float*)(F).A->in[16])
__device__ __forceinline__ float wave_sum(float v) {
#pragma unroll
    for (int o = 1; o < 64; o <<= 1) v += __shfl_xor(v, o);
    return v;
}
__device__ __forceinline__ float bf2f(unsigned short h) { return __uint_as_float(((unsigned)h) << 16); }
__device__ __forceinline__ float silu_f(float z) { return z / (1.f + __expf(-z)); }

__device__ __forceinline__ void transpose_item(const float* W, int ldw, int K, int kb, int n0, bf16* WT, int drow0, int rmul, LAS float* scr, int lane) {
    const int k0 = 64 * kb;
#pragma unroll 8
    for (int i = 0; i < 32; ++i) { const int kk = 2 * i + (lane >> 5); scr[kk * 33 + (lane & 31)] = W[(size_t)(k0 + kk) * ldw + n0 + (lane & 31)]; }
    LDS_WAIT(); asm volatile("" ::: "memory");
    const int cch = lane & 7;
#pragma unroll
    for (int j = 0; j < 4; ++j) { const int n = (lane >> 3) + 8 * j; const LAS float* s = scr + (8 * cch) * 33 + n;
        v4u o; o.x = pk2(s[0 * 33], s[1 * 33]); o.y = pk2(s[2 * 33], s[3 * 33]); o.z = pk2(s[4 * 33], s[5 * 33]); o.w = pk2(s[6 * 33], s[7 * 33]);
        *(GAS v4u*)(WT + (size_t)(drow0 + rmul * n) * K + k0 + 8 * cch) = o; }
    LDS_WAIT(); asm volatile("" ::: "memory");
}
__device__ __forceinline__ void map_in_odd(int nb, int& drow0, int& rmul) { rmul = 1;
    if (nb < 32) drow0 = C1_CQ + 32 * nb; else if (nb < 48) drow0 = C1_CKV + 32 * (nb - 32); else if (nb < 50) { drow0 = C1_KR + (nb - 48); rmul = 2; } else drow0 = C1_Z + 32 * (nb - 50); }
__device__ __forceinline__ void map_qb(int nb, int& drow0, int& rmul) { const int h = nb / 6, part = nb % 6; rmul = 1;
    if (part < 4) drow0 = h * 128 + part * 32; else { drow0 = 4096 + h * 64 + (part - 4); rmul = 2; } }
__device__ __forceinline__ void map_kvb(int nb, int& drow0, int& rmul) { const int h = nb / 8, part = nb % 8; rmul = 1;
    drow0 = part < 4 ? h * 128 + part * 32 : 4096 + h * 128 + (part - 4) * 32; }

__device__ __forceinline__ void p0_prologue(Ctx& F) {
    const int gw = F.vcu * NWAVES + F.wave, NGW = F.G * NWAVES, gt = gw * 64 + F.lane, NGT = NGW * 64;
    float* cs = (float*)(F.ws + WS_CS);
    for (int i = gt; i < M * 32; i += NGT) { const int row = i >> 5, j = i & 31;
        const float inv = powf(10000.0f, -(float)j / 32.0f); const float ang = (float)IN_POS(F)[row] * inv; float sn, cn; sincosf(ang, &sn, &cn);
        cs[(size_t)row * 64 + j] = cn; cs[(size_t)row * 64 + 32 + j] = sn; }
    bf16* wft = (bf16*)(F.ws + WS_WFT);
    for (int i = gt; i < 16 * DM; i += NGT) { const int n = i >> 12, k = i & 4095; wft[i] = (bf16)f2bf(IN_WINE(F)[(size_t)k * IN_EVEN + N0 + n]); }
    { v4u* pad = (v4u*)((bf16*)(F.ws + WS_BT1) + (size_t)IN_ODD * DM); const int npad = (N1 - IN_ODD) * DM / 8;
      for (int i = gt; i < npad; i += NGT) pad[i] = (v4u){0u, 0u, 0u, 0u}; }
    LAS float* scr = (LAS float*)(F.lds + RING_OFF + F.wave * 16384);
    constexpr int KB4 = DM / 64;
    constexpr int I_IN0 = KB4 * (N0 / 32), I_WO = KB4 * (DM / 32), I_IN1 = KB4 * (IN_ODD / 32), I_QB = (Q_LORA / 64) * (NQ / 32), I_KVB = (KV_LORA / 64) * (NKV / 32);
    constexpr int NITEMS = I_IN0 + 2 * I_WO + I_IN1 + I_QB + I_KVB;
    for (int it = gw; it < NITEMS; it += NGW) {
        int r = it, drow0, rmul;
        if (r < I_IN0) { const int nblk = N0 / 32; transpose_item(IN_WINE(F), IN_EVEN, DM, r / nblk, 32 * (r % nblk), (bf16*)(F.ws + WS_BT0), 32 * (r % nblk), 1, scr, F.lane); continue; } r -= I_IN0;
        if (r < I_WO) { const int nblk = DM / 32; transpose_item(IN_WOE(F), DM, DM, r / nblk, 32 * (r % nblk), (bf16*)(F.ws + WS_WO0), 32 * (r % nblk), 1, scr, F.lane); continue; } r -= I_WO;
        if (r < I_WO) { const int nblk = DM / 32; transpose_item(IN_WOO(F), DM, DM, r / nblk, 32 * (r % nblk), (bf16*)(F.ws + WS_WO1), 32 * (r % nblk), 1, scr, F.lane); continue; } r -= I_WO;
        if (r < I_IN1) { const int nblk = IN_ODD / 32; map_in_odd(r % nblk, drow0, rmul); transpose_item(IN_WINO(F), IN_ODD, DM, r / nblk, 32 * (r % nblk), (bf16*)(F.ws + WS_BT1), drow0, rmul, scr, F.lane); continue; } r -= I_IN1;
        if (r < I_QB) { const int nblk = NQ / 32; map_qb(r % nblk, drow0, rmul); transpose_item(IN_WQB(F), NQ, Q_LORA, r / nblk, 32 * (r % nblk), (bf16*)(F.ws + WS_WQB), drow0, rmul, scr, F.lane); continue; } r -= I_QB;
        { const int nblk = NKV / 32; map_kvb(r % nblk, drow0, rmul); transpose_item(IN_WKVB(F), NKV, KV_LORA, r / nblk, 32 * (r % nblk), (bf16*)(F.ws + WS_WKVB), drow0, rmul, scr, F.lane); }
    }
    __syncthreads();
    LAS float* sc = (LAS float*)(F.lds + RING_OFF);
    LAS float* red = (LAS float*)(F.lds + RING_OFF + 32768);
    for (int i = F.tid; i < BATCH * DM; i += NWAVES * 64) sc[i] = silu_f(IN_C(F)[i]);
    __syncthreads();
    float* mod = (float*)(F.ws + WS_MOD);
    const int c4 = F.tid & 7, kl = F.tid >> 3;
    for (int it = F.vcu; it < 2 * (3 * DM / 32); it += F.G) {
        const int l = it / (3 * DM / 32), n0 = 32 * (it % (3 * DM / 32));
        const float* wp = IN_WADA(F) + ((size_t)l * DM) * (3 * DM) + n0 + 4 * c4;
        f32x4 a0 = (f32x4){0.f, 0.f, 0.f, 0.f}, a1 = a0;
#pragma unroll 8
        for (int i = 0; i < 64; ++i) { const int k = kl + 64 * i; const f32x4 w = *(const GAS f32x4*)(wp + (size_t)k * (3 * DM)); a0 += w * sc[k]; a1 += w * sc[DM + k]; }
        LAS float* rp = red + (kl * 8 + c4) * 8;
        rp[0] = a0[0]; rp[1] = a0[1]; rp[2] = a0[2]; rp[3] = a0[3]; rp[4] = a1[0]; rp[5] = a1[1]; rp[6] = a1[2]; rp[7] = a1[3];
        __syncthreads();
        if (F.tid < 64) { const int b = F.tid >> 5, n = F.tid & 31; float s = 0.f;
            for (int q = 0; q < 64; ++q) s += red[(q * 8 + (n >> 2)) * 8 + b * 4 + (n & 3)];
            mod[((size_t)l * BATCH + b) * (3 * DM) + n0 + n] = s + IN_BADA(F)[(size_t)l * (3 * DM) + n0 + n]; }
        __syncthreads();
    }
}

__device__ __forceinline__ void adaln_rows(Ctx& F, const float* X, const float* g, const float* mod  , bf16* XN) {
    const int gw = F.vcu * NWAVES + F.wave, NGW = F.G * NWAVES;
    for (int m = gw; m < M; m += NGW) {
        const int b = m / SEQ;
        const GAS f32x4* xr = (const GAS f32x4*)(X + (size_t)m * DM) + F.lane;
        f32x4 v[16]; float s = 0.f;
#pragma unroll
        for (int j = 0; j < 16; ++j) { v[j] = xr[64 * j]; s += (v[j].x * v[j].x + v[j].y * v[j].y) + (v[j].z * v[j].z + v[j].w * v[j].w); }
        const float rstd = 1.0f / sqrtf(wave_sum(s) * (1.f / DM) + EPS);
        const f32x4* g4 = (const f32x4*)g + F.lane; const f32x4* sh4 = (const f32x4*)(mod + (size_t)b * 3 * DM) + F.lane; const f32x4* sc4 = (const f32x4*)(mod + (size_t)b * 3 * DM + DM) + F.lane;
        GAS unsigned long long* o8 = (GAS unsigned long long*)(XN + (size_t)m * DM) + F.lane;
#pragma unroll
        for (int j = 0; j < 16; ++j) { const f32x4 y = (v[j] * rstd) * g4[64 * j] * (sc4[64 * j] + 1.0f) + sh4[64 * j];
            o8[64 * j] = (unsigned long long)pk2(y.x, y.y) | ((unsigned long long)pk2(y.z, y.w) << 32); }
    }
}
__device__ __forceinline__ void final_rows(Ctx& F) {
    const int gw = F.vcu * NWAVES + F.wave, NGW = F.G * NWAVES;
    for (int m = gw; m < M; m += NGW) {
        GAS f32x4* xr = (GAS f32x4*)(F.out + (size_t)m * DM) + F.lane;
        f32x4 v[16]; float s = 0.f;
#pragma unroll
        for (int j = 0; j < 16; ++j) { v[j] = xr[64 * j]; s += (v[j].x * v[j].x + v[j].y * v[j].y) + (v[j].z * v[j].z + v[j].w * v[j].w); }
        const float rstd = 1.0f / sqrtf(wave_sum(s) * (1.f / DM) + EPS);
        const f32x4* g4 = (const f32x4*)IN_GFIN(F) + F.lane;
#pragma unroll
        for (int j = 0; j < 16; ++j) xr[64 * j] = (v[j] * rstd) * g4[64 * j];
    }
}
__device__ __forceinline__ void flogit_rows(Ctx& F) {
    typedef float f4 __attribute__((ext_vector_type(4)));
    const bf16* XN = (const bf16*)(F.ws + WS_XN); const bf16* WFT = (const bf16*)(F.ws + WS_WFT); float* FL = (float*)(F.ws + WS_FLOGIT);
    LAS f4* red = (LAS f4*)(F.lds + RING_OFF);
    const int r = F.lane & 15, kg = F.lane >> 4, kh = F.wave >> 2;
    for (int c0 = F.vcu; c0 < M / 64; c0 += F.G) {
        const int row0 = c0 * 64 + 16 * (F.wave & 3);
        const bf16* ap = XN + (size_t)(row0 + r) * DM + kh * 2048 + 8 * kg; const bf16* bp = WFT + (size_t)r * DM + kh * 2048 + 8 * kg;
        f4 acc = (f4){0.f, 0.f, 0.f, 0.f};
#pragma unroll 8
        for (int s = 0; s < 64; ++s) { const bf16x8 a = *(const GAS bf16x8*)(ap + 32 * s), b = *(const GAS bf16x8*)(bp + 32 * s);
            acc = __builtin_amdgcn_mfma_f32_16x16x32_bf16(a, b, acc, 0, 0, 0); }
        if (kh == 1) red[(F.wave & 3) * 64 + F.lane] = acc;
        __syncthreads();
        if (kh == 0) { const f4 o = acc + red[(F.wave & 3) * 64 + F.lane];
#pragma unroll
            for (int v = 0; v < 4; ++v) FL[(size_t)(row0 + 4 * kg + v) * 16 + r] = o[v]; }
        __syncthreads();
    }
}
__device__ __forceinline__ void combine_rows(Ctx& F) {
    const int gw = F.vcu * NWAVES + F.wave, NGW = F.G * NWAVES;
    const bf16* OP = (const bf16*)(F.ws + WS_OP); const float* LSE = (const float*)(F.ws + WS_LSE); const bf16* PR = (const bf16*)(F.ws + WS_PROJ0); bf16* G = (bf16*)(F.ws + WS_G);
    for (int m = gw; m < M; m += NGW) {
#pragma unroll
        for (int cc = 0; cc < 4; ++cc) { const int col = (cc * 64 + F.lane) * 8, h = col >> 7;
            const float l0 = LSE[(size_t)m * 16 + h], l1 = LSE[((size_t)M + m) * 16 + h], l2 = LSE[((size_t)2 * M + m) * 16 + h];
            const float mx = fmaxf(l0, fmaxf(l1, l2)); const float e0 = __expf(l0 - mx), e1 = __expf(l1 - mx), e2 = __expf(l2 - mx); const float inv = 1.f / (e0 + e1 + e2);
            const float w0 = e0 * inv, w1 = e1 * inv, w2 = e2 * inv;
            const v4u a = *(const GAS v4u*)(OP + (size_t)m * 2048 + col), b = *(const GAS v4u*)(OP + ((size_t)M + m) * 2048 + col), c = *(const GAS v4u*)(OP + ((size_t)2 * M + m) * 2048 + col);
            const v4u z = *(const GAS v4u*)(PR + (size_t)m * N0 + C_Z0 + col);
            v4u o;
#pragma unroll
            for (int q = 0; q < 4; ++q) { const unsigned ua = a[q], ub = b[q], uc = c[q], uz = z[q];
                const float lo = w0 * __uint_as_float(ua << 16) + w1 * __uint_as_float(ub << 16) + w2 * __uint_as_float(uc << 16);
                const float hi = w0 * __uint_as_float(ua & 0xffff0000u) + w1 * __uint_as_float(ub & 0xffff0000u) + w2 * __uint_as_float(uc & 0xffff0000u);
                o[q] = pk2(lo * silu_f(__uint_as_float(uz << 16)), hi * silu_f(__uint_as_float(uz & 0xffff0000u))); }
            *(GAS v4u*)(G + (size_t)m * DM + col) = o; }
    }
}
__device__ __forceinline__ void mla_norm_rows(Ctx& F) {
    const int gw = F.vcu * NWAVES + F.wave, NGW = F.G * NWAVES;
    const bf16* PR = (const bf16*)(F.ws + WS_PROJ1); bf16* CQN = (bf16*)(F.ws + WS_CQN); bf16* CKVN = (bf16*)(F.ws + WS_CKVN); bf16* KR = (bf16*)(F.ws + WS_KROPE); const float* cs = (const float*)(F.ws + WS_CS);
    const float* gq = IN_GQ(F); const float* gkv = IN_GKV(F);
    for (int m = gw; m < M; m += NGW) {
        const bf16* pr = PR + (size_t)m * N1;
        const v4u q0 = *(const GAS v4u*)(pr + C1_CQ + 8 * F.lane), q1 = *(const GAS v4u*)(pr + C1_CQ + 512 + 8 * F.lane), kv = *(const GAS v4u*)(pr + C1_CKV + 8 * F.lane);
        float fq[16], fk[8]; float sq = 0.f, sk = 0.f;
#pragma unroll
        for (int i = 0; i < 4; ++i) { fq[2 * i] = __uint_as_float(q0[i] << 16); fq[2 * i + 1] = __uint_as_float(q0[i] & 0xffff0000u); fq[8 + 2 * i] = __uint_as_float(q1[i] << 16); fq[8 + 2 * i + 1] = __uint_as_float(q1[i] & 0xffff0000u);
            fk[2 * i] = __uint_as_float(kv[i] << 16); fk[2 * i + 1] = __uint_as_float(kv[i] & 0xffff0000u); }
#pragma unroll
        for (int i = 0; i < 16; ++i) sq += fq[i] * fq[i];
#pragma unroll
        for (int i = 0; i < 8; ++i) sk += fk[i] * fk[i];
        const float rq = 1.0f / sqrtf(wave_sum(sq) * (1.f / Q_LORA) + EPS), rk = 1.0f / sqrtf(wave_sum(sk) * (1.f / KV_LORA) + EPS);
        const f32x4 g0a = *(const f32x4*)(gq + 8 * F.lane), g0b = *(const f32x4*)(gq + 8 * F.lane + 4), g1a = *(const f32x4*)(gq + 512 + 8 * F.lane), g1b = *(const f32x4*)(gq + 512 + 8 * F.lane + 4);
        const f32x4 gka = *(const f32x4*)(gkv + 8 * F.lane), gkb = *(const f32x4*)(gkv + 8 * F.lane + 4);
        v4u o0, o1, ok;
        o0.x = pk2(fq[0] * rq * g0a[0], fq[1] * rq * g0a[1]); o0.y = pk2(fq[2] * rq * g0a[2], fq[3] * rq * g0a[3]); o0.z = pk2(fq[4] * rq * g0b[0], fq[5] * rq * g0b[1]); o0.w = pk2(fq[6] * rq * g0b[2], fq[7] * rq * g0b[3]);
        o1.x = pk2(fq[8] * rq * g1a[0], fq[9] * rq * g1a[1]); o1.y = pk2(fq[10] * rq * g1a[2], fq[11] * rq * g1a[3]); o1.z = pk2(fq[12] * rq * g1b[0], fq[13] * rq * g1b[1]); o1.w = pk2(fq[14] * rq * g1b[2], fq[15] * rq * g1b[3]);
        ok.x = pk2(fk[0] * rk * gka[0], fk[1] * rk * gka[1]); ok.y = pk2(fk[2] * rk * gka[2], fk[3] * rk * gka[3]); ok.z = pk2(fk[4] * rk * gkb[0], fk[5] * rk * gkb[1]); ok.w = pk2(fk[6] * rk * gkb[2], fk[7] * rk * gkb[3]);
        *(GAS v4u*)(CQN + (size_t)m * Q_LORA + 8 * F.lane) = o0; *(GAS v4u*)(CQN + (size_t)m * Q_LORA + 512 + 8 * F.lane) = o1; *(GAS v4u*)(CKVN + (size_t)m * KV_LORA + 8 * F.lane) = ok;
        if (F.lane < 32) { const unsigned u = *(const GAS unsigned*)(pr + C1_KR + 2 * F.lane); const float x1 = __uint_as_float(u << 16), x2 = __uint_as_float(u & 0xffff0000u);
            const float cn = cs[(size_t)m * 64 + F.lane], sn = cs[(size_t)m * 64 + 32 + F.lane];
            *(GAS unsigned*)(KR + (size_t)m * 64 + 2 * F.lane) = pk2(x1 * cn - x2 * sn, x1 * sn + x2 * cn); }
    }
}

__device__ __forceinline__ int t5_bucket(int n) {
    if (n < 16) return n;
    const float nf = (float)(n > 1 ? n : 1);
    int large = 16 + (int)(logf(nf / 16.0f) / 4.852030263919617f * 16.0f);
    return large < 31 ? large : 31;
}
__device__ __forceinline__ void dil_ref(Ctx& F, int id, at::Ref& R, int& key) {
    const int j = id & 31, h = (id >> 5) & 15, b = (id >> 9) & 1, p = id >> 10; const int d = p == 0 ? 1 : (p == 1 ? 4 : 16);
    const int nblk = 32 / d, res = j / nblk, n = j % nblk;
    const at::bf16_t* pr = (const at::bf16_t*)(F.ws + WS_PROJ0) + ((size_t)b * SEQ + res) * N0 + h * HD;
    const long st = (long)d * N0;
    R.K = pr + C_KA; R.V = pr + C_VA; R.Q = pr + C_QA + (size_t)(256 * n) * st; R.Qr = nullptr; R.Kr = nullptr; R.qs = (int)st; R.ks = (int)st; R.P0 = 256 * n;
    const size_t orow = (size_t)b * SEQ + res + (size_t)d * 256 * n;
    R.O = (at::bf16_t*)(F.ws + WS_OP) + ((size_t)p * M + orow) * 2048 + h * HD; R.os = d * 2048; R.Z = nullptr; R.zs = 0;
    R.LSE = (float*)(F.ws + WS_LSE) + ((size_t)p * M + orow) * 16 + h; R.ls = d * 16;
    key = p * 16 + h;
}
__device__ __forceinline__ void dilated_phase(Ctx& F) {
    char* lds = (char*)F.lds + RING_OFF;
    const int total = 3 * BATCH * NHA * 32, chunk = (total + F.G - 1) / F.G; int id = F.vcu * chunk; const int end = (id + chunk < total) ? id + chunk : total;
    if (id >= end) return;
    at::Ref cur, nxt; int key = -1, kcur, knxt;
    dil_ref(F, id, cur, kcur);
    at::Seam<at::K_DIL> S;
    at::attn_prime<at::K_DIL>(cur, at::DIL_W, lds, S);
    for (;;) {
        if (kcur != key) {
            key = kcur; const int p = key >> 4, h = key & 15, d = p == 0 ? 1 : (p == 1 ? 4 : 16);
            float* tbl = (float*)(lds + at::OFF_BIAS); const float* relb = IN_RELB(F);
            for (int u = F.tid; u < at::TBL_N; u += NWAVES * 64) { const int dist = at::TBL_TOP - u;
                tbl[u] = (dist >= 0 && dist <= 128) ? relb[t5_bucket(dist * d) * NHA + h] * 11.313708498984761f : -__builtin_inff(); }
            __syncthreads();
        }
        const bool last = id + 1 >= end;
        if (!last) dil_ref(F, id + 1, nxt, knxt); else { nxt = cur; knxt = kcur; }
        const int dcur = (kcur >> 4) == 0 ? 1 : ((kcur >> 4) == 1 ? 4 : 16);
        at::attn_block<at::K_DIL>(cur, nxt, SEQ / dcur, at::DIL_W, lds, S);
        if (last) break;
        cur = nxt; kcur = knxt; ++id;
    }
}
__device__ __forceinline__ void fox_ref(Ctx& F, int item, int pass, at::Ref& R) {
    const int bh = item >> 4, x = item & 15, b = bh >> 4, h = bh & 15, qb = pass ? 31 - x : x;
    const at::bf16_t* pr = (const at::bf16_t*)(F.ws + WS_PROJ0) + (size_t)b * SEQ * N0 + h * HD;
    R.K = pr + C_KB; R.V = pr + C_VB; R.Q = pr + C_QB + (size_t)(256 * qb) * N0; R.Qr = nullptr; R.Kr = nullptr; R.qs = N0; R.ks = N0; R.P0 = 256 * qb;
    const size_t orow = (size_t)b * SEQ + 256 * qb;
    R.O = (at::bf16_t*)(F.ws + WS_G) + orow * DM + 2048 + h * HD; R.os = DM; R.Z = pr + C_Z0 + 2048 + (size_t)(256 * qb) * N0; R.zs = N0; R.LSE = nullptr; R.ls = 0;
}
__device__ __forceinline__ void fox_bias(Ctx& F, int bh, char* lds) {
    const int b = bh >> 4, h = bh & 15; const float* fl = (const float*)(F.ws + WS_FLOGIT) + ((size_t)b * SEQ + 16 * F.tid) * 16 + h; const float bf = IN_BF(F)[h];
    float ls[16]; double run = 0.0;
#pragma unroll
    for (int i = 0; i < 16; ++i) { const float xv = fl[i * 16] + bf; ls[i] = (xv >= 0.f) ? -log1pf(expf(-xv)) : xv - log1pf(expf(xv)); run += (double)ls[i]; }
    double inc = run;
#pragma unroll
    for (int o = 1; o < 64; o <<= 1) { const double t = __shfl_up(inc, o); if (F.lane >= o) inc += t; }
    LAS double* wt = (LAS double*)(lds + at::OFF_WS);
    if (F.lane == 63) wt[F.wave] = inc;
    __syncthreads();
    double pre = inc - run;
    for (int w = 0; w < F.wave; ++w) pre += wt[w];
    float* bias = (float*)(lds + at::OFF_BIAS) + 16 * F.tid;
#pragma unroll
    for (int i = 0; i < 16; ++i) { pre += (double)ls[i]; bias[i] = (float)(-pre * 11.313708498984761); }
    __syncthreads();
}
__device__ __forceinline__ void fox_phase(Ctx& F) {
    char* lds = (char*)F.lds + RING_OFF;
    const int total = BATCH * NHB * 16; int item = F.vcu; if (item >= total) return;
    at::Ref cur, nxt; int pass = 0;
    fox_ref(F, item, 0, cur);
    at::Seam<at::K_FOX> S;
    at::attn_prime<at::K_FOX>(cur, 1 << 30, lds, S);
    for (;;) {
        if (pass == 0) fox_bias(F, item >> 4, lds);
        const bool more_item = item + F.G < total, last = pass == 1 && !more_item;
        int itn = item, pn = 1; if (pass == 1) { pn = 0; itn = more_item ? item + F.G : item; }
        if (last) nxt = cur; else fox_ref(F, itn, pn, nxt);
        at::attn_block<at::K_FOX>(cur, nxt, SEQ, 1 << 30, lds, S);
        if (last) break;
        cur = nxt; item = itn; pass = pn;
    }
}
__device__ __forceinline__ void mla_ref(Ctx& F, int item, int pass, at::Ref& R) {
    const int bh = item >> 4, x = item & 15, b = bh >> 5, h = bh & 31, qb = pass ? 31 - x : x;
    const at::bf16_t* qp = (const at::bf16_t*)(F.ws + WS_QBUF) + ((size_t)b * SEQ + 256 * qb) * NQ; const at::bf16_t* kvp = (const at::bf16_t*)(F.ws + WS_KVBUF) + (size_t)b * SEQ * NKV;
    R.Q = qp + h * HD; R.Qr = qp + 4096 + h * 64; R.K = kvp + h * HD; R.V = kvp + 4096 + h * HD; R.Kr = (const at::bf16_t*)(F.ws + WS_KROPE) + (size_t)b * SEQ * 64; R.qs = NQ; R.ks = NKV; R.P0 = 256 * qb;
    const size_t orow = (size_t)b * SEQ + 256 * qb;
    R.O = (at::bf16_t*)(F.ws + WS_G) + orow * DM + h * HD; R.os = DM; R.Z = (const at::bf16_t*)(F.ws + WS_PROJ1) + orow * N1 + C1_Z + h * HD; R.zs = N1; R.LSE = nullptr; R.ls = 0;
}
__device__ __forceinline__ void mla_phase(Ctx& F) {
    char* lds = (char*)F.lds + RING_OFF;
    const int total = BATCH * NHC * 16; int item = F.vcu; if (item >= total) return;
    at::Ref cur, nxt; int pass = 0;
    mla_ref(F, item, 0, cur);
    at::Seam<at::K_MLA> S;
    at::attn_prime<at::K_MLA>(cur, 1 << 30, lds, S);
    for (;;) {
        const bool more_item = item + F.G < total, last = pass == 1 && !more_item;
        int itn = item, pn = 1; if (pass == 1) { pn = 0; itn = more_item ? item + F.G : item; }
        if (last) nxt = cur; else mla_ref(F, itn, pn, nxt);
        at::attn_block<at::K_MLA>(cur, nxt, SEQ, 1 << 30, lds, S);
        if (last) break;
        cur = nxt; item = itn; pass = pn;
    }
}

__global__ void __launch_bounds__(NWAVES * 64, 2) fwd_kernel(Args args) {
    extern __shared__ __attribute__((aligned(16))) unsigned char lds[];
    Ctx F;
    F.lds = (LAS unsigned char*)lds;
    volatile LAS unsigned* MISC = (volatile LAS unsigned*)(F.lds + MISC_OFF);
    F.tid = threadIdx.x; F.lane = F.tid & 63; F.wave = __builtin_amdgcn_readfirstlane(F.tid >> 6);
    F.G = gridDim.x; { const int bx = blockIdx.x; F.vcu = (F.G % 8 == 0) ? (bx % 8) * (F.G / 8) + bx / 8 : bx; }
    F.A = &args;
    F.out = args.out; F.ws = args.ws;
    unsigned char* ws = args.ws;
    gu32* ctl = (gu32*)(ws + WS_CTL);
    for (int u = F.tid; u < (LDS_BYTES - LDSCTL_OFF) / 4; u += NWAVES * 64) ((LAS unsigned*)(F.lds + LDSCTL_OFF))[u] = 0u;
    __syncthreads();
    XcdBarrier bar; bar.bar = (unsigned*)(ctl + CW_BAR); bar.x = 0; bar.st = nullptr;
    if (!MK_PER_PHASE) bar = xcd_barrier_post((unsigned*)(ctl + CW_BAR), MISC + 8);
    const int lo = args.ph_lo, hi = args.ph_hi;
#ifndef PH_MASK
#define PH_MASK 0x1fff
#endif
#define IN(k) (((PH_MASK >> (k)) & 1) && lo <= (k) && (k) < hi)
#define SEAM(k) do { if (IN(k) && IN((k) + 1)) xcd_barrier(bar); } while (0)
    float* mod = (float*)(ws + WS_MOD);
    bf16* XN = (bf16*)(ws + WS_XN); bf16* G = (bf16*)(ws + WS_G);

    if (IN(0)) { p0_prologue(F); } SEAM(0);
    if (IN(1)) { adaln_rows(F, IN_X(F), IN_GNORM(F), mod, XN); } SEAM(1);
    if (IN(2)) {
        flogit_rows(F);
        pg8::Gemm g{XN, (const bf16*)(ws + WS_BT0), M, N0, DM}; pg8::StaticOrder S; S.init(M, N0, F.G, (int)blockIdx.x);
        pg8::EpiBf16<0> E{(bf16*)(ws + WS_PROJ0), N0, nullptr, 0, 0, 1.f};
        pg8::gemm_phase<pg8::EpiBf16<0>, pg8::StaticOrder, true, true>(F.lds + RING_OFF, g, S, E);
    } SEAM(2);
    if (IN(3)) { dilated_phase(F); __syncthreads(); fox_phase(F); } SEAM(3);
    if (IN(4)) { combine_rows(F); } SEAM(4);
    if (IN(5)) {
        pg8::Gemm g{G, (const bf16*)(ws + WS_WO0), M, DM, DM}; pg8::StaticOrder S; S.init(M, DM, F.G, (int)blockIdx.x);
        pg8::EpiResGate E{IN_X(F), F.out, DM, mod + 2 * DM, 3 * DM, SEQ};
        pg8::gemm_phase<pg8::EpiResGate, pg8::StaticOrder, true, true>(F.lds + RING_OFF, g, S, E);
    } SEAM(5);
    if (IN(6)) { adaln_rows(F, F.out, IN_GNORM(F) + DM, mod + BATCH * 3 * DM, XN); } SEAM(6);
    if (IN(7)) {
        pg8::Gemm g{XN, (const bf16*)(ws + WS_BT1), M, N1, DM}; pg8::StaticOrder S; S.init(M, N1, F.G, (int)blockIdx.x);
        pg8::EpiBf16<0> E{(bf16*)(ws + WS_PROJ1), N1, nullptr, 0, 0, 1.f};
        pg8::gemm_phase<pg8::EpiBf16<0>, pg8::StaticOrder, true, true>(F.lds + RING_OFF, g, S, E);
    } SEAM(7);
    if (IN(8)) { mla_norm_rows(F); } SEAM(8);
    if (IN(9)) {
        { pg8::Gemm g{(const bf16*)(ws + WS_CQN), (const bf16*)(ws + WS_WQB), M, NQ, Q_LORA}; pg8::StaticOrder S; S.init(M, NQ, F.G, (int)blockIdx.x);
          pg8::EpiQRope E{(bf16*)(ws + WS_QBUF), NQ, (const float*)(ws + WS_CS), 4096};
          pg8::gemm_phase<pg8::EpiQRope, pg8::StaticOrder, true, true>(F.lds + RING_OFF, g, S, E); }
        __syncthreads();
        { pg8::Gemm g{(const bf16*)(ws + WS_CKVN), (const bf16*)(ws + WS_WKVB), M, NKV, KV_LORA}; pg8::StaticOrder S; S.init(M, NKV, F.G, (int)blockIdx.x);
          pg8::EpiBf16<0> E{(bf16*)(ws + WS_KVBUF), NKV, nullptr, 0, 0, 1.f};
          pg8::gemm_phase<pg8::EpiBf16<0>, pg8::StaticOrder, true, true>(F.lds + RING_OFF, g, S, E); }
    } SEAM(9);
    if (IN(10)) { mla_phase(F); } SEAM(10);
    if (IN(11)) {
        pg8::Gemm g{G, (const bf16*)(ws + WS_WO1), M, DM, DM}; pg8::StaticOrder S; S.init(M, DM, F.G, (int)blockIdx.x);
        pg8::EpiResGate E{F.out, F.out, DM, mod + BATCH * 3 * DM + 2 * DM, 3 * DM, SEQ};
        pg8::gemm_phase<pg8::EpiResGate, pg8::StaticOrder, true, true>(F.lds + RING_OFF, g, S, E);
    } SEAM(11);
    if (IN(12)) { final_rows(F); }
#undef IN
#undef SEAM
}

extern "C" void kernel_launch(void* const* d_in, const int* in_sizes, int n_in, void* d_out, int out_size, void* d_ws, size_t ws_size, hipStream_t stream) {
    static int grid = 0;
    if (grid == 0) {
        if (n_in != 17 || in_sizes[0] != M * DM || out_size != M * DM || ws_size < WS_END) { fprintf(stderr, "kernel_launch: unexpected shapes (n_in %d, in0 %d, out %d, ws %zu, need %zu); nothing launched\n", n_in, n_in > 0 ? in_sizes[0] : -1, out_size, ws_size, (size_t)WS_END); grid = -1; return; }
        int dev = 0, cus = 0, per_cu = 0;
        if (hipGetDevice(&dev) != hipSuccess || hipDeviceGetAttribute(&cus, hipDeviceAttributeMultiprocessorCount, dev) != hipSuccess) { grid = -1; return; }
        if (hipFuncSetAttribute((const void*)fwd_kernel, hipFuncAttributeMaxDynamicSharedMemorySize, LDS_BYTES) != hipSuccess) { fprintf(stderr, "kernel_launch: hipFuncSetAttribute failed\n"); grid = -1; return; }
        if (hipOccupancyMaxActiveBlocksPerMultiprocessor(&per_cu, (const void*)fwd_kernel, NWAVES * 64, LDS_BYTES) != hipSuccess || per_cu < 1) { fprintf(stderr, "kernel_launch: occupancy query says %d\n", per_cu); }
        (void)hipGetLastError();
        grid = cus;
    }
    if (grid < 0) return;
    if (hipMemsetAsync((char*)d_ws + WS_CTL, 0, CTL_ZERO_BYTES, stream) != hipSuccess) return;
    Args a{};
    for (int i = 0; i < 17; ++i) a.in[i] = d_in[i];
    a.out = (float*)d_out; a.ws = (unsigned char*)d_ws;
#if MK_PER_PHASE
    for (int p = 0; p < N_PHASES; ++p) { a.ph_lo = p; a.ph_hi = p + 1; hipLaunchKernelGGL(fwd_kernel, dim3(grid), dim3(NWAVES * 64), LDS_BYTES, stream, a); }
#else
    a.ph_lo = 0; a.ph_hi = N_PHASES;
    hipLaunchKernelGGL(fwd_kernel, dim3(grid), dim3(NWAVES * 64), LDS_BYTES, stream, a);
#endif
    const hipError_t le = hipPeekAtLastError();
    if (le != hipSuccess) fprintf(stderr, "kernel_launch: launch failed: %s\n", hipGetErrorName(le));
}
```

```cpp
#include <hip/hip_runtime.h>

#include <cstdio>
#include <cstdint>
#include <cmath>
namespace pg8 {
#define PG8_LAS __attribute__((address_space(3)))
typedef unsigned short bf16_t;
typedef short bf16x8 __attribute__((ext_vector_type(8)));
typedef float f32x4 __attribute__((ext_vector_type(4)));
typedef unsigned u32x4 __attribute__((ext_vector_type(4)));
constexpr int BM = 256, BK = 64, HALF = 128, HTB = HALF * BK * 2  , STAGE_BYTES = 8 * HTB, NXCD = 8, WGM = 8;

__host__ __device__ __forceinline__ int lds_byte(int r, int c) { const int st = (r >> 4) * 2 + (c >> 5), rr = r & 15, cc = c & 31, ob = rr * 64 + cc * 2; return st * 1024 + (ob ^ (((ob >> 9) & 1) << 5)); }
__host__ __device__ __forceinline__ void stage_rc(int b, int& R, int& C) { const int st = b / 1024, sb = b % 1024, swz = sb ^ (((sb >> 9) & 1) << 5); R = (st >> 1) * 16 + swz / 64; C = (st & 1) * 32 + (swz % 64) / 2; }
__host__ __device__ __forceinline__ int perm32(int rho) { const int n = rho >> 4, i = rho & 15; return 8 * (i >> 2) + 4 * n + (i & 3); }

struct Unit { int pm, pn; };
struct Gemm { const bf16_t* A; const bf16_t* Bt; int M, N, K; };

struct StaticOrder {
    int nM, nN, nwg, G, c;
    __host__ __device__ void init(int M, int N, int G_, int c_) { nM = M / BM; nN = N / BM; nwg = nM * nN; G = G_; c = c_; }
    __host__ __device__ bool next(int i, Unit& u) const {
        const long L = (long)i * G + c; if (L >= nwg) return false;
        int wgid = (int)L; { const int q = nwg / NXCD, r = nwg % NXCD, xcd = wgid % NXCD, off = wgid / NXCD; wgid = (xcd < r ? xcd * (q + 1) : r * (q + 1) + (xcd - r) * q) + off; }
        const int nig = WGM * nN, gid = wgid / nig, fm = gid * WGM, gsz = (nM - fm) < WGM ? (nM - fm) : WGM;
        u.pm = fm + ((wgid % nig) % gsz); u.pn = (wgid % nig) / gsz; return true;
    }
    __device__ __forceinline__ void a_ready(const Unit&) const {}
    __device__ __forceinline__ void done(const Unit&) const {}
};

__device__ __forceinline__ unsigned cvt_pk_bf16(float lo, float hi) { unsigned r; asm volatile("v_cvt_pk_bf16_f32 %0, %1, %2" : "=v"(r) : "v"(lo), "v"(hi)); return r; }
typedef float f32x2 __attribute__((ext_vector_type(2)));
__device__ __forceinline__ f32x2 gelu_pk(f32x2 v) {
    const f32x2 av = __builtin_elementwise_abs(v), d = av * 0.2316418882f + 1.0f;
    f32x2 t; t.x = __builtin_amdgcn_rcpf(d.x); t.y = __builtin_amdgcn_rcpf(d.y);
    f32x2 q = t * 0.5307027145f + (-0.7265760135f); q = q * t + 0.7107068705f; q = q * t + (-0.142248368f); q = q * t + 0.127414796f; q = q * t;
    const f32x2 s = (v * v) * (-0.72134752044f);
    f32x2 e; e.x = __builtin_amdgcn_exp2f(s.x); e.y = __builtin_amdgcn_exp2f(s.y);
    const f32x2 m = v * (q * e), r = v - m;
    f32x2 o; o.x = v.x < 0.f ? m.x : r.x; o.y = v.y < 0.f ? m.y : r.y; return o;
}

template <int ACT  > struct EpiBf16 {
    static constexpr bool PERM = true, AFTER_DRAIN = false; static_assert(ACT == 0 || ACT == 1, "EpiBf16: ACT is 0 (none) or 1 (gelu_pk)");
    bf16_t* O; int ldc; const float* bias; int split_cols; size_t split_stride; float scale0;
    __device__ __forceinline__ void operator()(const f32x4 (&acc)[2][2][4][2], const Unit& u, int wr, int wc, int fr, int fq) const {
        const int row0 = u.pm * BM + wr * 64 + fr; int colt = u.pn * BM; bf16_t* base = O;
        float sc = 1.f; if (split_cols) { const int t = colt / split_cols; base += (size_t)t * split_stride; colt -= t * split_cols; if (t == 0) sc = scale0; }
        const int col0 = colt + wc * 32 + 8 * fq, bcol0 = u.pn * BM + wc * 32 + 8 * fq;
        f32x4 bv[2][2];
#pragma unroll
        for (int bj = 0; bj < 2; ++bj)
#pragma unroll
            for (int n = 0; n < 2; ++n) bv[bj][n] = bias ? *(const f32x4*)(bias + bcol0 + bj * HALF + 4 * n) : (f32x4){0.f, 0.f, 0.f, 0.f};
#pragma unroll
        for (int ai = 0; ai < 2; ++ai)
#pragma unroll
            for (int m = 0; m < 4; ++m) { bf16_t* rowp = base + (size_t)(row0 + ai * HALF + m * 16) * ldc + col0;
#pragma unroll
                for (int bj = 0; bj < 2; ++bj) { f32x4 v0 = acc[ai][bj][m][0] + bv[bj][0], v1 = acc[ai][bj][m][1] + bv[bj][1];
                    if (ACT == 1) { f32x2 a = gelu_pk((f32x2){v0[0], v0[1]}), b = gelu_pk((f32x2){v0[2], v0[3]}), c = gelu_pk((f32x2){v1[0], v1[1]}), d = gelu_pk((f32x2){v1[2], v1[3]});
                        v0 = (f32x4){a.x, a.y, b.x, b.y}; v1 = (f32x4){c.x, c.y, d.x, d.y}; }
                    v0 = v0 * sc; v1 = v1 * sc; u32x4 w; w.x = cvt_pk_bf16(v0[0], v0[1]); w.y = cvt_pk_bf16(v0[2], v0[3]); w.z = cvt_pk_bf16(v1[0], v1[1]); w.w = cvt_pk_bf16(v1[2], v1[3]);
                    *(u32x4*)(rowp + bj * HALF) = w; } }
    }
};
struct EpiQRope {
    static constexpr bool PERM = true, AFTER_DRAIN = false;
    bf16_t* O; int ldc; const float* cs; int rope_col0; float qmul;
    __device__ __forceinline__ void operator()(const f32x4 (&acc)[2][2][4][2], const Unit& u, int wr, int wc, int fr, int fq) const {
        const int row0 = u.pm * BM + wr * 64 + fr; const int colt = u.pn * BM;
        const int col0 = colt + wc * 32 + 8 * fq;
        const bool rope = colt >= rope_col0;
        const int j0 = ((wc & 1) * 32 + 8 * fq) >> 1;
#pragma unroll
        for (int ai = 0; ai < 2; ++ai)
#pragma unroll
            for (int m = 0; m < 4; ++m) { const int row = row0 + ai * HALF + m * 16; bf16_t* rowp = O + (size_t)row * ldc + col0;
                f32x4 c = (f32x4){1.f, 1.f, 1.f, 1.f}, s = (f32x4){0.f, 0.f, 0.f, 0.f};
                if (rope) { c = *(const f32x4*)(cs + (size_t)row * 64 + j0); s = *(const f32x4*)(cs + (size_t)row * 64 + 32 + j0); }
                c *= qmul; s *= qmul;
#pragma unroll
                for (int bj = 0; bj < 2; ++bj) { const f32x4 v0 = acc[ai][bj][m][0], v1 = acc[ai][bj][m][1];
                    u32x4 w;
                    w.x = cvt_pk_bf16(v0[0] * c[0] - v0[1] * s[0], v0[0] * s[0] + v0[1] * c[0]);
                    w.y = cvt_pk_bf16(v0[2] * c[1] - v0[3] * s[1], v0[2] * s[1] + v0[3] * c[1]);
                    w.z = cvt_pk_bf16(v1[0] * c[2] - v1[1] * s[2], v1[0] * s[2] + v1[1] * c[2]);
                    w.w = cvt_pk_bf16(v1[2] * c[3] - v1[3] * s[3], v1[2] * s[3] + v1[3] * c[3]);
                    *(u32x4*)(rowp + bj * HALF) = w; } }
    }
};
struct EpiResGate {
    static constexpr bool PERM = false, AFTER_DRAIN = false;
    const float* base; float* out; int ldc; const float* gate; int gate_stride; int rows_per_batch;
    __device__ __forceinline__ void operator()(const f32x4 (&acc)[2][2][4][2], const Unit& u, int wr, int wc, int fr, int fq) const {
        const int col0 = u.pn * BM + wc * 32 + 4 * fq; const int b = (u.pm * BM) / rows_per_batch;
        f32x4 gv[2][2];
#pragma unroll
        for (int bj = 0; bj < 2; ++bj)
#pragma unroll
            for (int n = 0; n < 2; ++n) gv[bj][n] = *(const f32x4*)(gate + (size_t)b * gate_stride + col0 + bj * HALF + n * 16);
#pragma unroll
        for (int ai = 0; ai < 2; ++ai)
#pragma unroll
            for (int m = 0; m < 4; ++m) { const size_t off = (size_t)(u.pm * BM + ai * HALF + wr * 64 + m * 16 + fr) * ldc + col0;
#pragma unroll
                for (int bj = 0; bj < 2; ++bj)
#pragma unroll
                    for (int n = 0; n < 2; ++n) { const f32x4 bs = *(const f32x4*)(base + off + bj * HALF + n * 16);
                        *(f32x4*)(out + off + bj * HALF + n * 16) = bs + gv[bj][n] * acc[ai][bj][m][n]; }
                if (m & 1) asm volatile("" ::: "memory"); }
    }
};

struct EpiBf16Nrm {
    static constexpr bool PERM = true, AFTER_DRAIN = false;
    bf16_t* O; int ldc; unsigned* nq; unsigned* nk; int q_pn0, k_pn0, rows_per_batch;
    __device__ __forceinline__ void operator()(const f32x4 (&acc)[2][2][4][2], const Unit& u, int wr, int wc, int fr, int fq) const {
        const int row0 = u.pm * BM + wr * 64 + fr; const int col0 = u.pn * BM + wc * 32 + 8 * fq;
#pragma unroll
        for (int ai = 0; ai < 2; ++ai)
#pragma unroll
            for (int m = 0; m < 4; ++m) { bf16_t* rowp = O + (size_t)(row0 + ai * HALF + m * 16) * ldc + col0;
#pragma unroll
                for (int bj = 0; bj < 2; ++bj) { const f32x4 v0 = acc[ai][bj][m][0], v1 = acc[ai][bj][m][1];
                    u32x4 w; w.x = cvt_pk_bf16(v0[0], v0[1]); w.y = cvt_pk_bf16(v0[2], v0[3]); w.z = cvt_pk_bf16(v1[0], v1[1]); w.w = cvt_pk_bf16(v1[2], v1[3]);
                    *(u32x4*)(rowp + bj * HALF) = w; } }
        unsigned* dst = nullptr; int h0 = 0;
        if (u.pn >= q_pn0 && u.pn < q_pn0 + 8) { dst = nq; h0 = (u.pn - q_pn0) * 2; } else if (u.pn >= k_pn0 && u.pn < k_pn0 + 8) { dst = nk; h0 = (u.pn - k_pn0) * 2; }
        if (dst) {
            const int rt = u.pm * BM + wr * 64, b = rt / rows_per_batch;
#pragma unroll
            for (int ai = 0; ai < 2; ++ai)
#pragma unroll
                for (int bj = 0; bj < 2; ++bj) { float mx = 0.f;
#pragma unroll
                    for (int m = 0; m < 4; ++m) { const f32x4 a = acc[ai][bj][m][0], c = acc[ai][bj][m][1];
                        float s = (a[0] * a[0] + a[1] * a[1]) + (a[2] * a[2] + a[3] * a[3]) + (c[0] * c[0] + c[1] * c[1]) + (c[2] * c[2] + c[3] * c[3]);
                        s += __shfl_xor(s, 16); s += __shfl_xor(s, 32); mx = fmaxf(mx, s); }
                    mx = fmaxf(mx, __shfl_xor(mx, 1)); mx = fmaxf(mx, __shfl_xor(mx, 2)); mx = fmaxf(mx, __shfl_xor(mx, 4)); mx = fmaxf(mx, __shfl_xor(mx, 8));
                    if (fr == 0 && fq == 0) { const int t64 = ((rt + ai * HALF) % rows_per_batch) / 64;
                        atomicMax(dst + (((size_t)(b * 16 + h0 + bj)) * 128 + t64) * 4 + wc, __float_as_uint(mx)); } }
        }
    }
};

struct EpiGateBf16 {
    static constexpr bool PERM = true, AFTER_DRAIN = false;
    bf16_t* O; int ldc; const float* gate; int gate_stride; int rows_per_batch;
    __device__ __forceinline__ void operator()(const f32x4 (&acc)[2][2][4][2], const Unit& u, int wr, int wc, int fr, int fq) const {
        const int row0 = u.pm * BM + wr * 64 + fr; const int col0 = u.pn * BM + wc * 32 + 8 * fq; const int b = (u.pm * BM) / rows_per_batch;
        f32x4 gv[2][2];
#pragma unroll
        for (int bj = 0; bj < 2; ++bj)
#pragma unroll
            for (int n = 0; n < 2; ++n) gv[bj][n] = *(const f32x4*)(gate + (size_t)b * gate_stride + col0 + bj * HALF + 4 * n);
#pragma unroll
        for (int ai = 0; ai < 2; ++ai)
#pragma unroll
            for (int m = 0; m < 4; ++m) { bf16_t* rowp = O + (size_t)(row0 + ai * HALF + m * 16) * ldc + col0;
#pragma unroll
                for (int bj = 0; bj < 2; ++bj) { const f32x4 v0 = acc[ai][bj][m][0] * gv[bj][0], v1 = acc[ai][bj][m][1] * gv[bj][1];
                    u32x4 w; w.x = cvt_pk_bf16(v0[0], v0[1]); w.y = cvt_pk_bf16(v0[2], v0[3]); w.z = cvt_pk_bf16(v1[0], v1[1]); w.w = cvt_pk_bf16(v1[2], v1[3]);
                    *(u32x4*)(rowp + bj * HALF) = w; } }
    }
};

template <class Epi, class Sched, bool ALIGN_EPI = false, bool SP2 = false>
__device__ __forceinline__ void gemm_phase(PG8_LAS unsigned char* lds, const Gemm g, const Sched& S, const Epi& E) {
    const int tid = threadIdx.x, wid = __builtin_amdgcn_readfirstlane(tid >> 6), lane = tid & 63, wr = wid >> 2, wc = wid & 3, fr = lane & 15, fq = lane >> 4;
    const int K = g.K, nt = K / BK;
    unsigned voffA[2], voffB[2];
#pragma unroll
    for (int i = 0; i < 2; ++i) { int R, C; stage_rc(tid * 16 + i * 8192, R, C); const int Rb = Epi::PERM ? ((R & ~31) + perm32(R & 31)) : R;
        voffA[i] = (unsigned)(R * K + C) * 2u; voffB[i] = (unsigned)(Rb * K + C) * 2u; }
    const size_t kstep = (size_t)(BK * 2);
    const size_t hstep = (size_t)HALF * K * 2;
    const size_t tstep = 2 * hstep;
    const unsigned ldsw = (unsigned)wid * 1024u;
    const int aoff = lds_byte(wr * 64 + fr, fq * 8), boff = lds_byte(wc * 32 + fr, fq * 8);
#define PG8_SA(b, h) (((b) * 2 + (h)) * HTB)
#define PG8_SB(b, h) ((4 + (b) * 2 + (h)) * HTB)
#define PG8_STAGE(bufoff, gbase, voff) do { _Pragma("unroll") for (int _i = 0; _i < 2; ++_i) \
        __builtin_amdgcn_global_load_lds((const unsigned*)((const char*)(gbase) + (voff)[_i]), (PG8_LAS unsigned*)(lds + (bufoff) + ldsw + _i * 8192), 16, 0, 0); } while (0)
#define PG8_LDA(dst, b, h) do { _Pragma("unroll") for (int m = 0; m < 4; ++m) _Pragma("unroll") for (int k = 0; k < 2; ++k) dst[m][k] = *(const PG8_LAS bf16x8*)(lds + PG8_SA(b, h) + aoff + m * 2048 + k * 1024); } while (0)
#define PG8_LDB(dst, b, h) do { _Pragma("unroll") for (int n = 0; n < 2; ++n) _Pragma("unroll") for (int k = 0; k < 2; ++k) dst[n][k] = *(const PG8_LAS bf16x8*)(lds + PG8_SB(b, h) + boff + n * 2048 + k * 1024); } while (0)
#define PG8_MMA(ai, bj, At, Bt) do { __builtin_amdgcn_s_setprio(1); _Pragma("unroll") for (int m = 0; m < 4; ++m) _Pragma("unroll") for (int n = 0; n < 2; ++n) _Pragma("unroll") for (int k = 0; k < 2; ++k) \
        acc[ai][bj][m][n] = __builtin_amdgcn_mfma_f32_16x16x32_bf16(Bt[n][k], At[m][k], acc[ai][bj][m][n], 0, 0, 0); __builtin_amdgcn_s_setprio(0); } while (0)
#define PG8_WAIT_V(n) asm volatile("s_waitcnt vmcnt(" #n ")" ::: "memory")
#define PG8_WAIT_L(n) asm volatile("s_waitcnt lgkmcnt(" #n ")" ::: "memory")
#define PG8_BAR __builtin_amdgcn_s_barrier()
#define PG8_SCHED __builtin_amdgcn_sched_barrier(0)
    Unit cur, nxt; int ui = 0;
    if (!S.next(0, cur)) return;
    f32x4 acc[2][2][4][2];
#pragma unroll
    for (int a = 0; a < 2; ++a)
#pragma unroll
        for (int b = 0; b < 2; ++b)
#pragma unroll
            for (int m = 0; m < 4; ++m)
#pragma unroll
                for (int n = 0; n < 2; ++n) acc[a][b][m][n] = (f32x4){0.f, 0.f, 0.f, 0.f};
    bf16x8 At[4][2], B0[2][2], B1[2][2];
    const char* cA = (const char*)g.A + (size_t)cur.pm * tstep; const char* cB = (const char*)g.Bt + (size_t)cur.pn * tstep;
    S.a_ready(cur);
    if constexpr (SP2) {
        PG8_STAGE(PG8_SB(0, 0), cB, voffB); PG8_STAGE(PG8_SB(0, 1), cB + hstep, voffB); PG8_STAGE(PG8_SA(0, 0), cA, voffA); PG8_STAGE(PG8_SA(0, 1), cA + hstep, voffA);
        if (wr == 1) PG8_BAR;
        PG8_WAIT_V(2); PG8_BAR;
        PG8_STAGE(PG8_SB(1, 0), cB + kstep, voffB); PG8_STAGE(PG8_SA(1, 0), cA + kstep, voffA); PG8_STAGE(PG8_SB(1, 1), cB + hstep + kstep, voffB);
        PG8_WAIT_V(6); PG8_BAR;
    } else {
        PG8_STAGE(PG8_SB(0, 0), cB, voffB); PG8_STAGE(PG8_SA(0, 0), cA, voffA); PG8_STAGE(PG8_SB(0, 1), cB + hstep, voffB); PG8_STAGE(PG8_SA(0, 1), cA + hstep, voffA);
        if (wr == 1) PG8_BAR;
        PG8_WAIT_V(4); PG8_BAR;
        PG8_STAGE(PG8_SB(1, 0), cB + kstep, voffB); PG8_STAGE(PG8_SA(1, 0), cA + kstep, voffA); PG8_STAGE(PG8_SB(1, 1), cB + hstep + kstep, voffB);
        PG8_WAIT_V(6); PG8_BAR;
    }
    for (;;) {
        const bool has_next = S.next(ui + 1, nxt);
        const char* nA = has_next ? (const char*)g.A + (size_t)nxt.pm * tstep : cA; const char* nB = has_next ? (const char*)g.Bt + (size_t)nxt.pn * tstep : cB;
        for (int t = 0; t < nt; t += 2) {
            const bool last = (t == nt - 2);
            const char* a1 = cA + (size_t)(t + 1) * kstep;
            const char* a2 = last ? nA : cA + (size_t)(t + 2) * kstep; const char* b2 = last ? nB : cB + (size_t)(t + 2) * kstep;
            const char* a3 = a2 + kstep; const char* b3 = b2 + kstep;
            if (last && has_next) S.a_ready(nxt);
            if constexpr (SP2) {
            PG8_LDB(B0, 0, 0); PG8_LDB(B1, 0, 1); PG8_SCHED; PG8_LDA(At, 0, 0); PG8_STAGE(PG8_SA(1, 1), a1 + hstep, voffA);
            PG8_WAIT_V(8); PG8_WAIT_L(0); PG8_BAR; PG8_MMA(0, 0, At, B0); PG8_MMA(0, 1, At, B1); PG8_BAR; PG8_SCHED;
            PG8_LDA(At, 0, 1); PG8_STAGE(PG8_SB(0, 0), b2, voffB); PG8_STAGE(PG8_SB(0, 1), b2 + hstep, voffB); PG8_STAGE(PG8_SA(0, 0), a2, voffA);
            PG8_WAIT_V(8); PG8_WAIT_L(0); PG8_BAR; PG8_MMA(1, 0, At, B0); PG8_MMA(1, 1, At, B1); PG8_BAR; PG8_SCHED;
            PG8_LDB(B0, 1, 0); PG8_LDB(B1, 1, 1); PG8_SCHED; PG8_LDA(At, 1, 0); PG8_STAGE(PG8_SA(0, 1), a2 + hstep, voffA);
            PG8_WAIT_V(8); PG8_WAIT_L(0); PG8_BAR; PG8_MMA(0, 0, At, B0); PG8_MMA(0, 1, At, B1); PG8_BAR; PG8_SCHED;
            PG8_LDA(At, 1, 1); PG8_STAGE(PG8_SB(1, 0), b3, voffB); PG8_STAGE(PG8_SB(1, 1), b3 + hstep, voffB); PG8_STAGE(PG8_SA(1, 0), a3, voffA);
            PG8_WAIT_V(8); PG8_WAIT_L(0); PG8_BAR; PG8_MMA(1, 0, At, B0); PG8_MMA(1, 1, At, B1); PG8_BAR; PG8_SCHED;
            } else {
            PG8_LDB(B0, 0, 0); PG8_SCHED; PG8_LDA(At, 0, 0); PG8_STAGE(PG8_SA(1, 1), a1 + hstep, voffA);
            PG8_WAIT_L(8); PG8_BAR; PG8_WAIT_L(0); PG8_MMA(0, 0, At, B0); PG8_BAR; PG8_SCHED;
            PG8_LDB(B1, 0, 1); PG8_STAGE(PG8_SB(0, 0), b2, voffB);
            PG8_BAR; PG8_WAIT_L(0); PG8_MMA(0, 1, At, B1); PG8_BAR;
            PG8_LDA(At, 0, 1); PG8_STAGE(PG8_SA(0, 0), a2, voffA);
            PG8_BAR; PG8_WAIT_L(0); PG8_MMA(1, 0, At, B0); PG8_BAR; PG8_SCHED;
            PG8_STAGE(PG8_SB(0, 1), b2 + hstep, voffB);
            PG8_WAIT_V(6); PG8_BAR; PG8_MMA(1, 1, At, B1); PG8_BAR;
            PG8_LDB(B0, 1, 0); PG8_SCHED; PG8_LDA(At, 1, 0); PG8_STAGE(PG8_SA(0, 1), a2 + hstep, voffA);
            PG8_WAIT_L(8); PG8_BAR; PG8_WAIT_L(0); PG8_MMA(0, 0, At, B0); PG8_BAR; PG8_SCHED;
            PG8_LDB(B1, 1, 1); PG8_STAGE(PG8_SB(1, 0), b3, voffB);
            PG8_BAR; PG8_WAIT_L(0); PG8_MMA(0, 1, At, B1); PG8_BAR;
            PG8_LDA(At, 1, 1); PG8_STAGE(PG8_SA(1, 0), a3, voffA);
            PG8_BAR; PG8_WAIT_L(0); PG8_MMA(1, 0, At, B0); PG8_BAR; PG8_SCHED;
            PG8_STAGE(PG8_SB(1, 1), b3 + hstep, voffB);
            PG8_WAIT_V(6); PG8_BAR; PG8_MMA(1, 1, At, B1); PG8_BAR;
            }
        }
        if constexpr (ALIGN_EPI) { if (wr == 0) PG8_BAR; }
        if constexpr (!Epi::AFTER_DRAIN) { E(acc, cur, wr, wc, fr, fq); S.done(cur); }
        if (!has_next) break;
#pragma unroll
        for (int a = 0; a < 2; ++a)
#pragma unroll
            for (int b = 0; b < 2; ++b)
#pragma unroll
                for (int m = 0; m < 4; ++m)
#pragma unroll
                    for (int n = 0; n < 2; ++n) acc[a][b][m][n] = (f32x4){0.f, 0.f, 0.f, 0.f};
        cur = nxt; cA = nA; cB = nB; ++ui;
        if constexpr (ALIGN_EPI) { if (wr == 1) PG8_BAR; }
    }
    PG8_WAIT_V(0);
    if constexpr (!ALIGN_EPI) { if (wr == 0) PG8_BAR; }
    PG8_BAR;
    if constexpr (Epi::AFTER_DRAIN) { E.fused(acc, cur, wr, wc, fr, fq, lds, wid, lane); S.done(cur); }
#undef PG8_SA
#undef PG8_SB
#undef PG8_STAGE
#undef PG8_LDA
#undef PG8_LDB
#undef PG8_MMA
#undef PG8_WAIT_V
#undef PG8_WAIT_L
#undef PG8_BAR
#undef PG8_SCHED
}
}
namespace at {
typedef unsigned short bf16_t;
typedef short bf16x8 __attribute__((ext_vector_type(8)));
typedef short s16x4 __attribute__((ext_vector_type(4)));
typedef float f32x16 __attribute__((ext_vector_type(16)));
typedef float f32x4 __attribute__((ext_vector_type(4)));
typedef unsigned u32x4 __attribute__((ext_vector_type(4)));
enum { K_DIL = 0, K_FOX = 1, K_MLA = 2 };
constexpr int NW = 8, QBLK = 32, KVBLK = 64, QB = NW * QBLK, D = 128;
constexpr int SHM_V = KVBLK * D * 2, K_ROW = 272, SHM_K = KVBLK * K_ROW, KR_ROW = 144, SHM_KR = KVBLK * KR_ROW;
constexpr int OFF_V = 0, OFF_K = 2 * SHM_V, OFF_KR = OFF_K + 2 * SHM_K, OFF_WS = OFF_KR + 2 * SHM_KR, OFF_BIAS = OFF_WS + NW * 64 * 4, BIAS_BYTES = 32768, LDS_BYTES = OFF_BIAS + BIAS_BYTES;
constexpr int DIL_W = 129, TBL_N = 640, TBL_TOP = 383;
template <int KIND> struct Cfg;
template <> struct Cfg<K_DIL> { static constexpr float SCALE = 0.08838834764831845f; static constexpr int NQ = 8; static constexpr bool SK = true; };
template <> struct Cfg<K_FOX> { static constexpr float SCALE = 0.08838834764831845f; static constexpr int NQ = 8; static constexpr bool SK = false; };
template <> struct Cfg<K_MLA> { static constexpr float SCALE = 0.07216878364870322f; static constexpr int NQ = 12; static constexpr bool SK = false; };
constexpr float THR = 8.f;

#define KSWZ(row, colB) ((row) * K_ROW + (colB))
#define SBAR() __builtin_amdgcn_sched_barrier(0)
__device__ __forceinline__ int v_st(int k, int c) { const int kk = (k & ~0xC) | ((k & 4) << 1) | ((k & 8) >> 1); return ((kk >> 3) * 4 + (c >> 5)) * 512 + ((kk & 7) * 32 + (c & 31)) * 2; }
__device__ __forceinline__ int v_rd_base(int lane) { return ((lane & 3) << 3) | (((lane >> 2) & 3) << 6) | (((lane >> 4) & 1) << 5) | (((lane >> 5) & 1) << 8); }
constexpr int v_rd_off(int d0, int ks, int half) { return d0 * 512 + ks * 4096 + half * 2048; }
__device__ __forceinline__ int crow(int r, int hi) { return (r & 3) + 8 * (r >> 2) + 4 * hi; }
typedef float f32x2_t __attribute__((ext_vector_type(2))); typedef __bf16 bf16x2_t __attribute__((ext_vector_type(2)));
__device__ __forceinline__ unsigned cvtpk(float lo, float hi) { f32x2_t v = {lo, hi}; bf16x2_t b = __builtin_convertvector(v, bf16x2_t); return __builtin_bit_cast(unsigned, b); }
__device__ __forceinline__ bf16x8 ld8(const bf16_t* p) { return *reinterpret_cast<const bf16x8*>(p); }
__device__ __forceinline__ float bf2f(unsigned short h) { return __uint_as_float(((unsigned)h) << 16); }
__device__ __forceinline__ void mask_tile(f32x16& p0, f32x16& p1, int dq, unsigned W) {
    const float NEG = -__builtin_inff();
#pragma unroll
    for (int r = 0; r < 16; ++r) {
        const int c = (r & 3) + 8 * (r >> 2);
        if ((unsigned)(dq - c) >= W) p0[r] = NEG;
        if ((unsigned)(dq - c - 32) >= W) p1[r] = NEG;
    }
}
template <int KIND, bool NOEXP = false>
__device__ __forceinline__ void partialSM(f32x16& p0, f32x16& p1, float& m_reg, float& mn, float& alpha) {
    constexpr float SCALE = Cfg<KIND>::SCALE;
    float ma = p0[0], mb = p0[8], mc = p1[0], md = p1[8];
#pragma unroll
    for (int r = 1; r < 8; ++r) { ma = fmaxf(ma, p0[r]); mb = fmaxf(mb, p0[8 + r]); mc = fmaxf(mc, p1[r]); md = fmaxf(md, p1[8 + r]); }
    float pmax = fmaxf(fmaxf(ma, mb), fmaxf(mc, md));
    constexpr float C2 = 1.4426950408889634f * SCALE;
    if (__builtin_expect(__all((pmax - m_reg) * SCALE <= THR), 1)) { mn = m_reg; alpha = 1.f; }
    else { { auto rr = __builtin_amdgcn_permlane32_swap(__float_as_uint(pmax), __float_as_uint(pmax), false, false); pmax = fmaxf(__uint_as_float(rr[0]), __uint_as_float(rr[1])); }
           mn = fmaxf(m_reg, pmax); alpha = __builtin_amdgcn_exp2f((m_reg - mn) * C2); m_reg = mn; }
    const float mnL = -mn * C2;
    for (int r = 0; r < 16; ++r) p0[r] = fmaf(p0[r], C2, mnL); for (int r = 0; r < 16; ++r) p1[r] = fmaf(p1[r], C2, mnL);
    if constexpr (!NOEXP) { for (int r = 0; r < 16; ++r) p0[r] = __builtin_amdgcn_exp2f(p0[r]); }
}
template <bool NOEXP = false>
__device__ __forceinline__ void finishSM(f32x16& p0, f32x16& p1, bf16x8& pa0, bf16x8& pa1, bf16x8& pa2, bf16x8& pa3) {
    if constexpr (!NOEXP) { for (int r = 0; r < 16; ++r) p1[r] = __builtin_amdgcn_exp2f(p1[r]); }
#define PK4(P, B_, OUT) do { unsigned a0 = cvtpk(P[B_+0], P[B_+1]), a1 = cvtpk(P[B_+2], P[B_+3]);                          \
        unsigned b0 = cvtpk(P[B_+4], P[B_+5]), b1 = cvtpk(P[B_+6], P[B_+7]);                                             \
        auto r0 = __builtin_amdgcn_permlane32_swap(a0, b0, false, false); auto r1 = __builtin_amdgcn_permlane32_swap(a1, b1, false, false); \
        u32x4 w = {r0[0], r1[0], r0[1], r1[1]}; OUT = *reinterpret_cast<bf16x8*>(&w); } while (0)
    PK4(p0, 0, pa0); PK4(p0, 8, pa1); PK4(p1, 0, pa2); PK4(p1, 8, pa3);
#undef PK4
}
template <int KIND, int KB, bool NOROPE = false>
__device__ __forceinline__ void qkt(f32x16& p0, f32x16& p1, const char* lds, int r32, int hi, const bf16x8* qr, bool act, int bofs) {
    constexpr bool SK = Cfg<KIND>::SK;
    if (SK && !act) { const float NEG = -__builtin_inff();
#pragma unroll
        for (int r = 0; r < 16; ++r) { p0[r] = NEG; p1[r] = NEG; } return; }
    if constexpr (KIND == K_FOX) { const float* bp = reinterpret_cast<const float*>(lds + OFF_BIAS) + bofs;
#pragma unroll
        for (int g = 0; g < 4; ++g) { const f32x4 a = *reinterpret_cast<const f32x4*>(bp + 8 * g), b = *reinterpret_cast<const f32x4*>(bp + 32 + 8 * g);
            p0[4 * g] = a[0]; p0[4 * g + 1] = a[1]; p0[4 * g + 2] = a[2]; p0[4 * g + 3] = a[3]; p1[4 * g] = b[0]; p1[4 * g + 1] = b[1]; p1[4 * g + 2] = b[2]; p1[4 * g + 3] = b[3]; } }
    else if constexpr (KIND == K_DIL) { const float* bp = reinterpret_cast<const float*>(lds + OFF_BIAS) + bofs;
#pragma unroll
        for (int r = 0; r < 16; ++r) { const int c = (r & 3) + 8 * (r >> 2); p0[r] = bp[c]; p1[r] = bp[c + 32]; } }
    else { p0 = f32x16{}; p1 = f32x16{}; }
    const char* kbp = lds + OFF_K + KB * SHM_K + r32 * K_ROW + hi * 16;
#pragma unroll
    for (int d0 = 0; d0 < 8; ++d0) { const char* a = kbp + d0 * 32;
        bf16x8 b0 = *reinterpret_cast<const bf16x8*>(a);
        bf16x8 b1 = *reinterpret_cast<const bf16x8*>(a + 32 * K_ROW);
        p0 = __builtin_amdgcn_mfma_f32_32x32x16_bf16(b0, qr[d0], p0, 0, 0, 0);
        p1 = __builtin_amdgcn_mfma_f32_32x32x16_bf16(b1, qr[d0], p1, 0, 0, 0); }
    if constexpr (KIND == K_MLA && !NOROPE) {
        const char* krb = lds + OFF_KR + KB * SHM_KR + r32 * KR_ROW + hi * 16;
#pragma unroll
        for (int d0 = 0; d0 < 4; ++d0) { const char* a = krb + d0 * 32;
            bf16x8 b0 = *reinterpret_cast<const bf16x8*>(a);
            bf16x8 b1 = *reinterpret_cast<const bf16x8*>(a + 32 * KR_ROW);
            const bf16x8 qf = *reinterpret_cast<const bf16x8*>(lds + OFF_BIAS + bofs + d0 * 1024);
            p0 = __builtin_amdgcn_mfma_f32_32x32x16_bf16(b0, qf, p0, 0, 0, 0);
            p1 = __builtin_amdgcn_mfma_f32_32x32x16_bf16(b1, qf, p1, 0, 0, 0); } }
#define SGB(mask, n) __builtin_amdgcn_sched_group_barrier(mask, n, 0)
    constexpr int LA = 3;
    if constexpr (KIND == K_FOX) SGB(0x100, 8);
    SGB(0x100, 2 * LA);
#pragma unroll
    for (int i = 0; i < 8 - LA; ++i) { SGB(0x008, 2); SGB(0x100, 2); }
    if constexpr (KIND == K_MLA && !NOROPE) {
#pragma unroll
        for (int i = 0; i < 4; ++i) { SGB(0x008, 2); SGB(0x100, 3); }
    }
    SGB(0x008, 2 * LA);
#undef SGB
}
template <int VB, bool SK>
__device__ __forceinline__ void pv_tile(f32x16* o, f32x16& ol, int vb0, bf16x8 pa0, bf16x8 pa1, bf16x8 pa2, bf16x8 pa3, bool act) {
    if (SK && !act) return;
#define TRRD(dst, off) asm volatile("ds_read_b64_tr_b16 %0, %1 offset:%2" : "=&v"(dst) : "v"(vb0), "i"(off) : "memory")
#define PV_D0(d0) do { s16x4 l0, l1, l2, l3, h0, h1, h2, h3; constexpr int b_ = OFF_V + VB * SHM_V + v_rd_off(d0, 0, 0);   \
        TRRD(l0, b_); TRRD(h0, b_ + 2048); TRRD(l1, b_ + 4096); TRRD(h1, b_ + 6144); TRRD(l2, b_ + 8192); TRRD(h2, b_ + 10240); TRRD(l3, b_ + 12288); TRRD(h3, b_ + 14336); \
        asm volatile("s_waitcnt lgkmcnt(0)" ::: "memory"); SBAR();   \
        o[d0] = __builtin_amdgcn_mfma_f32_32x32x16_bf16(pa0, (bf16x8){l0[0], l0[1], l0[2], l0[3], h0[0], h0[1], h0[2], h0[3]}, o[d0], 0, 0, 0);   \
        o[d0] = __builtin_amdgcn_mfma_f32_32x32x16_bf16(pa1, (bf16x8){l1[0], l1[1], l1[2], l1[3], h1[0], h1[1], h1[2], h1[3]}, o[d0], 0, 0, 0);   \
        o[d0] = __builtin_amdgcn_mfma_f32_32x32x16_bf16(pa2, (bf16x8){l2[0], l2[1], l2[2], l2[3], h2[0], h2[1], h2[2], h2[3]}, o[d0], 0, 0, 0);   \
        o[d0] = __builtin_amdgcn_mfma_f32_32x32x16_bf16(pa3, (bf16x8){l3[0], l3[1], l3[2], l3[3], h3[0], h3[1], h3[2], h3[3]}, o[d0], 0, 0, 0); } while (0)
    PV_D0(0); PV_D0(1); PV_D0(2); PV_D0(3);
    { const bf16x8 ones = (bf16x8){0x3F80, 0x3F80, 0x3F80, 0x3F80, 0x3F80, 0x3F80, 0x3F80, 0x3F80};
      ol = __builtin_amdgcn_mfma_f32_32x32x16_bf16(pa0, ones, ol, 0, 0, 0); ol = __builtin_amdgcn_mfma_f32_32x32x16_bf16(pa1, ones, ol, 0, 0, 0);
      ol = __builtin_amdgcn_mfma_f32_32x32x16_bf16(pa2, ones, ol, 0, 0, 0); ol = __builtin_amdgcn_mfma_f32_32x32x16_bf16(pa3, ones, ol, 0, 0, 0); }
#undef PV_D0
#undef TRRD
}

struct Ref { const bf16_t* Q; const bf16_t* K; const bf16_t* V; const bf16_t* Qr; const bf16_t* Kr; int qs, ks; int P0; int dir; int jlo; bf16_t* O; int os; const bf16_t* Z; int zs; float* LSE; int ls; };
template <int KIND> struct Seam { bf16x8 qr[Cfg<KIND>::NQ]; bf16x8 st_v0, st_v1, st_k0, st_k1, st_kr; };
__device__ __forceinline__ int swa_jlo(int P0, int W) { const int lowk = P0 - W + 1; return lowk > 0 ? lowk / KVBLK : 0; }
#define VMW() asm volatile("s_waitcnt vmcnt(0)" ::: "memory")
#define VMWN(n) asm volatile("s_waitcnt vmcnt(%0)" :: "i"(n) : "memory")
#define SLOAD_K(R, k0, TO, TID) do { const bf16_t* kb_ = (R).K + (size_t)(k0) * (R).ks; S.st_k0 = ld8(kb_ + (TO)); S.st_k1 = ld8(kb_ + (size_t)32 * (R).ks + (TO));   \
                            if constexpr (KIND == K_MLA) S.st_kr = ld8((R).Kr + (size_t)(k0) * 64 + (TID) * 8); } while (0)
#define SLOAD_V(R, k0, TO) do { const bf16_t* vb_ = (R).V + (size_t)(k0) * (R).ks; S.st_v0 = ld8(vb_ + (TO)); S.st_v1 = ld8(vb_ + (size_t)32 * (R).ks + (TO)); } while (0)
#define SW_OFFS() int tw_ = tid; asm volatile("" : "+v"(tw_)); const int sr_ = tw_ >> 4, sc_ = (tw_ & 15) * 8; (void)sr_; (void)sc_
#define SWRITE_HK(bf) do { SW_OFFS(); const int kws_ = KSWZ(sr_, sc_ * 2); *(bf16x8*)(K_lds + (bf) * SHM_K + kws_) = S.st_k0; *(bf16x8*)(K_lds + (bf) * SHM_K + kws_ + 32 * K_ROW) = S.st_k1;                 \
                           if constexpr (KIND == K_MLA) *(bf16x8*)(KR_lds + (bf) * SHM_KR + (tw_ >> 3) * KR_ROW + (tw_ & 7) * 16) = S.st_kr; } while (0)
#define SWRITE_HV(bf) do { SW_OFFS(); *(bf16x8*)(V_lds + (bf) * SHM_V + v_st(sr_, sc_)) = S.st_v0; *(bf16x8*)(V_lds + (bf) * SHM_V + v_st(32 + sr_, sc_)) = S.st_v1; } while (0)
#define QLOAD(R, R32, HI) do { const bf16_t* qb_ = (R).Q + (size_t)(wid * QBLK) * (R).qs; const unsigned qo_ = (unsigned)((R32) * (R).qs + (HI) * 8);                             \
                      _Pragma("unroll") for (int d0 = 0; d0 < 8; ++d0) S.qr[d0] = ld8(qb_ + qo_ + d0 * 16); } while (0)
#define QLOAD_R(R, R32, HI) do { if constexpr (KIND == K_MLA) { const bf16_t* qb_ = (R).Qr + (size_t)(wid * QBLK) * (R).qs; const unsigned qo_ = (unsigned)((R32) * (R).qs + (HI) * 8);     \
                      _Pragma("unroll") for (int d0 = 0; d0 < 4; ++d0) S.qr[8 + d0] = ld8(qb_ + qo_ + d0 * 16); } } while (0)
#define BAR() do { asm volatile("s_waitcnt lgkmcnt(0)" ::: "memory"); __builtin_amdgcn_s_barrier(); asm volatile("" ::: "memory"); } while (0)
struct Blk { int a, b, c; };
#define LAUNDER_BLK(x) asm volatile("" : "+s"((x).a), "+s"((x).b), "+s"((x).c))
template <int KIND, class MK>
__device__ __forceinline__ void attn_prime(const Blk cb, const MK& mk, int W, char* lds, Seam<KIND>& S) {
    const int tid = threadIdx.x, wid = __builtin_amdgcn_readfirstlane(tid >> 6), lane = tid & 63, r32 = lane & 31, hi = lane >> 5;
    const int sr = tid >> 4, sc = (tid & 15) * 8;
    char* K_lds = lds + OFF_K; char* KR_lds = lds + OFF_KR; (void)KR_lds;
    Ref cur; mk(cb, cur);
    const int kb0 = cur.dir ? ((cur.P0 + QB - 1) / KVBLK) * KVBLK : (KIND == K_FOX ? cur.jlo : swa_jlo(cur.P0, W)) * KVBLK, kb1 = cur.dir ? kb0 - KVBLK : kb0 + KVBLK; const unsigned toff = (unsigned)(sr * cur.ks + sc);
    QLOAD(cur, r32, hi); QLOAD_R(cur, r32, hi);
    SLOAD_K(cur, kb0, toff, tid); VMW(); SWRITE_HK(0);
    SLOAD_K(cur, kb1, toff, tid); SLOAD_V(cur, kb0, toff);
    __syncthreads();
}
template <int KIND, int VAR = 0, class MK>
__device__ __forceinline__ void attn_block(const Blk cb, const Blk nb, const MK& mk, int skv, int W, char* lds, Seam<KIND>& S) {
    constexpr bool SK = Cfg<KIND>::SK; constexpr float SCALE = Cfg<KIND>::SCALE; constexpr int NQL = Cfg<KIND>::NQ;
    constexpr bool NOGATE = (VAR & 1) != 0, NOEXP = (VAR & 4) != 0, NOROPE = (VAR & 8) != 0, NOPV = (VAR & 16) != 0, NOSM = (VAR & 32) != 0, NOSTAGE = (VAR & 128) != 0, NOQK = (VAR & 256) != 0;
    const int tid = threadIdx.x, wid = __builtin_amdgcn_readfirstlane(tid >> 6), lane = tid & 63, r32 = lane & 31, hi = lane >> 5;
    const int grp = wid >> 2;
    Ref cur; mk(cb, cur);
    const int j_lo = KIND == K_FOX ? cur.jlo : swa_jlo(cur.P0, W);
    int j_hi = (cur.P0 + QB - 1) / KVBLK + 1; if (j_hi > skv / KVBLK) j_hi = skv / KVBLK;
    const int NT = j_hi - j_lo;
    const int qlo = cur.P0 + wid * QBLK, qm = qlo + r32 - 4 * hi;
    char* V_lds = lds + OFF_V; char* K_lds = lds + OFF_K; char* KR_lds = lds + OFF_KR; (void)KR_lds;
    float* ws = (float*)(lds + OFF_WS) + wid * 64; float* li_l = ws, * al_l = ws + 32;
    float m_reg = -1e30f; f32x16 o[4] = {}; f32x16 ol = {};
    const int sr = tid >> 4, sc = (tid & 15) * 8;
    const int vb0 = (int)(uintptr_t)V_lds + v_rd_base(lane);
    const unsigned toff = (unsigned)(sr * cur.ks + sc);
    int tq_ = tid; asm volatile("" : "+v"(tq_));
    const int qrofs = wid * 4096 + (tq_ & 63) * 16;
#define RESC(a) do { if (__any((a) < 1.f)) { if (hi == 0) al_l[r32] = (a); asm volatile("s_waitcnt lgkmcnt(0)" ::: "memory");              \
                     for (int r = 0; r < 16; ++r) { const float a_ = al_l[crow(r, hi)]; ol[r] *= a_; for (int d_ = 0; d_ < 4; ++d_) o[d_][r] *= a_; } } } while (0)
#define KBASE(t) ((cur.dir ? j_hi - 1 - (t) : j_lo + (t)) * KVBLK)
#define ACT(t) (KBASE(t) <= qlo + QBLK - 1 && KBASE(t) + KVBLK - 1 >= qlo - W + 1)
#define BOFS(t) (KIND == K_FOX ? KBASE(t) + 4 * hi : (KIND == K_DIL ? TBL_TOP - (qm - KBASE(t)) : qrofs))
#define MASKT(P0_, P1_, t) do { if constexpr (KIND != K_DIL) { const int kb_ = KBASE(t); if ((!SK || ACT(t)) && (kb_ + KVBLK - 1 > qlo || kb_ <= qlo + QBLK - 1 - W)) mask_tile(P0_, P1_, qm - kb_, (unsigned)W); } } while (0)
    f32x16 p0 = {}, p1 = {}; float mn, al; bf16x8 pa0 = {}, pa1 = {}, pa2 = {}, pa3 = {};
#define SLOT(i) do { if constexpr (NOSTAGE) break; VMW(); { SW_OFFS(); const int vst_ = v_st(sr_, sc_), kws_ = KSWZ(sr_, sc_ * 2);     \
                     if ((i) < NT) { *(bf16x8*)(V_lds + ((i) & 1) * SHM_V + vst_) = S.st_v0; *(bf16x8*)(V_lds + ((i) & 1) * SHM_V + vst_ + 8192) = S.st_v1; }                       \
                     if ((i) + 1 < NT) { *(bf16x8*)(K_lds + (((i) + 1) & 1) * SHM_K + kws_) = S.st_k0; *(bf16x8*)(K_lds + (((i) + 1) & 1) * SHM_K + kws_ + 32 * K_ROW) = S.st_k1;          \
                         if constexpr (KIND == K_MLA) *(bf16x8*)(KR_lds + (((i) + 1) & 1) * SHM_KR + (tw_ >> 3) * KR_ROW + (tw_ & 7) * 16) = S.st_kr; } } SBAR();                       \
                     if ((i) + 1 < NT) SLOAD_V(cur, KBASE((i) + 1), toff); if ((i) + 2 < NT) SLOAD_K(cur, KBASE((i) + 2), toff, tid); SBAR(); } while (0)
#define SMSEG(t) do { if constexpr (NOSM) break; SBAR(); MASKT(p0, p1, (t)); partialSM<KIND, NOEXP>(p0, p1, m_reg, mn, al); SBAR(); finishSM<NOEXP>(p0, p1, pa0, pa1, pa2, pa3); SBAR(); RESC(al); SBAR(); } while (0)
#define MSEG(t, KB, VB) do { SBAR(); if constexpr (!NOPV) { if ((t) > 0) pv_tile<VB, SK>(o, ol, vb0, pa0, pa1, pa2, pa3, ACT((t) - 1)); } SBAR();         \
                             if constexpr (!NOQK) qkt<KIND, KB, NOROPE>(p0, p1, lds, r32, hi, S.qr, ACT(t), BOFS(t)); SBAR(); } while (0)
#define STEP(t, KB, VB) do { MSEG(t, KB, VB); BAR(); SLOT((t) + grp); SMSEG(t); BAR(); } while (0)
    if constexpr (KIND == K_MLA) {
#pragma unroll
        for (int d0 = 0; d0 < 4; ++d0) *(bf16x8*)(lds + OFF_BIAS + qrofs + d0 * 1024) = S.qr[8 + d0]; }
    if (grp) { SLOT(0); BAR(); }
    int t = 0;
    for (; t + 1 < NT; t += 2) { STEP(t, 0, 1); STEP(t + 1, 1, 0); }
    if (t < NT) { STEP(t, 0, 1); }
    int tid_t = tid; asm volatile("" : "+v"(tid_t));
    Blk nb2 = nb; LAUNDER_BLK(nb2); Ref nxt; mk(nb2, nxt);
    const int kbn0 = nxt.dir ? ((nxt.P0 + QB - 1) / KVBLK) * KVBLK : (KIND == K_FOX ? nxt.jlo : swa_jlo(nxt.P0, W)) * KVBLK, kbn1 = nxt.dir ? kbn0 - KVBLK : kbn0 + KVBLK;
    const int r32t = tid_t & 31, hit = (tid_t >> 5) & 1; const unsigned toffn = (unsigned)((tid_t >> 4) * nxt.ks + (tid_t & 15) * 8);
    if constexpr (!NOPV) { if (((NT - 1) & 1) != 0) pv_tile<1, SK>(o, ol, vb0, pa0, pa1, pa2, pa3, ACT(NT - 1)); else pv_tile<0, SK>(o, ol, vb0, pa0, pa1, pa2, pa3, ACT(NT - 1)); }
    SBAR(); SLOAD_K(nxt, kbn0, toffn, tid_t); SBAR(); QLOAD(nxt, r32t, hit); QLOAD_R(nxt, r32t, hit); SBAR();
    BAR();
    VMWN(NQL); SWRITE_HK(0); SBAR(); SLOAD_K(nxt, kbn1, toffn, tid_t); SLOAD_V(nxt, kbn0, toffn); SBAR();
    BAR();
    if (grp == 0) BAR();
    Blk cb2 = cb; LAUNDER_BLK(cb2); Ref ce; mk(cb2, ce);
    if constexpr (KIND == K_DIL) {
        if (r32t == 0) {
#pragma unroll
            for (int r = 0; r < 16; ++r) li_l[crow(r, hit)] = ol[r]; }
        asm volatile("s_waitcnt lgkmcnt(0)" ::: "memory");
        if (hit == 0) ce.LSE[(size_t)(wid * QBLK + r32t) * ce.ls] = m_reg * SCALE + logf(li_l[r32t]); }
    float rli[16];
#pragma unroll
    for (int r = 0; r < 16; ++r) rli[r] = __builtin_amdgcn_rcpf(ol[r]);
    char* stg = lds + OFF_V + wid * 4096;
    const int srow = (tid_t >> 3) & 7, sch = tid_t & 7;
    bf16_t* Ow = ce.O + (size_t)(wid * QBLK) * ce.os; const unsigned ooff = (unsigned)(srow * ce.os + sch * 4);
    const bf16_t* Zw = ce.Z + (size_t)(wid * QBLK) * ce.zs; const unsigned zoff = (unsigned)(srow * ce.zs + sch * 4); (void)Zw; (void)zoff;
#pragma unroll
    for (int d0 = 0; d0 < 4; ++d0) {
#pragma unroll
        for (int r = 0; r < 16; ++r) *(float*)(stg + crow(r, hit) * 128 + r32t * 4) = o[d0][r] * rli[r];
        asm volatile("s_waitcnt lgkmcnt(0)" ::: "memory");
#pragma unroll
        for (int i = 0; i < 4; ++i) { f32x4 v = *(const f32x4*)(stg + (srow + 8 * i) * 128 + sch * 16);
            if constexpr (KIND != K_DIL && !NOGATE) { const uint2 zz = *(const uint2*)(Zw + (size_t)(8 * i) * ce.zs + zoff + d0 * 32);
                const float z0 = __uint_as_float(zz.x << 16), z1 = __uint_as_float(zz.x & 0xffff0000u), z2 = __uint_as_float(zz.y << 16), z3 = __uint_as_float(zz.y & 0xffff0000u);
                v[0] = v[0] * z0 / (1.f + __expf(-z0)); v[1] = v[1] * z1 / (1.f + __expf(-z1)); v[2] = v[2] * z2 / (1.f + __expf(-z2)); v[3] = v[3] * z3 / (1.f + __expf(-z3)); }
            uint2 w; w.x = cvtpk(v[0], v[1]); w.y = cvtpk(v[2], v[3]);
            *(uint2*)(Ow + (size_t)(8 * i) * ce.os + ooff + d0 * 32) = w; }
        asm volatile("s_waitcnt lgkmcnt(0)" ::: "memory");
    }
    BAR();
#undef RESC
#undef KBASE
#undef ACT
#undef BOFS
#undef MASKT
#undef SLOT
#undef SMSEG
#undef MSEG
#undef STEP
}
#undef VMW
#undef VMWN
#undef SLOAD_K
#undef SLOAD_V
#undef SWRITE_HK
#undef SWRITE_HV
#undef QLOAD
#undef QLOAD_R
#undef KSWZ
}

namespace t32 {
using at::bf16_t; using at::bf16x8; using at::s16x4; using at::f32x4; using at::f32x16; using at::u32x4; using at::Ref; using at::Blk; using at::cvtpk; using at::ld8;
constexpr int NW = 8, QBLK = 32, KVBLK = 64, QB = NW * QBLK;
constexpr int SHM_V = 16384, K_ROW = 272, SHM_K = KVBLK * K_ROW, KR_ROW = 144, SHM_KR = KVBLK * KR_ROW;
constexpr int OFF_V = 0, OFF_K = 2 * SHM_V, OFF_KR = OFF_K + 2 * SHM_K, OFF_QR = OFF_KR + 2 * SHM_KR, LDS_BYTES = OFF_QR + NW * 4096;
static_assert(K_ROW == 272 && KR_ROW == 144, "KWS / KRWS");
constexpr float QMUL = 1.4426950408889634f * 0.07216878364870322f, THR2 = 8.f * 1.4426950408889634f;
struct Seam { bf16x8 qr[12]; bf16x8 st_v0, st_v1, st_k0, st_k1, st_kr; };
#define SBAR() __builtin_amdgcn_sched_barrier(0)
#define SGB(mask, n) __builtin_amdgcn_sched_group_barrier(mask, n, 0)
#define MF32(a, b, c) __builtin_amdgcn_mfma_f32_32x32x16_bf16(a, b, c, 0, 0, 0)
#define VMW() asm volatile("s_waitcnt vmcnt(0)" ::: "memory")
#define VMWN(n) asm volatile("s_waitcnt vmcnt(%0)" :: "i"(n) : "memory")
#define BAR() do { asm volatile("s_waitcnt lgkmcnt(0)" ::: "memory"); __builtin_amdgcn_s_barrier(); asm volatile("" ::: "memory"); } while (0)
#define LAUNDER_BLK(x) asm volatile("" : "+s"((x).a), "+s"((x).b), "+s"((x).c))
#define KWS(tw_) (((tw_) + ((tw_) >> 4)) << 4)
#define KRWS(tw_) (((tw_) + ((tw_) >> 3)) << 4)
#define VROW(tw_) (4 * ((tw_) >> 6) + (((tw_) >> 2) & 3))
#define VCH(tw_) (4 * (((tw_) >> 4) & 3) + ((tw_) & 3))
#define VWS(tw_) ((tw_) << 4)
#define SLOAD_K(R, k0, TOK, TID) do { const bf16_t* kb_ = (R).K + (size_t)(k0) * (R).ks; S.st_k0 = ld8(kb_ + (TOK)); S.st_k1 = ld8(kb_ + (size_t)32 * (R).ks + (TOK)); S.st_kr = ld8((R).Kr + (size_t)(k0) * 64 + (TID) * 8); } while (0)
#define SLOAD_V(R, k0, TOV) do { const bf16_t* vb_ = (R).V + (size_t)(k0) * (R).ks; S.st_v0 = ld8(vb_ + (TOV)); S.st_v1 = ld8(vb_ + (size_t)32 * (R).ks + (TOV)); } while (0)
#define SWRITE_HK(bf, tw_) do { const int kws_ = KWS(tw_); *(bf16x8*)(K_lds + (bf) * SHM_K + kws_) = S.st_k0; *(bf16x8*)(K_lds + (bf) * SHM_K + kws_ + 32 * K_ROW) = S.st_k1;   \
                                *(bf16x8*)(KR_lds + (bf) * SHM_KR + KRWS(tw_)) = S.st_kr; } while (0)
#define QLOAD(R, R32, HI) do { const bf16_t* qb_ = (R).Q + (size_t)(wid * QBLK) * (R).qs; const bf16_t* qrb_ = (R).Qr + (size_t)(wid * QBLK) * (R).qs; const unsigned qo_ = (unsigned)((R32) * (R).qs + (HI) * 8);   \
                      _Pragma("unroll") for (int d_ = 0; d_ < 8; ++d_) S.qr[d_] = ld8(qb_ + qo_ + d_ * 16);                                                                                              \
                      _Pragma("unroll") for (int d_ = 0; d_ < 4; ++d_) S.qr[8 + d_] = ld8(qrb_ + qo_ + d_ * 16); } while (0)

template <class MK>
__device__ __forceinline__ void attn_prime(const Blk cb, const MK& mk, char* lds, Seam& S) {
    const int tid = threadIdx.x, wid = __builtin_amdgcn_readfirstlane(tid >> 6), lane = tid & 63;
    char* K_lds = lds + OFF_K; char* KR_lds = lds + OFF_KR;
    Ref cur; mk(cb, cur);
    const int kb0 = cur.dir ? ((cur.P0 + QB - 1) / KVBLK) * KVBLK : 0, kb1 = cur.dir ? kb0 - KVBLK : kb0 + KVBLK;
    const unsigned tok = (unsigned)((tid >> 4) * cur.ks + (tid & 15) * 8), tov = (unsigned)(VROW(tid) * cur.ks + VCH(tid) * 8);
    QLOAD(cur, lane & 31, lane >> 5);
    SLOAD_K(cur, kb0, tok, tid); VMW(); SWRITE_HK(0, tid);
    SLOAD_K(cur, kb1, tok, tid); SLOAD_V(cur, kb0, tov);
    __syncthreads();
}

template <int KB>
__device__ __forceinline__ void qkt(f32x16& p0, f32x16& p1, const f32x16& ci, const char* lds, int r32, int hi, int qrofs, const bf16x8* qr) {
    const char* kbp = lds + OFF_K + KB * SHM_K + r32 * K_ROW + hi * 16;
#pragma unroll
    for (int d0 = 0; d0 < 8; ++d0) { const char* a = kbp + d0 * 32;
        const bf16x8 b0 = *reinterpret_cast<const bf16x8*>(a), b1 = *reinterpret_cast<const bf16x8*>(a + 32 * K_ROW);
        p0 = MF32(b0, qr[d0], d0 == 0 ? ci : p0); p1 = MF32(b1, qr[d0], d0 == 0 ? ci : p1); }
    const char* krb = lds + OFF_KR + KB * SHM_KR + r32 * KR_ROW + hi * 16;
#pragma unroll
    for (int d0 = 0; d0 < 4; ++d0) { const char* a = krb + d0 * 32;
        const bf16x8 b0 = *reinterpret_cast<const bf16x8*>(a), b1 = *reinterpret_cast<const bf16x8*>(a + 32 * KR_ROW);
        const bf16x8 qf = *reinterpret_cast<const bf16x8*>(lds + OFF_QR + qrofs + d0 * 1024);
        p0 = MF32(b0, qf, p0); p1 = MF32(b1, qf, p1); }
    constexpr int LA = 3;
    SGB(0x100, 2 * LA);
#pragma unroll
    for (int i = 0; i < 8 - LA; ++i) { SGB(0x008, 2); SGB(0x100, 2); }
#pragma unroll
    for (int i = 0; i < 4; ++i) { SGB(0x008, 2); SGB(0x100, 3); }
    SGB(0x008, 2 * LA);
}
template <int VB>
__device__ __forceinline__ void pv_tile(f32x16 (&o)[4], f32x16& ol, int vb0, const bf16x8 (&pa)[4]) {
#define TRRD(dst, off) asm volatile("ds_read_b64_tr_b16 %0, %1 offset:%2" : "=&v"(dst) : "v"(vb0), "i"(off) : "memory")
#define PV_K(ks) do { s16x4 l0, h0, l1, h1, l2, h2, l3, h3; constexpr int b_ = OFF_V + VB * SHM_V + (ks) * 4096;                                                      \
        TRRD(l0, b_); TRRD(h0, b_ + 2048); TRRD(l1, b_ + 256); TRRD(h1, b_ + 256 + 2048); TRRD(l2, b_ + 512); TRRD(h2, b_ + 512 + 2048); TRRD(l3, b_ + 768); TRRD(h3, b_ + 768 + 2048);   \
        asm volatile("s_waitcnt lgkmcnt(0)" ::: "memory"); SBAR();                                                                                                 \
        o[0] = MF32(((bf16x8){l0[0], l0[1], l0[2], l0[3], h0[0], h0[1], h0[2], h0[3]}), pa[ks], o[0]);                                                             \
        o[1] = MF32(((bf16x8){l1[0], l1[1], l1[2], l1[3], h1[0], h1[1], h1[2], h1[3]}), pa[ks], o[1]);                                                             \
        o[2] = MF32(((bf16x8){l2[0], l2[1], l2[2], l2[3], h2[0], h2[1], h2[2], h2[3]}), pa[ks], o[2]);                                                             \
        o[3] = MF32(((bf16x8){l3[0], l3[1], l3[2], l3[3], h3[0], h3[1], h3[2], h3[3]}), pa[ks], o[3]); } while (0)
    PV_K(0); PV_K(1); PV_K(2); PV_K(3);
    { const bf16x8 ones = (bf16x8){0x3F80, 0x3F80, 0x3F80, 0x3F80, 0x3F80, 0x3F80, 0x3F80, 0x3F80};
      ol = MF32(ones, pa[0], ol); ol = MF32(ones, pa[1], ol); ol = MF32(ones, pa[2], ol); ol = MF32(ones, pa[3], ol); }
#undef PV_K
#undef TRRD
}

template <class MK>
__device__ __forceinline__ void attn_block(const Blk cb, const Blk nb, const MK& mk, int skv, char* lds, Seam& S) {
    const int W = 1 << 30;
    const int tid = threadIdx.x, wid = __builtin_amdgcn_readfirstlane(tid >> 6), lane = tid & 63, r32 = lane & 31, hi = lane >> 5;
    const int grp = wid >> 2;
    Ref cur; mk(cb, cur);
    const int j_lo = 0;
    int j_hi = (cur.P0 + QB - 1) / KVBLK + 1; if (j_hi > skv / KVBLK) j_hi = skv / KVBLK;
    const int NT = j_hi - j_lo;
    const int qlo = cur.P0 + wid * QBLK, qm = qlo + r32 - 4 * hi;
    char* V_lds = lds + OFF_V; char* K_lds = lds + OFF_K; char* KR_lds = lds + OFF_KR;
    float m = -1e30f; f32x16 o[4] = {}; f32x16 ol = {};
    f32x16 ci = {}; bool inited = false;
    const int vb0 = (int)(uintptr_t)V_lds + hi * 1024 + ((lane >> 2) & 3) * 64 + ((lane >> 4) & 1) * 32 + (lane & 3) * 8;
    const unsigned tok = (unsigned)((tid >> 4) * cur.ks + (tid & 15) * 8), tov = (unsigned)(VROW(tid) * cur.ks + VCH(tid) * 8);
    int tq_ = tid; asm volatile("" : "+v"(tq_));
    const int qrofs = wid * 4096 + (tq_ & 63) * 16;
#define KBASE(t) ((cur.dir ? j_hi - 1 - (t) : j_lo + (t)) * KVBLK)
    f32x16 p0 = {}, p1 = {}; bf16x8 pa[4] = {};
#define SLOT(i) do { VMW(); { int tw_ = tid; asm volatile("" : "+v"(tw_)); const int vst_ = VWS(tw_);                                                              \
                     if ((i) < NT) { *(bf16x8*)(V_lds + ((i) & 1) * SHM_V + vst_) = S.st_v0; *(bf16x8*)(V_lds + ((i) & 1) * SHM_V + vst_ + 8192) = S.st_v1; }       \
                     if ((i) + 1 < NT) { SWRITE_HK(((i) + 1) & 1, tw_); } } SBAR();                                                                                \
                     if ((i) + 1 < NT) SLOAD_V(cur, KBASE((i) + 1), tov); if ((i) + 2 < NT) SLOAD_K(cur, KBASE((i) + 2), tok, tid); SBAR(); } while (0)
#define SMSEG(t) do { SBAR(); { const int kb_ = KBASE(t); if (kb_ + KVBLK - 1 > qlo || kb_ <= qlo + QBLK - 1 - W) at::mask_tile(p0, p1, qm - kb_, (unsigned)W); }                \
        float ma = p0[0], mb = p0[8], mc = p1[0], md = p1[8];                                                                                                      \
        _Pragma("unroll") for (int r = 1; r < 8; ++r) { ma = fmaxf(ma, p0[r]); mb = fmaxf(mb, p0[8 + r]); mc = fmaxf(mc, p1[r]); md = fmaxf(md, p1[8 + r]); }        \
        float pm = fmaxf(fmaxf(ma, mb), fmaxf(mc, md));                                                                                                            \
        if (!__builtin_expect(inited && __all(pm <= THR2), 1)) {                         \
            pm = fmaxf(pm, __shfl_xor(pm, 32));                                                                                                                    \
            const float u = -ci[0];                                                          \
            const float n = fmaxf(m, pm + u), al = __builtin_amdgcn_exp2f(m - n), sb = n - u;                                                                      \
            _Pragma("unroll") for (int r = 0; r < 16; ++r) { p0[r] -= sb; p1[r] -= sb; ol[r] *= al; o[0][r] *= al; o[1][r] *= al; o[2][r] *= al; o[3][r] *= al; }    \
            m = n; const float c_ = n > -1e29f ? -n : 0.f; _Pragma("unroll") for (int r = 0; r < 16; ++r) ci[r] = c_;                                              \
            inited = __all(n > -1e29f) != 0; }                                                                                                                     \
        _Pragma("unroll") for (int r = 0; r < 16; ++r) { p0[r] = __builtin_amdgcn_exp2f(p0[r]); p1[r] = __builtin_amdgcn_exp2f(p1[r]); }                            \
        { u32x4 w0_ = {cvtpk(p0[0], p0[1]), cvtpk(p0[2], p0[3]), cvtpk(p0[4], p0[5]), cvtpk(p0[6], p0[7])}, w1_ = {cvtpk(p0[8], p0[9]), cvtpk(p0[10], p0[11]), cvtpk(p0[12], p0[13]), cvtpk(p0[14], p0[15])};   \
          u32x4 w2_ = {cvtpk(p1[0], p1[1]), cvtpk(p1[2], p1[3]), cvtpk(p1[4], p1[5]), cvtpk(p1[6], p1[7])}, w3_ = {cvtpk(p1[8], p1[9]), cvtpk(p1[10], p1[11]), cvtpk(p1[12], p1[13]), cvtpk(p1[14], p1[15])};   \
          pa[0] = *reinterpret_cast<bf16x8*>(&w0_); pa[1] = *reinterpret_cast<bf16x8*>(&w1_); pa[2] = *reinterpret_cast<bf16x8*>(&w2_); pa[3] = *reinterpret_cast<bf16x8*>(&w3_); }   \
        SBAR(); } while (0)
#define MSEG(t, KB, VB) do { SBAR(); if ((t) > 0) pv_tile<VB>(o, ol, vb0, pa); SBAR(); qkt<KB>(p0, p1, ci, lds, r32, hi, qrofs, S.qr); SBAR(); } while (0)
#define STEP(t, KB, VB) do { MSEG(t, KB, VB); BAR(); SLOT((t) + grp); SMSEG(t); BAR(); } while (0)
#pragma unroll
    for (int f = 0; f < 4; ++f) *(bf16x8*)(lds + OFF_QR + qrofs + f * 1024) = S.qr[8 + f];
    if (grp) { SLOT(0); BAR(); }
    int t = 0;
    for (; t + 1 < NT; t += 2) { STEP(t, 0, 1); STEP(t + 1, 1, 0); }
    if (t < NT) { STEP(t, 0, 1); }
    int tid_t = tid; asm volatile("" : "+v"(tid_t));
    Blk nb2 = nb; LAUNDER_BLK(nb2); Ref nxt; mk(nb2, nxt);
    const int kbn0 = nxt.dir ? ((nxt.P0 + QB - 1) / KVBLK) * KVBLK : 0, kbn1 = nxt.dir ? kbn0 - KVBLK : kbn0 + KVBLK;
    const unsigned tokn = (unsigned)((tid_t >> 4) * nxt.ks + (tid_t & 15) * 8), tovn = (unsigned)(VROW(tid_t) * nxt.ks + VCH(tid_t) * 8);
    if (((NT - 1) & 1) != 0) pv_tile<1>(o, ol, vb0, pa); else pv_tile<0>(o, ol, vb0, pa);
    SBAR(); SLOAD_K(nxt, kbn0, tokn, tid_t); SBAR(); QLOAD(nxt, tid_t & 31, (tid_t >> 5) & 1); SBAR();
    BAR();
    VMWN(12); SWRITE_HK(0, tid_t); SBAR(); SLOAD_K(nxt, kbn1, tokn, tid_t); SLOAD_V(nxt, kbn0, tovn); SBAR();
    BAR();
    if (grp == 0) BAR();
    Blk cb2 = cb; LAUNDER_BLK(cb2); Ref ce; mk(cb2, ce);
    const int qt_ = tid_t & 31, ht_ = (tid_t >> 5) & 1;
    bf16_t* Ow = ce.O + (size_t)(wid * QBLK) * ce.os; const bf16_t* Zw = ce.Z + (size_t)(wid * QBLK) * ce.zs;
    const float rl = __builtin_amdgcn_rcpf(ol[0]);
    const unsigned ooff = (unsigned)(qt_ * ce.os + 4 * ht_), zoff = (unsigned)(qt_ * ce.zs + 4 * ht_);
#pragma unroll
    for (int c = 0; c < 4; ++c) {
        uint2 zz[4];
#pragma unroll
        for (int rr = 0; rr < 4; ++rr) zz[rr] = *(const uint2*)(Zw + zoff + 32 * c + 8 * rr);
#pragma unroll
        for (int rr = 0; rr < 4; ++rr) {
            const float z0 = __uint_as_float(zz[rr].x << 16), z1 = __uint_as_float(zz[rr].x & 0xffff0000u), z2 = __uint_as_float(zz[rr].y << 16), z3 = __uint_as_float(zz[rr].y & 0xffff0000u);
            const float v0 = o[c][4 * rr] * rl, v1 = o[c][4 * rr + 1] * rl, v2 = o[c][4 * rr + 2] * rl, v3 = o[c][4 * rr + 3] * rl;
            uint2 w; w.x = cvtpk(v0 * z0 / (1.f + __expf(-z0)), v1 * z1 / (1.f + __expf(-z1))); w.y = cvtpk(v2 * z2 / (1.f + __expf(-z2)), v3 * z3 / (1.f + __expf(-z3)));
            *(uint2*)(Ow + ooff + 32 * c + 8 * rr) = w; }
    }
    BAR();
#undef KBASE
#undef SLOT
#undef SMSEG
#undef MSEG
#undef STEP
}
#undef SBAR
#undef SGB
#undef MF32
#undef VMW
#undef VMWN
#undef BAR
#undef LAUNDER_BLK
#undef KWS
#undef KRWS
#undef VROW
#undef VCH
#undef VWS
#undef SLOAD_K
#undef SLOAD_V
#undef SWRITE_HK
#undef QLOAD
}

#define GAS __attribute__((address_space(1)))
#define LAS __attribute__((address_space(3)))
typedef unsigned short bf16;
typedef unsigned v4u __attribute__((ext_vector_type(4)));
typedef float f32x4 __attribute__((ext_vector_type(4)));
typedef short bf16x8 __attribute__((ext_vector_type(8)));
typedef GAS unsigned gu32;
typedef GAS unsigned long long gu64;
#define RLX_AGENT __ATOMIC_RELAXED, __HIP_MEMORY_SCOPE_AGENT
#define LDS_WAIT() asm volatile("s_waitcnt lgkmcnt(0)" ::: "memory")
#define VM_WAIT() asm volatile("s_waitcnt vmcnt(0)" ::: "memory")
__device__ __forceinline__ unsigned long long rt() { return __builtin_amdgcn_s_memrealtime(); }
__device__ __forceinline__ unsigned f2bf(float f) { unsigned u = __builtin_bit_cast(unsigned, f); return (u + 0x7fffu + ((u >> 16) & 1u)) >> 16; }
__device__ __forceinline__ unsigned pk2(float lo, float hi) { return f2bf(lo) | (f2bf(hi) << 16); }

#define XB_TMO      128
#define XB_XCNT(j)  (256  + 64 * (j))
#define XB_XSUB(j)  (1280 + 64 * (j))
#define XB_XGEN(j)  (2304 + 64 * (j))
#define XB_TOP      3328
#define XB_TOPGEN   3392
#define XCD_BAR_WORDS 3456
#define XB_SPIN_CAP (1u << 18)

__device__ __forceinline__ unsigned xb_ld(unsigned* p)              { return __hip_atomic_load(p, __ATOMIC_RELAXED, __HIP_MEMORY_SCOPE_AGENT); }
__device__ __forceinline__ unsigned xb_add(unsigned* p, unsigned v) { return __hip_atomic_fetch_add(p, v, __ATOMIC_RELAXED, __HIP_MEMORY_SCOPE_AGENT); }
__device__ __forceinline__ unsigned xb_xcc_id() { return (unsigned)__builtin_amdgcn_s_getreg((3 << 11) | 20) & 0xFu; }
#define XB_SPIN(cond, bar) do { unsigned _sp = 0; while (cond) { __builtin_amdgcn_s_sleep(1); \
    if ((++_sp & 255u) == 0u) { if (xb_ld(&(bar)[XB_TMO])) break; if (_sp > XB_SPIN_CAP) { atomicAdd(&(bar)[XB_TMO], 1u); break; } } } } while (0)

struct XcdBarrier {
    unsigned* bar; unsigned x;
    volatile LAS unsigned* st;
};

__device__ __forceinline__ XcdBarrier xcd_barrier_post(unsigned* bar, volatile LAS unsigned* st) {
    XcdBarrier b; b.bar = bar; b.x = xb_xcc_id(); b.st = st;
    if (threadIdx.x == 0) (void)xb_add(&bar[XB_XCNT(b.x)], 1u);
    return b;
}
__device__ __forceinline__ void xcd_barrier_complete(unsigned* bar, unsigned x, unsigned& nloc, unsigned& nx) {
    const unsigned G = gridDim.x * gridDim.y * gridDim.z;
    unsigned sum, cnt, mine, sp = 0u;
    for (;;) {
        sum = 0u; cnt = 0u; mine = 0u;
#pragma unroll
        for (unsigned j = 0; j < 16; ++j) { const unsigned c = xb_ld(&bar[XB_XCNT(j)]); sum += c; cnt += (c > 0u) ? 1u : 0u; mine = (j == x) ? c : mine; }
        if (sum == G) break;
        __builtin_amdgcn_s_sleep(1);
        if ((++sp & 255u) == 0u) { if (xb_ld(&bar[XB_TMO])) break; if (sp > XB_SPIN_CAP) { atomicAdd(&bar[XB_TMO], 1u); break; } }
    }
    nloc = mine > 0u ? mine : 1u; nx = cnt > 0u ? cnt : 1u;
}

__device__ __forceinline__ void xcd_barrier(const XcdBarrier& b) {
    asm volatile("s_waitcnt vmcnt(0)" ::: "memory");
    __syncthreads();
    if (threadIdx.x == 0) {
        unsigned* bar = b.bar;
        __builtin_amdgcn_s_waitcnt(0);
        unsigned nloc = b.st[0], nx = b.st[1];
        if (nloc == 0u) { xcd_barrier_complete(bar, b.x, nloc, nx); b.st[0] = nloc; b.st[1] = nx; }
        const unsigned old = xb_add(&bar[XB_XSUB(b.x)], 1u);
        const unsigned gen = old / nloc;
        if (old + 1u == (gen + 1u) * nloc) {
            __builtin_amdgcn_fence(__ATOMIC_RELEASE, "agent");
            asm volatile("s_waitcnt vmcnt(0)" ::: "memory");
            const unsigned og = xb_add(&bar[XB_TOP], 1u);
            const unsigned tg = og / nx;
            if (og + 1u == (tg + 1u) * nx) xb_add(&bar[XB_TOPGEN], 1u);
            else XB_SPIN(xb_ld(&bar[XB_TOPGEN]) == tg, bar);
            __builtin_amdgcn_fence(__ATOMIC_ACQUIRE, "agent");
            xb_add(&bar[XB_XGEN(b.x)], 1u);
            asm volatile("s_waitcnt vmcnt(0)" ::: "memory");
        } else {
            XB_SPIN(xb_ld(&bar[XB_XGEN(b.x)]) == gen, bar);
            __builtin_amdgcn_fence(__ATOMIC_ACQUIRE, "agent");
            asm volatile("s_waitcnt vmcnt(0)" ::: "memory");
        }
    }
    __syncthreads();
}

constexpr int BATCH = 2, SEQ = 8192, DM = 4096, M = BATCH * SEQ, HD = 128;
constexpr int NHA = 16, NHB = 16, NHC = 32;
constexpr int IN_EVEN = 16400, IN_ODD = 5696, Q_LORA = 1024, KV_LORA = 512, QK_ROPE = 64;
constexpr int N0 = 16384;
constexpr int C_QA = 0, C_KA = 2048, C_VA = 4096, C_QB = 6144, C_KB = 8192, C_VB = 10240, C_Z0 = 12288;
constexpr int N1 = 5888;
constexpr int C1_Z = 0, C1_CQ = 4096, C1_CKV = 5120, C1_KR = 5632;
constexpr int NQ = 6144;
constexpr int NKV = 8192;
constexpr float EPS = 1e-6f;
constexpr int NWAVES = 8;
#ifndef MK_PER_PHASE
#define MK_PER_PHASE 0
#endif
constexpr int N_PHASES = 13;

constexpr size_t MiB = 1u << 20;
constexpr size_t WS_CTL = 0, CTL_ZERO_BYTES = 1 * MiB;
constexpr size_t WS_MOD = 1 * MiB;
constexpr size_t WS_FLOGIT = 2 * MiB;
constexpr size_t WS_CS = 4 * MiB;
constexpr size_t WS_LSE = 8 * MiB;
constexpr size_t WS_WFT = 12 * MiB;
constexpr size_t WS_BT0 = 16 * MiB;
constexpr size_t WS_WO0 = 144 * MiB;
constexpr size_t WS_BT1 = 176 * MiB;
constexpr size_t WS_WQB = 222 * MiB;
constexpr size_t WS_WKVB = 234 * MiB;
constexpr size_t WS_WO1 = 242 * MiB;
constexpr size_t WS_XN = 274 * MiB;
constexpr size_t WS_PROJ0 = 402 * MiB;
constexpr size_t WS_OP = 914 * MiB;
constexpr size_t WS_G = 1106 * MiB;
constexpr size_t WS_END = 1234 * MiB;
constexpr size_t WS_Y1 = 16 * MiB, WS_Y2 = 828 * MiB;
constexpr size_t WS_PROJ1 = 402 * MiB;
constexpr size_t WS_CQN = 586 * MiB;
constexpr size_t WS_CKVN = 618 * MiB;
constexpr size_t WS_KROPE = 634 * MiB;
constexpr size_t WS_QBUF = 636 * MiB;
constexpr size_t WS_KVBUF = 828 * MiB;
static_assert(WS_KVBUF + (size_t)M * NKV * 2 <= WS_G && WS_PROJ1 + (size_t)M * N1 * 2 <= WS_CQN && WS_QBUF + (size_t)M * NQ * 2 <= WS_KVBUF, "d_ws map");
constexpr int CW_BAR = 4096;
constexpr int CW_QUEUE = 64;
constexpr size_t WS_NRMQ = 256 * 1024, WS_NRMK = 320 * 1024;

constexpr int RING_OFF = 0, RING_BYTES = 131072;
constexpr int LDSCTL_OFF = RING_BYTES, MISC_OFF = LDSCTL_OFF + 320;
constexpr int LDS_BYTES = 147456;
static_assert(MISC_OFF + 128 <= LDS_BYTES && at::LDS_BYTES <= RING_BYTES && t32::LDS_BYTES <= RING_BYTES && pg8::STAGE_BYTES <= RING_BYTES, "LDS map");

struct Args { const void* in[17]; float* out; unsigned char* ws; int ph_lo, ph_hi; };

struct Ctx {
    LAS unsigned char* lds; int tid, lane, wave, vcu, G;
    const __attribute__((address_space(4))) Args* A;
    float* out; unsigned char* ws;
};
__device__ __forceinline__ const __attribute__((address_space(4))) Args* late(const __attribute__((address_space(4))) Args* a) { asm volatile("" : "+s"(a)); return a; }
#define IN_X(F)        ((const float*)late((F).A)->in[0])
#define IN_C(F)        ((const float*)late((F).A)->in[1])
#define IN_POS(F)      ((const int*)late((F).A)->in[2])
#define IN_GNORM(F)    ((const float*)late((F).A)->in[3])
#define IN_WADA(F)     ((const float*)late((F).A)->in[4])
#define IN_BADA(F)     ((const float*)late((F).A)->in[5])
#define IN_RELB(F)     ((const float*)late((F).A)->in[6])
#define IN_WINE(F)     ((const float*)late((F).A)->in[7])
#define IN_BF(F)       ((const float*)late((F).A)->in[8])
#define IN_WOE(F)      ((const float*)late((F).A)->in[9])
#define IN_WINO(F)     ((const float*)late((F).A)->in[10])
#define IN_GQ(F)       ((const float*)late((F).A)->in[11])
#define IN_GKV(F)      ((const float*)late((F).A)->in[12])
#define IN_WQB(F)      ((const float*)late((F).A)->in[13])
#define IN_WKVB(F)     ((const float*)late((F).A)->in[14])
#define IN_WOO(F)      ((const float*)late((F).A)->in[15])
#define IN_GFIN(F)     ((const float*)late((F).A)->in[16])
__device__ __forceinline__ float wave_sum(float v) {
#pragma unroll
    for (int o = 1; o < 64; o <<= 1) v += __shfl_xor(v, o);
    return v;
}
__device__ __forceinline__ float bf2f(unsigned short h) { return __uint_as_float(((unsigned)h) << 16); }
__device__ __forceinline__ float silu_f(float z) { return z / (1.f + __expf(-z)); }

__device__ __forceinline__ void transpose_item(const float* W, int ldw, int K, int kb, int n0, bf16* WT, int drow0, int rmul, LAS float* scr, int lane) {
    const int k0 = 64 * kb;
#pragma unroll 8
    for (int i = 0; i < 32; ++i) { const int kk = 2 * i + (lane >> 5); scr[kk * 33 + (lane & 31)] = W[(size_t)(k0 + kk) * ldw + n0 + (lane & 31)]; }
    LDS_WAIT(); asm volatile("" ::: "memory");
    const int cch = lane & 7;
#pragma unroll
    for (int j = 0; j < 4; ++j) { const int n = (lane >> 3) + 8 * j; const LAS float* s = scr + (8 * cch) * 33 + n;
        v4u o; o.x = pk2(s[0 * 33], s[1 * 33]); o.y = pk2(s[2 * 33], s[3 * 33]); o.z = pk2(s[4 * 33], s[5 * 33]); o.w = pk2(s[6 * 33], s[7 * 33]);
        *(GAS v4u*)(WT + (size_t)(drow0 + rmul * n) * K + k0 + 8 * cch) = o; }
    LDS_WAIT(); asm volatile("" ::: "memory");
}
__device__ __forceinline__ void map_in_odd(int nb, int& drow0, int& rmul) { rmul = 1;
    if (nb < 32) drow0 = C1_CQ + 32 * nb; else if (nb < 48) drow0 = C1_CKV + 32 * (nb - 32); else if (nb < 50) { drow0 = C1_KR + (nb - 48); rmul = 2; } else drow0 = C1_Z + 32 * (nb - 50); }
__device__ __forceinline__ void map_qb(int nb, int& drow0, int& rmul) { const int h = nb / 6, part = nb % 6; rmul = 1;
    if (part < 4) drow0 = h * 128 + part * 32; else { drow0 = 4096 + h * 64 + (part - 4); rmul = 2; } }
__device__ __forceinline__ void map_kvb(int nb, int& drow0, int& rmul) { const int h = nb / 8, part = nb % 8; rmul = 1;
    drow0 = part < 4 ? h * 128 + part * 32 : 4096 + h * 128 + (part - 4) * 32; }

__device__ __forceinline__ void p0_prologue(Ctx& F) {
    const int gw = F.vcu * NWAVES + F.wave, NGW = F.G * NWAVES, gt = gw * 64 + F.lane, NGT = NGW * 64;
    float* cs = (float*)(F.ws + WS_CS);
    for (int i = gt; i < M * 32; i += NGT) { const int row = i >> 5, j = i & 31;
        const float inv = powf(10000.0f, -(float)j / 32.0f); const float ang = (float)IN_POS(F)[row] * inv; float sn, cn; sincosf(ang, &sn, &cn);
        cs[(size_t)row * 64 + j] = cn; cs[(size_t)row * 64 + 32 + j] = sn; }
    bf16* wft = (bf16*)(F.ws + WS_WFT);
    for (int i = gt; i < 16 * DM; i += NGT) { const int n = i >> 12, k = i & 4095; wft[i] = (bf16)f2bf(IN_WINE(F)[(size_t)k * IN_EVEN + N0 + n]); }
    { v4u* pad = (v4u*)((bf16*)(F.ws + WS_BT1) + (size_t)IN_ODD * DM); const int npad = (N1 - IN_ODD) * DM / 8;
      for (int i = gt; i < npad; i += NGT) pad[i] = (v4u){0u, 0u, 0u, 0u}; }
    LAS float* scr = (LAS float*)(F.lds + RING_OFF + F.wave * 16384);
    constexpr int KB4 = DM / 64;
    constexpr int I_IN0 = KB4 * (N0 / 32), I_WO = KB4 * (DM / 32), I_IN1 = KB4 * (IN_ODD / 32), I_QB = (Q_LORA / 64) * (NQ / 32), I_KVB = (KV_LORA / 64) * (NKV / 32);
    constexpr int NITEMS = I_IN0 + 2 * I_WO + I_IN1 + I_QB + I_KVB;
    for (int it = gw; it < NITEMS; it += NGW) {
        int r = it, drow0, rmul;
        if (r < I_IN0) { const int nblk = N0 / 32; transpose_item(IN_WINE(F), IN_EVEN, DM, r / nblk, 32 * (r % nblk), (bf16*)(F.ws + WS_BT0), 32 * (r % nblk), 1, scr, F.lane); continue; } r -= I_IN0;
        if (r < I_WO) { const int nblk = DM / 32; transpose_item(IN_WOE(F), DM, DM, r / nblk, 32 * (r % nblk), (bf16*)(F.ws + WS_WO0), 32 * (r % nblk), 1, scr, F.lane); continue; } r -= I_WO;
        if (r < I_WO) { const int nblk = DM / 32; transpose_item(IN_WOO(F), DM, DM, r / nblk, 32 * (r % nblk), (bf16*)(F.ws + WS_WO1), 32 * (r % nblk), 1, scr, F.lane); continue; } r -= I_WO;
        if (r < I_IN1) { const int nblk = IN_ODD / 32; map_in_odd(r % nblk, drow0, rmul); transpose_item(IN_WINO(F), IN_ODD, DM, r / nblk, 32 * (r % nblk), (bf16*)(F.ws + WS_BT1), drow0, rmul, scr, F.lane); continue; } r -= I_IN1;
        if (r < I_QB) { const int nblk = NQ / 32; map_qb(r % nblk, drow0, rmul); transpose_item(IN_WQB(F), NQ, Q_LORA, r / nblk, 32 * (r % nblk), (bf16*)(F.ws + WS_WQB), drow0, rmul, scr, F.lane); continue; } r -= I_QB;
        { const int nblk = NKV / 32; map_kvb(r % nblk, drow0, rmul); transpose_item(IN_WKVB(F), NKV, KV_LORA, r / nblk, 32 * (r % nblk), (bf16*)(F.ws + WS_WKVB), drow0, rmul, scr, F.lane); }
    }
    __syncthreads();
    LAS float* sc = (LAS float*)(F.lds + RING_OFF);
    LAS float* red = (LAS float*)(F.lds + RING_OFF + 32768);
    for (int i = F.tid; i < BATCH * DM; i += NWAVES * 64) sc[i] = silu_f(IN_C(F)[i]);
    __syncthreads();
    float* mod = (float*)(F.ws + WS_MOD);
    const int c4 = F.tid & 7, kl = F.tid >> 3;
    for (int it = F.vcu; it < 2 * (3 * DM / 32); it += F.G) {
        const int l = it / (3 * DM / 32), n0 = 32 * (it % (3 * DM / 32));
        const float* wp = IN_WADA(F) + ((size_t)l * DM) * (3 * DM) + n0 + 4 * c4;
        f32x4 a0 = (f32x4){0.f, 0.f, 0.f, 0.f}, a1 = a0;
#pragma unroll 8
        for (int i = 0; i < 64; ++i) { const int k = kl + 64 * i; const f32x4 w = *(const GAS f32x4*)(wp + (size_t)k * (3 * DM)); a0 += w * sc[k]; a1 += w * sc[DM + k]; }
        LAS float* rp = red + (kl * 8 + c4) * 8;
        rp[0] = a0[0]; rp[1] = a0[1]; rp[2] = a0[2]; rp[3] = a0[3]; rp[4] = a1[0]; rp[5] = a1[1]; rp[6] = a1[2]; rp[7] = a1[3];
        __syncthreads();
        if (F.tid < 64) { const int b = F.tid >> 5, n = F.tid & 31; float s = 0.f;
            for (int q = 0; q < 64; ++q) s += red[(q * 8 + (n >> 2)) * 8 + b * 4 + (n & 3)];
            mod[((size_t)l * BATCH + b) * (3 * DM) + n0 + n] = s + IN_BADA(F)[(size_t)l * (3 * DM) + n0 + n]; }
        __syncthreads();
    }
}

__device__ __forceinline__ void adaln_rows(Ctx& F, const float* X, const float* g, const float* mod  , bf16* XN) {
    const int gw = F.vcu * NWAVES + F.wave, NGW = F.G * NWAVES;
    for (int m = gw; m < M; m += NGW) {
        const int b = m / SEQ;
        const GAS f32x4* xr = (const GAS f32x4*)(X + (size_t)m * DM) + F.lane;
        f32x4 v[16]; float s = 0.f;
#pragma unroll
        for (int j = 0; j < 16; ++j) { v[j] = xr[64 * j]; s += (v[j].x * v[j].x + v[j].y * v[j].y) + (v[j].z * v[j].z + v[j].w * v[j].w); }
        const float rstd = 1.0f / sqrtf(wave_sum(s) * (1.f / DM) + EPS);
        const f32x4* g4 = (const f32x4*)g + F.lane; const f32x4* sh4 = (const f32x4*)(mod + (size_t)b * 3 * DM) + F.lane; const f32x4* sc4 = (const f32x4*)(mod + (size_t)b * 3 * DM + DM) + F.lane;
        GAS unsigned long long* o8 = (GAS unsigned long long*)(XN + (size_t)m * DM) + F.lane;
#pragma unroll
        for (int j = 0; j < 16; ++j) { const f32x4 y = (v[j] * rstd) * g4[64 * j] * (sc4[64 * j] + 1.0f) + sh4[64 * j];
            o8[64 * j] = (unsigned long long)pk2(y.x, y.y) | ((unsigned long long)pk2(y.z, y.w) << 32); }
    }
}
__device__ __forceinline__ void adaln_add_rows(Ctx& F, const float* X, const bf16* Y, const float* g, const float* mod  , bf16* XN) {
    const int gw = F.vcu * NWAVES + F.wave, NGW = F.G * NWAVES;
    for (int m = gw; m < M; m += NGW) {
        const int b = m / SEQ;
        const GAS f32x4* xr = (const GAS f32x4*)(X + (size_t)m * DM) + F.lane; const GAS unsigned long long* yr = (const GAS unsigned long long*)(Y + (size_t)m * DM) + F.lane;
        f32x4 v[16]; float s = 0.f;
#pragma unroll
        for (int j = 0; j < 16; ++j) { const unsigned long long y8 = yr[64 * j]; const unsigned ylo = (unsigned)y8, yhi = (unsigned)(y8 >> 32);
            v[j] = xr[64 * j] + (f32x4){__uint_as_float(ylo << 16), __uint_as_float(ylo & 0xffff0000u), __uint_as_float(yhi << 16), __uint_as_float(yhi & 0xffff0000u)};
            s += (v[j].x * v[j].x + v[j].y * v[j].y) + (v[j].z * v[j].z + v[j].w * v[j].w); }
        const float rstd = 1.0f / sqrtf(wave_sum(s) * (1.f / DM) + EPS);
        const f32x4* g4 = (const f32x4*)g + F.lane; const f32x4* sh4 = (const f32x4*)(mod + (size_t)b * 3 * DM) + F.lane; const f32x4* sc4 = (const f32x4*)(mod + (size_t)b * 3 * DM + DM) + F.lane;
        GAS unsigned long long* o8 = (GAS unsigned long long*)(XN + (size_t)m * DM) + F.lane;
#pragma unroll
        for (int j = 0; j < 16; ++j) { const f32x4 y = (v[j] * rstd) * g4[64 * j] * (sc4[64 * j] + 1.0f) + sh4[64 * j];
            o8[64 * j] = (unsigned long long)pk2(y.x, y.y) | ((unsigned long long)pk2(y.z, y.w) << 32); }
    }
}
__device__ __forceinline__ void final_rows(Ctx& F) {
    const int gw = F.vcu * NWAVES + F.wave, NGW = F.G * NWAVES;
    int ln = threadIdx.x; asm volatile("" : "+v"(ln)); ln &= 63;
    for (int m = gw; m < M; m += NGW) {
        GAS f32x4* xr = (GAS f32x4*)(F.out + (size_t)m * DM) + ln; const GAS f32x4* xin = (const GAS f32x4*)(IN_X(F) + (size_t)m * DM) + ln;
        const GAS unsigned long long* yr = (const GAS unsigned long long*)((const bf16*)(F.ws + WS_Y2) + (size_t)m * DM) + ln; const GAS unsigned long long* y1r = (const GAS unsigned long long*)((const bf16*)(F.ws + WS_Y1) + (size_t)m * DM) + ln;
        f32x4 v[16]; float s = 0.f;
#pragma unroll
        for (int j = 0; j < 16; ++j) { const unsigned long long y8 = yr[64 * j], z8 = y1r[64 * j]; const unsigned ylo = (unsigned)y8, yhi = (unsigned)(y8 >> 32), zlo = (unsigned)z8, zhi = (unsigned)(z8 >> 32);
            v[j] = (xin[64 * j] + (f32x4){__uint_as_float(zlo << 16), __uint_as_float(zlo & 0xffff0000u), __uint_as_float(zhi << 16), __uint_as_float(zhi & 0xffff0000u)})
                 + (f32x4){__uint_as_float(ylo << 16), __uint_as_float(ylo & 0xffff0000u), __uint_as_float(yhi << 16), __uint_as_float(yhi & 0xffff0000u)};
            s += (v[j].x * v[j].x + v[j].y * v[j].y) + (v[j].z * v[j].z + v[j].w * v[j].w); }
        const float rstd = 1.0f / sqrtf(wave_sum(s) * (1.f / DM) + EPS);
        const f32x4* g4 = (const f32x4*)IN_GFIN(F) + ln;
#pragma unroll
        for (int j = 0; j < 16; ++j) xr[64 * j] = (v[j] * rstd) * g4[64 * j];
    }
}
__device__ __forceinline__ void flogit_rows(Ctx& F) {
    typedef float f4 __attribute__((ext_vector_type(4)));
    const bf16* XN = (const bf16*)(F.ws + WS_XN); const bf16* WFT = (const bf16*)(F.ws + WS_WFT); float* FL = (float*)(F.ws + WS_FLOGIT);
    LAS f4* red = (LAS f4*)(F.lds + RING_OFF);
    const int r = F.lane & 15, kg = F.lane >> 4, kh = F.wave >> 2;
    for (int c0 = F.vcu; c0 < M / 64; c0 += F.G) {
        const int row0 = c0 * 64 + 16 * (F.wave & 3);
        const bf16* ap = XN + (size_t)(row0 + r) * DM + kh * 2048 + 8 * kg; const bf16* bp = WFT + (size_t)r * DM + kh * 2048 + 8 * kg;
        f4 acc = (f4){0.f, 0.f, 0.f, 0.f};
#pragma unroll 8
        for (int s = 0; s < 64; ++s) { const bf16x8 a = *(const GAS bf16x8*)(ap + 32 * s), b = *(const GAS bf16x8*)(bp + 32 * s);
            acc = __builtin_amdgcn_mfma_f32_16x16x32_bf16(a, b, acc, 0, 0, 0); }
        if (kh == 1) red[(F.wave & 3) * 64 + F.lane] = acc;
        __syncthreads();
        if (kh == 0) { const f4 o = acc + red[(F.wave & 3) * 64 + F.lane];
#pragma unroll
            for (int v = 0; v < 4; ++v) FL[(size_t)(row0 + 4 * kg + v) * 16 + r] = o[v]; }
        __syncthreads();
    }
}
__device__ __forceinline__ void combine_rows(Ctx& F) {
    const int gw = F.vcu * NWAVES + F.wave, NGW = F.G * NWAVES;
    const bf16* OP = (const bf16*)(F.ws + WS_OP); const float* LSE = (const float*)(F.ws + WS_LSE); const bf16* PR = (const bf16*)(F.ws + WS_PROJ0); bf16* G = (bf16*)(F.ws + WS_G);
    for (int m = gw; m < M; m += NGW) {
#pragma unroll
        for (int cc = 0; cc < 4; ++cc) { const int col = (cc * 64 + F.lane) * 8, h = col >> 7;
            const float l0 = LSE[(size_t)m * 16 + h], l1 = LSE[((size_t)M + m) * 16 + h], l2 = LSE[((size_t)2 * M + m) * 16 + h];
            const float mx = fmaxf(l0, fmaxf(l1, l2)); const float e0 = __expf(l0 - mx), e1 = __expf(l1 - mx), e2 = __expf(l2 - mx); const float inv = 1.f / (e0 + e1 + e2);
            const float w0 = e0 * inv, w1 = e1 * inv, w2 = e2 * inv;
            const v4u a = *(const GAS v4u*)(OP + (size_t)m * 2048 + col), b = *(const GAS v4u*)(OP + ((size_t)M + m) * 2048 + col), c = *(const GAS v4u*)(OP + ((size_t)2 * M + m) * 2048 + col);
            const v4u z = *(const GAS v4u*)(PR + (size_t)m * N0 + C_Z0 + col);
            v4u o;
#pragma unroll
            for (int q = 0; q < 4; ++q) { const unsigned ua = a[q], ub = b[q], uc = c[q], uz = z[q];
                const float lo = w0 * __uint_as_float(ua << 16) + w1 * __uint_as_float(ub << 16) + w2 * __uint_as_float(uc << 16);
                const float hi = w0 * __uint_as_float(ua & 0xffff0000u) + w1 * __uint_as_float(ub & 0xffff0000u) + w2 * __uint_as_float(uc & 0xffff0000u);
                o[q] = pk2(lo * silu_f(__uint_as_float(uz << 16)), hi * silu_f(__uint_as_float(uz & 0xffff0000u))); }
            *(GAS v4u*)(G + (size_t)m * DM + col) = o; }
    }
}
__device__ __forceinline__ void mla_norm_rows(Ctx& F) {
    const int gw = F.vcu * NWAVES + F.wave, NGW = F.G * NWAVES;
    const bf16* PR = (const bf16*)(F.ws + WS_PROJ1); bf16* CQN = (bf16*)(F.ws + WS_CQN); bf16* CKVN = (bf16*)(F.ws + WS_CKVN); bf16* KR = (bf16*)(F.ws + WS_KROPE); const float* cs = (const float*)(F.ws + WS_CS);
    const float* gq = IN_GQ(F); const float* gkv = IN_GKV(F);
    for (int m = gw; m < M; m += NGW) {
        const bf16* pr = PR + (size_t)m * N1;
        const v4u q0 = *(const GAS v4u*)(pr + C1_CQ + 8 * F.lane), q1 = *(const GAS v4u*)(pr + C1_CQ + 512 + 8 * F.lane), kv = *(const GAS v4u*)(pr + C1_CKV + 8 * F.lane);
        float fq[16], fk[8]; float sq = 0.f, sk = 0.f;
#pragma unroll
        for (int i = 0; i < 4; ++i) { fq[2 * i] = __uint_as_float(q0[i] << 16); fq[2 * i + 1] = __uint_as_float(q0[i] & 0xffff0000u); fq[8 + 2 * i] = __uint_as_float(q1[i] << 16); fq[8 + 2 * i + 1] = __uint_as_float(q1[i] & 0xffff0000u);
            fk[2 * i] = __uint_as_float(kv[i] << 16); fk[2 * i + 1] = __uint_as_float(kv[i] & 0xffff0000u); }
#pragma unroll
        for (int i = 0; i < 16; ++i) sq += fq[i] * fq[i];
#pragma unroll
        for (int i = 0; i < 8; ++i) sk += fk[i] * fk[i];
        const float rq = 1.0f / sqrtf(wave_sum(sq) * (1.f / Q_LORA) + EPS), rk = 1.0f / sqrtf(wave_sum(sk) * (1.f / KV_LORA) + EPS);
        const f32x4 g0a = *(const f32x4*)(gq + 8 * F.lane), g0b = *(const f32x4*)(gq + 8 * F.lane + 4), g1a = *(const f32x4*)(gq + 512 + 8 * F.lane), g1b = *(const f32x4*)(gq + 512 + 8 * F.lane + 4);
        const f32x4 gka = *(const f32x4*)(gkv + 8 * F.lane), gkb = *(const f32x4*)(gkv + 8 * F.lane + 4);
        v4u o0, o1, ok;
        o0.x = pk2(fq[0] * rq * g0a[0], fq[1] * rq * g0a[1]); o0.y = pk2(fq[2] * rq * g0a[2], fq[3] * rq * g0a[3]); o0.z = pk2(fq[4] * rq * g0b[0], fq[5] * rq * g0b[1]); o0.w = pk2(fq[6] * rq * g0b[2], fq[7] * rq * g0b[3]);
        o1.x = pk2(fq[8] * rq * g1a[0], fq[9] * rq * g1a[1]); o1.y = pk2(fq[10] * rq * g1a[2], fq[11] * rq * g1a[3]); o1.z = pk2(fq[12] * rq * g1b[0], fq[13] * rq * g1b[1]); o1.w = pk2(fq[14] * rq * g1b[2], fq[15] * rq * g1b[3]);
        ok.x = pk2(fk[0] * rk * gka[0], fk[1] * rk * gka[1]); ok.y = pk2(fk[2] * rk * gka[2], fk[3] * rk * gka[3]); ok.z = pk2(fk[4] * rk * gkb[0], fk[5] * rk * gkb[1]); ok.w = pk2(fk[6] * rk * gkb[2], fk[7] * rk * gkb[3]);
        *(GAS v4u*)(CQN + (size_t)m * Q_LORA + 8 * F.lane) = o0; *(GAS v4u*)(CQN + (size_t)m * Q_LORA + 512 + 8 * F.lane) = o1; *(GAS v4u*)(CKVN + (size_t)m * KV_LORA + 8 * F.lane) = ok;
        if (F.lane < 32) { const unsigned u = *(const GAS unsigned*)(pr + C1_KR + 2 * F.lane); const float x1 = __uint_as_float(u << 16), x2 = __uint_as_float(u & 0xffff0000u);
            const float cn = cs[(size_t)m * 64 + F.lane], sn = cs[(size_t)m * 64 + 32 + F.lane];
            *(GAS unsigned*)(KR + (size_t)m * 64 + 2 * F.lane) = pk2(x1 * cn - x2 * sn, x1 * sn + x2 * cn); }
    }
}

__device__ __forceinline__ int t5_bucket(int n) {
    if (n < 16) return n;
    const float nf = (float)(n > 1 ? n : 1);
    int large = 16 + (int)(logf(nf / 16.0f) / 4.852030263919617f * 16.0f);
    return large < 31 ? large : 31;
}
__device__ __forceinline__ void dil_ref(unsigned char* ws, int id, at::Ref& R) {
    const int j = id & 31, h = (id >> 5) & 15, b = (id >> 9) & 1, p = id >> 10; const int d = p == 0 ? 1 : (p == 1 ? 4 : 16);
    const int nblk = 32 / d, res = j / nblk, n = j % nblk;
    const at::bf16_t* pr = (const at::bf16_t*)(ws + WS_PROJ0) + ((size_t)b * SEQ + res) * N0 + h * HD;
    const long st = (long)d * N0;
    R.K = pr + C_KA; R.V = pr + C_VA; R.Q = pr + C_QA + (size_t)(256 * n) * st; R.Qr = nullptr; R.Kr = nullptr; R.qs = (int)st; R.ks = (int)st; R.P0 = 256 * n; R.dir = 0; R.jlo = 0;
    const size_t orow = (size_t)b * SEQ + res + (size_t)d * 256 * n;
    R.O = (at::bf16_t*)(ws + WS_OP) + ((size_t)p * M + orow) * 2048 + h * HD; R.os = d * 2048; R.Z = nullptr; R.zs = 0;
    R.LSE = (float*)(ws + WS_LSE) + ((size_t)p * M + orow) * 16 + h; R.ls = d * 16;
}
struct MkDil { unsigned char* ws; __device__ __forceinline__ void operator()(const at::Blk& k, at::Ref& R) const { dil_ref(ws, k.a, R); } };
__device__ __forceinline__ void dilated_phase(Ctx& F) {
    char* lds = (char*)F.lds + RING_OFF;
    const int total = 3 * BATCH * NHA * 32, chunk = (total + F.G - 1) / F.G; int id = F.vcu * chunk; const int end = (id + chunk < total) ? id + chunk : total;
    if (id >= end) return;
    const MkDil mk{F.ws}; int key = -1;
    at::Seam<at::K_DIL> S;
    at::attn_prime<at::K_DIL>(at::Blk{id, 0, 0}, mk, at::DIL_W, lds, S);
    for (;;) {
        const int kcur = ((id >> 10) << 4) | ((id >> 5) & 15);
        if (kcur != key) {
            key = kcur; const int p = key >> 4, h = key & 15, d = p == 0 ? 1 : (p == 1 ? 4 : 16);
            float* tbl = (float*)(lds + at::OFF_BIAS); const float* relb = IN_RELB(F);
            for (int u = F.tid; u < at::TBL_N; u += NWAVES * 64) { const int dist = at::TBL_TOP - u;
                tbl[u] = (dist >= 0 && dist <= 128) ? relb[t5_bucket(dist * d) * NHA + h] * 11.313708498984761f : -__builtin_inff(); }
            __syncthreads();
        }
        const bool last = id + 1 >= end;
        const int dcur = (id >> 10) == 0 ? 1 : ((id >> 10) == 1 ? 4 : 16);
        at::attn_block<at::K_DIL, 0>(at::Blk{id, 0, 0}, at::Blk{last ? id : id + 1, 0, 0}, mk, SEQ / dcur, at::DIL_W, lds, S);
        if (last) break;
        ++id;
    }
}
__device__ __forceinline__ bool causal_sched(const Ctx& F, int s, int npairs_total, int& bh, int& qb, int& dir) {
    if (F.G == 256) { const int x = F.vcu >> 5, i = F.vcu & 31, per = npairs_total / 8, r = s >> 1; if (r >= per) return false;
        bh = 2 * (x * per + r) + (s & 1); qb = (s & 1) ? 31 - i : i; dir = s & 1; return true; }
    const int item = F.vcu + (s >> 1) * F.G; if (item >= npairs_total * 32) return false;
    bh = item >> 4; qb = (s & 1) ? 31 - (item & 15) : (item & 15); dir = 0; return true;
}
__device__ __forceinline__ void fox_ref(unsigned char* ws, int bh, int qb, int jlo, at::Ref& R) {
    const int b = bh >> 4, h = bh & 15;
    const at::bf16_t* pr = (const at::bf16_t*)(ws + WS_PROJ0) + (size_t)b * SEQ * N0 + h * HD;
    R.K = pr + C_KB; R.V = pr + C_VB; R.Q = pr + C_QB + (size_t)(256 * qb) * N0; R.Qr = nullptr; R.Kr = nullptr; R.qs = N0; R.ks = N0; R.P0 = 256 * qb; R.dir = 1  ; R.jlo = jlo;
    const size_t orow = (size_t)b * SEQ + 256 * qb;
    R.O = (at::bf16_t*)(ws + WS_G) + orow * DM + 2048 + h * HD; R.os = DM; R.Z = pr + C_Z0 + 2048 + (size_t)(256 * qb) * N0; R.zs = N0; R.LSE = nullptr; R.ls = 0;
}
struct MkFox { unsigned char* ws; __device__ __forceinline__ void operator()(const at::Blk& k, at::Ref& R) const { fox_ref(ws, k.a, k.b, k.c, R); } };
__device__ __forceinline__ void fox_bias(Ctx& F, int bh, char* lds) {
    int tl = F.tid; asm volatile("" : "+v"(tl));
    const int ll = tl & 63;
    const int b = bh >> 4, h = bh & 15; const float* fl = (const float*)(F.ws + WS_FLOGIT) + ((size_t)b * SEQ + 16 * tl) * 16 + h; const float bf = IN_BF(F)[h];
    float ls[16]; double run = 0.0;
#pragma unroll
    for (int i = 0; i < 16; ++i) { const float xv = fl[i * 16] + bf; ls[i] = (xv >= 0.f) ? -log1pf(expf(-xv)) : xv - log1pf(expf(xv)); run += (double)ls[i]; }
    double inc = run;
#pragma unroll
    for (int o = 1; o < 64; o <<= 1) { const double t = __shfl_up(inc, o); if (ll >= o) inc += t; }
    LAS double* wt = (LAS double*)(lds + at::OFF_WS);
    if (ll == 63) wt[F.wave] = inc;
    __syncthreads();
    double pre = inc - run;
    for (int w = 0; w < F.wave; ++w) pre += wt[w];
    float* bias = (float*)(lds + at::OFF_BIAS) + 16 * tl;
#pragma unroll
    for (int i = 0; i < 16; ++i) { pre += (double)ls[i]; bias[i] = (float)(-pre * 11.313708498984761); }
    __syncthreads();
}
__device__ __forceinline__ int fox_jlo(Ctx& F, int bh, int qb, char* lds) {
    int tl = F.tid; asm volatile("" : "+v"(tl));
    const unsigned* nk = (const unsigned*)(F.ws + WS_NRMK) + (size_t)bh * 512;
    const float* bias = (const float*)(lds + at::OFF_BIAS);
    LAS float* sc = (LAS float*)(lds + at::OFF_WS);
    float sd = 3.0e38f, qn = 0.f;
    if (tl < 256) { const int b = bh >> 4, h = bh & 15;
        const at::bf16_t* rowp = (const at::bf16_t*)(F.ws + WS_PROJ0) + ((size_t)b * SEQ + 256 * qb + tl) * N0 + h * HD;
        float a = 0.f;
#pragma unroll
        for (int c = 0; c < 16; ++c) { const v4u q8 = *(const GAS v4u*)(rowp + C_QB + 8 * c), k8 = *(const GAS v4u*)(rowp + C_KB + 8 * c);
#pragma unroll
            for (int e = 0; e < 4; ++e) { const float ql = __uint_as_float(q8[e] << 16), qh = __uint_as_float(q8[e] & 0xffff0000u);
                a += ql * __uint_as_float(k8[e] << 16); a += qh * __uint_as_float(k8[e] & 0xffff0000u); qn += ql * ql; qn += qh * qh; } }
        sd = a;
#pragma unroll
        for (int o = 1; o < 64; o <<= 1) { sd = fminf(sd, __shfl_xor(sd, o)); qn = fmaxf(qn, __shfl_xor(qn, o)); }
        if ((tl & 63) == 0) { sc[4 + (tl >> 6)] = sd; sc[8 + (tl >> 6)] = qn; } }
    __syncthreads();
    int first = 999; float e = 0.f; bool cand = false;
    if (tl < 128) { const float smin = fminf(fminf(sc[4], sc[5]), fminf(sc[6], sc[7]));
        const uint4 wk = *(const uint4*)(nk + 4 * tl); const float k2 = __uint_as_float(wk.x) + __uint_as_float(wk.y) + __uint_as_float(wk.z) + __uint_as_float(wk.w);
        const float q2 = fmaxf(fmaxf(sc[8], sc[9]), fmaxf(sc[10], sc[11]));
        const float qk = (1.02f * sqrtf(q2) * sqrtf(k2) - smin) * 0.08838834764831845f + 0.01f;
        const float Ft0 = -bias[256 * qb] * 0.08838834764831845f, Fe = -bias[64 * tl + 63] * 0.08838834764831845f;
        cand = tl < 4 * qb;
        e = cand ? 64.0f * __expf(fminf(qk + (Ft0 - Fe), 0.f)) : 1.0f;
#pragma unroll
        for (int o = 1; o < 64; o <<= 1) { const float v = __shfl_up(e, o); if ((tl & 63) >= o) e += v; }
        if ((tl & 63) == 63) sc[12 + (tl >> 6)] = e; }
    __syncthreads();
    if (tl < 128) { const float pre = e + ((tl >> 6) ? sc[12] : 0.f);
        const bool prune = cand && pre < 5.0e-8f;
        const unsigned long long keep = __ballot(!prune);
        first = (tl & 64) + (keep ? __ffsll((long long)keep) - 1 : 64);
        if ((tl & 63) == 0) sc[2 + (tl >> 6)] = __int_as_float(first); }
    __syncthreads();
    const int f0 = __float_as_int(sc[2]), f1 = __float_as_int(sc[3]);
    const int jlo = f0 < 64 ? f0 : f1;
    __syncthreads();
    return __builtin_amdgcn_readfirstlane(jlo);
}
__device__ __forceinline__ void fox_phase(Ctx& F) {
    char* lds = (char*)F.lds + RING_OFF;
    int bias_bh = -1;
    const MkFox mk{F.ws};
    at::Seam<at::K_FOX> S;
    gu32* qh = (gu32*)(F.ws + WS_CTL) + CW_QUEUE;
    LAS int* tick = (LAS int*)(lds + at::OFF_WS + 64);
    for (;;) {
        if (F.tid == 0) *tick = (int)__hip_atomic_fetch_add(qh, 1u, __ATOMIC_RELAXED, __HIP_MEMORY_SCOPE_AGENT);
        __syncthreads();
        const int t = __builtin_amdgcn_readfirstlane(*tick);
        __syncthreads();
        if (t >= BATCH * NHB * 32) break;
        const int qb = 31 - (t >> 5), bh = t & 31;
        if (bh != bias_bh) { fox_bias(F, bh, lds); bias_bh = bh; }
        const int jlo = fox_jlo(F, bh, qb, lds);
        const at::Blk cur{bh, qb, jlo};
        at::attn_prime<at::K_FOX>(cur, mk, 1 << 30, lds, S);
        at::attn_block<at::K_FOX, 0>(cur, cur, mk, SEQ, 1 << 30, lds, S);
    }
}
template <int VAR>
__device__ __forceinline__ void mla_ref(unsigned char* ws, int bh, int qb, int dir, at::Ref& R) {
    const int b = bh >> 5, h = bh & 31;
    const at::bf16_t* qp = (const at::bf16_t*)(ws + WS_QBUF) + ((size_t)b * SEQ + 256 * qb) * NQ; const at::bf16_t* kvp = (const at::bf16_t*)(ws + WS_KVBUF) + (size_t)b * SEQ * NKV;
    R.Q = qp + h * HD; R.Qr = qp + 4096 + h * 64; R.K = kvp + h * HD; R.V = kvp + 4096 + h * HD; R.Kr = (const at::bf16_t*)(ws + WS_KROPE) + (size_t)b * SEQ * 64; R.qs = NQ; R.ks = NKV; R.P0 = 256 * qb; R.dir = dir; R.jlo = 0;
    const size_t orow = (size_t)b * SEQ + 256 * qb;
    R.O = (at::bf16_t*)(ws + WS_G) + orow * DM + h * HD; R.os = DM; R.Z = (const at::bf16_t*)(ws + WS_PROJ1) + orow * N1 + C1_Z + h * HD; R.zs = N1; R.LSE = nullptr; R.ls = 0;
}
template <int VAR> struct MkMla { unsigned char* ws; __device__ __forceinline__ void operator()(const at::Blk& k, at::Ref& R) const { mla_ref<VAR>(ws, k.a, k.b, k.c, R); } };
template <int VAR>
__device__ __forceinline__ void mla_phase(Ctx& F) {
    char* lds = (char*)F.lds + RING_OFF;
    int s = 0; at::Blk cur, nxt;
    if (!causal_sched(F, 0, BATCH * NHC / 2, cur.a, cur.b, cur.c)) return;
    const MkMla<VAR> mk{F.ws};
    t32::Seam S;
    t32::attn_prime(cur, mk, lds, S);
    for (;;) {
        const bool last = !causal_sched(F, s + 1, BATCH * NHC / 2, nxt.a, nxt.b, nxt.c);
        if (last) nxt = cur;
        t32::attn_block(cur, nxt, mk, SEQ, lds, S);
        if (last) break;
        cur = nxt; ++s;
    }
}

__global__ void __launch_bounds__(NWAVES * 64, 2) fwd_kernel(Args args) {
    extern __shared__ __attribute__((aligned(16))) unsigned char lds[];
    Ctx F;
    F.lds = (LAS unsigned char*)lds;
    volatile LAS unsigned* MISC = (volatile LAS unsigned*)(F.lds + MISC_OFF);
    F.tid = threadIdx.x; F.lane = F.tid & 63; F.wave = __builtin_amdgcn_readfirstlane(F.tid >> 6);
    F.G = gridDim.x; { const int bx = blockIdx.x; F.vcu = (F.G % 8 == 0) ? (bx % 8) * (F.G / 8) + bx / 8 : bx; }
    F.A = (const __attribute__((address_space(4))) Args*)__builtin_amdgcn_kernarg_segment_ptr();
    F.out = args.out; F.ws = args.ws;
    unsigned char* ws = args.ws;
    gu32* ctl = (gu32*)(ws + WS_CTL);
    for (int u = F.tid; u < (LDS_BYTES - LDSCTL_OFF) / 4; u += NWAVES * 64) ((LAS unsigned*)(F.lds + LDSCTL_OFF))[u] = 0u;
    __syncthreads();
    XcdBarrier bar; bar.bar = (unsigned*)(ctl + CW_BAR); bar.x = 0; bar.st = nullptr;
    if (!MK_PER_PHASE) bar = xcd_barrier_post((unsigned*)(ctl + CW_BAR), MISC + 8);
    const int lo = args.ph_lo, hi = args.ph_hi;
#define IN(k) (lo <= (k) && (k) < hi)
#define SEAM(k) do { if (IN(k) && IN((k) + 1)) xcd_barrier(bar); } while (0)
    float* mod = (float*)(ws + WS_MOD);
    bf16* XN = (bf16*)(ws + WS_XN); bf16* G = (bf16*)(ws + WS_G);

#define PH0 { p0_prologue(F); }
#define PH1 { adaln_rows(F, IN_X(F), IN_GNORM(F), mod, XN); }
#define PH2 { flogit_rows(F); \
        pg8::Gemm g{XN, (const bf16*)(ws + WS_BT0), M, N0, DM}; pg8::StaticOrder S; S.init(M, N0, F.G, (int)blockIdx.x); \
        pg8::EpiBf16Nrm E{(bf16*)(ws + WS_PROJ0), N0, (unsigned*)(ws + WS_NRMQ), (unsigned*)(ws + WS_NRMK), 1 << 20  , C_KB / 256, SEQ}; \
        pg8::gemm_phase<pg8::EpiBf16Nrm, pg8::StaticOrder, true, true>(F.lds + RING_OFF, g, S, E); }
#define PH3 { dilated_phase(F); __syncthreads(); fox_phase(F); }
#define PH4 { combine_rows(F); }
#define PH5 { pg8::Gemm g{G, (const bf16*)(ws + WS_WO0), M, DM, DM}; pg8::StaticOrder S; S.init(M, DM, F.G, (int)blockIdx.x); \
        pg8::EpiGateBf16 E{(bf16*)(ws + WS_Y1), DM, mod + 2 * DM, 3 * DM, SEQ}; \
        pg8::gemm_phase<pg8::EpiGateBf16, pg8::StaticOrder, true, true>(F.lds + RING_OFF, g, S, E); }
#define PH6 { adaln_add_rows(F, IN_X(F), (const bf16*)(ws + WS_Y1), IN_GNORM(F) + DM, mod + BATCH * 3 * DM, XN); }
#define PH7 { pg8::Gemm g{XN, (const bf16*)(ws + WS_BT1), M, N1, DM}; pg8::StaticOrder S; S.init(M, N1, F.G, (int)blockIdx.x); \
        pg8::EpiBf16<0> E{(bf16*)(ws + WS_PROJ1), N1, nullptr, 0, 0, 1.f}; \
        pg8::gemm_phase<pg8::EpiBf16<0>, pg8::StaticOrder, true, true>(F.lds + RING_OFF, g, S, E); }
#define PH8 { mla_norm_rows(F); }
#define PH9 { { pg8::Gemm g{(const bf16*)(ws + WS_CQN), (const bf16*)(ws + WS_WQB), M, NQ, Q_LORA}; pg8::StaticOrder S; S.init(M, NQ, F.G, (int)blockIdx.x); \
          pg8::EpiQRope E{(bf16*)(ws + WS_QBUF), NQ, (const float*)(ws + WS_CS), 4096, t32::QMUL}; \
          pg8::gemm_phase<pg8::EpiQRope, pg8::StaticOrder, true, true>(F.lds + RING_OFF, g, S, E); } \
        __syncthreads(); \
        { pg8::Gemm g{(const bf16*)(ws + WS_CKVN), (const bf16*)(ws + WS_WKVB), M, NKV, KV_LORA}; pg8::StaticOrder S; S.init(M, NKV, F.G, (int)blockIdx.x); \
          pg8::EpiBf16<0> E{(bf16*)(ws + WS_KVBUF), NKV, nullptr, 0, 0, 1.f}; \
          pg8::gemm_phase<pg8::EpiBf16<0>, pg8::StaticOrder, true, true>(F.lds + RING_OFF, g, S, E); } }
#define PH10 { mla_phase<0>(F); }
#define PH11 { pg8::Gemm g{G, (const bf16*)(ws + WS_WO1), M, DM, DM}; pg8::StaticOrder S; S.init(M, DM, F.G, (int)blockIdx.x); \
        pg8::EpiGateBf16 E{(bf16*)(ws + WS_Y2), DM, mod + BATCH * 3 * DM + 2 * DM, 3 * DM, SEQ}; \
        pg8::gemm_phase<pg8::EpiGateBf16, pg8::StaticOrder, true, true>(F.lds + RING_OFF, g, S, E); }
#define PH12 { final_rows(F); }
#define RUN(k, BODY) do { if (IN(k)) { BODY } SEAM(k); } while (0)
    RUN(0, PH0); RUN(1, PH1); RUN(2, PH2); RUN(3, PH3); RUN(4, PH4); RUN(5, PH5); RUN(6, PH6); RUN(7, PH7); RUN(8, PH8); RUN(9, PH9); RUN(10, PH10);
    if (IN(11)) PH11 SEAM(11);
    if (IN(12)) PH12
#undef IN
#undef SEAM
}

extern "C" void kernel_launch(void* const* d_in, const int* in_sizes, int n_in, void* d_out, int out_size, void* d_ws, size_t ws_size, hipStream_t stream) {
    static int grid = 0;
    if (grid == 0) {
        if (n_in != 17 || in_sizes[0] != M * DM || out_size != M * DM || ws_size < WS_END) { fprintf(stderr, "kernel_launch: unexpected shapes (n_in %d, in0 %d, out %d, ws %zu, need %zu); nothing launched\n", n_in, n_in > 0 ? in_sizes[0] : -1, out_size, ws_size, (size_t)WS_END); grid = -1; return; }
        int dev = 0, cus = 0, per_cu = 0;
        if (hipGetDevice(&dev) != hipSuccess || hipDeviceGetAttribute(&cus, hipDeviceAttributeMultiprocessorCount, dev) != hipSuccess) { grid = -1; return; }
        if (hipFuncSetAttribute((const void*)fwd_kernel, hipFuncAttributeMaxDynamicSharedMemorySize, LDS_BYTES) != hipSuccess) { fprintf(stderr, "kernel_launch: hipFuncSetAttribute failed\n"); grid = -1; return; }
        if (hipOccupancyMaxActiveBlocksPerMultiprocessor(&per_cu, (const void*)fwd_kernel, NWAVES * 64, LDS_BYTES) != hipSuccess || per_cu < 1) { fprintf(stderr, "kernel_launch: occupancy query says %d\n", per_cu); }
        (void)hipGetLastError();
        grid = cus;
    }
    if (grid < 0) return;
    if (hipMemsetAsync((char*)d_ws + WS_CTL, 0, CTL_ZERO_BYTES, stream) != hipSuccess) return;
    Args a{};
    for (int i = 0; i < 17; ++i) a.in[i] = d_in[i];
    a.out = (float*)d_out; a.ws = (unsigned char*)d_ws;
#if MK_PER_PHASE
    for (int p = 0; p < N_PHASES; ++p) { a.ph_lo = p; a.ph_hi = p + 1; hipLaunchKernelGGL(fwd_kernel, dim3(grid), dim3(NWAVES * 64), LDS_BYTES, stream, a); }
#else
    a.ph_lo = 0; a.ph_hi = N_PHASES;
    hipLaunchKernelGGL(fwd_kernel, dim3(grid), dim3(NWAVES * 64), LDS_BYTES, stream, a);
#endif
    const hipError_t le = hipPeekAtLastError();
    if (le != hipSuccess) fprintf(stderr, "kernel_launch: launch failed: %s\n", hipGetErrorName(le));
}
```

```cpp
#include <hip/hip_runtime.h>

#include <cstdio>
#include <cstdint>
#include <cmath>
namespace pg8 {
#define PG8_LAS __attribute__((address_space(3)))
typedef unsigned short bf16_t;
typedef short bf16x8 __attribute__((ext_vector_type(8)));
typedef float f32x4 __attribute__((ext_vector_type(4)));
typedef unsigned u32x4 __attribute__((ext_vector_type(4)));
constexpr int BM = 256, BK = 64, HALF = 128, HTB = HALF * BK * 2  , STAGE_BYTES = 8 * HTB, NXCD = 8, WGM = 8;

__host__ __device__ __forceinline__ int lds_byte(int r, int c) { const int st = (r >> 4) * 2 + (c >> 5), rr = r & 15, cc = c & 31, ob = rr * 64 + cc * 2; return st * 1024 + (ob ^ (((ob >> 9) & 1) << 5)); }
__host__ __device__ __forceinline__ void stage_rc(int b, int& R, int& C) { const int st = b / 1024, sb = b % 1024, swz = sb ^ (((sb >> 9) & 1) << 5); R = (st >> 1) * 16 + swz / 64; C = (st & 1) * 32 + (swz % 64) / 2; }
__host__ __device__ __forceinline__ int perm32(int rho) { const int n = rho >> 4, i = rho & 15; return 8 * (i >> 2) + 4 * n + (i & 3); }

struct Unit { int pm, pn; };
struct Gemm { const bf16_t* A; const bf16_t* Bt; int M, N, K; };

struct StaticOrder {
    int nM, nN, nwg, G, c;
    __host__ __device__ void init(int M, int N, int G_, int c_) { nM = M / BM; nN = N / BM; nwg = nM * nN; G = G_; c = c_; }
    __host__ __device__ bool next(int i, Unit& u) const {
        const long L = (long)i * G + c; if (L >= nwg) return false;
        int wgid = (int)L; { const int q = nwg / NXCD, r = nwg % NXCD, xcd = wgid % NXCD, off = wgid / NXCD; wgid = (xcd < r ? xcd * (q + 1) : r * (q + 1) + (xcd - r) * q) + off; }
        const int nig = WGM * nN, gid = wgid / nig, fm = gid * WGM, gsz = (nM - fm) < WGM ? (nM - fm) : WGM;
        u.pm = fm + ((wgid % nig) % gsz); u.pn = (wgid % nig) / gsz; return true;
    }
    __device__ __forceinline__ void a_ready(const Unit&) const {}
    __device__ __forceinline__ void done(const Unit&) const {}
};

__device__ __forceinline__ unsigned cvt_pk_bf16(float lo, float hi) { unsigned r; asm volatile("v_cvt_pk_bf16_f32 %0, %1, %2" : "=v"(r) : "v"(lo), "v"(hi)); return r; }
typedef float f32x2 __attribute__((ext_vector_type(2)));
__device__ __forceinline__ f32x2 gelu_pk(f32x2 v) {
    const f32x2 av = __builtin_elementwise_abs(v), d = av * 0.2316418882f + 1.0f;
    f32x2 t; t.x = __builtin_amdgcn_rcpf(d.x); t.y = __builtin_amdgcn_rcpf(d.y);
    f32x2 q = t * 0.5307027145f + (-0.7265760135f); q = q * t + 0.7107068705f; q = q * t + (-0.142248368f); q = q * t + 0.127414796f; q = q * t;
    const f32x2 s = (v * v) * (-0.72134752044f);
    f32x2 e; e.x = __builtin_amdgcn_exp2f(s.x); e.y = __builtin_amdgcn_exp2f(s.y);
    const f32x2 m = v * (q * e), r = v - m;
    f32x2 o; o.x = v.x < 0.f ? m.x : r.x; o.y = v.y < 0.f ? m.y : r.y; return o;
}

template <int ACT  > struct EpiBf16 {
    static constexpr bool PERM = true, AFTER_DRAIN = false; static_assert(ACT == 0 || ACT == 1, "EpiBf16: ACT is 0 (none) or 1 (gelu_pk)");
    bf16_t* O; int ldc; const float* bias; int split_cols; size_t split_stride; float scale0;
    __device__ __forceinline__ void operator()(const f32x4 (&acc)[2][2][4][2], const Unit& u, int wr, int wc, int fr, int fq) const {
        const int row0 = u.pm * BM + wr * 64 + fr; int colt = u.pn * BM; bf16_t* base = O;
        float sc = 1.f; if (split_cols) { const int t = colt / split_cols; base += (size_t)t * split_stride; colt -= t * split_cols; if (t == 0) sc = scale0; }
        const int col0 = colt + wc * 32 + 8 * fq, bcol0 = u.pn * BM + wc * 32 + 8 * fq;
        f32x4 bv[2][2];
#pragma unroll
        for (int bj = 0; bj < 2; ++bj)
#pragma unroll
            for (int n = 0; n < 2; ++n) bv[bj][n] = bias ? *(const f32x4*)(bias + bcol0 + bj * HALF + 4 * n) : (f32x4){0.f, 0.f, 0.f, 0.f};
#pragma unroll
        for (int ai = 0; ai < 2; ++ai)
#pragma unroll
            for (int m = 0; m < 4; ++m) { bf16_t* rowp = base + (size_t)(row0 + ai * HALF + m * 16) * ldc + col0;
#pragma unroll
                for (int bj = 0; bj < 2; ++bj) { f32x4 v0 = acc[ai][bj][m][0] + bv[bj][0], v1 = acc[ai][bj][m][1] + bv[bj][1];
                    if (ACT == 1) { f32x2 a = gelu_pk((f32x2){v0[0], v0[1]}), b = gelu_pk((f32x2){v0[2], v0[3]}), c = gelu_pk((f32x2){v1[0], v1[1]}), d = gelu_pk((f32x2){v1[2], v1[3]});
                        v0 = (f32x4){a.x, a.y, b.x, b.y}; v1 = (f32x4){c.x, c.y, d.x, d.y}; }
                    v0 = v0 * sc; v1 = v1 * sc; u32x4 w; w.x = cvt_pk_bf16(v0[0], v0[1]); w.y = cvt_pk_bf16(v0[2], v0[3]); w.z = cvt_pk_bf16(v1[0], v1[1]); w.w = cvt_pk_bf16(v1[2], v1[3]);
                    *(u32x4*)(rowp + bj * HALF) = w; } }
    }
};
struct EpiQRope {
    static constexpr bool PERM = true, AFTER_DRAIN = false;
    bf16_t* O; int ldc; const float* cs; int rope_col0; float qmul;
    __device__ __forceinline__ void operator()(const f32x4 (&acc)[2][2][4][2], const Unit& u, int wr, int wc, int fr, int fq) const {
        const int row0 = u.pm * BM + wr * 64 + fr; const int colt = u.pn * BM;
        const int col0 = colt + wc * 32 + 8 * fq;
        const bool rope = colt >= rope_col0;
        const int j0 = ((wc & 1) * 32 + 8 * fq) >> 1;
#pragma unroll
        for (int ai = 0; ai < 2; ++ai)
#pragma unroll
            for (int m = 0; m < 4; ++m) { const int row = row0 + ai * HALF + m * 16; bf16_t* rowp = O + (size_t)row * ldc + col0;
                f32x4 c = (f32x4){1.f, 1.f, 1.f, 1.f}, s = (f32x4){0.f, 0.f, 0.f, 0.f};
                if (rope) { c = *(const f32x4*)(cs + (size_t)row * 64 + j0); s = *(const f32x4*)(cs + (size_t)row * 64 + 32 + j0); }
                c *= qmul; s *= qmul;
#pragma unroll
                for (int bj = 0; bj < 2; ++bj) { const f32x4 v0 = acc[ai][bj][m][0], v1 = acc[ai][bj][m][1];
                    u32x4 w;
                    w.x = cvt_pk_bf16(v0[0] * c[0] - v0[1] * s[0], v0[0] * s[0] + v0[1] * c[0]);
                    w.y = cvt_pk_bf16(v0[2] * c[1] - v0[3] * s[1], v0[2] * s[1] + v0[3] * c[1]);
                    w.z = cvt_pk_bf16(v1[0] * c[2] - v1[1] * s[2], v1[0] * s[2] + v1[1] * c[2]);
                    w.w = cvt_pk_bf16(v1[2] * c[3] - v1[3] * s[3], v1[2] * s[3] + v1[3] * c[3]);
                    *(u32x4*)(rowp + bj * HALF) = w; } }
    }
};
struct EpiResGate {
    static constexpr bool PERM = false, AFTER_DRAIN = false;
    const float* base; float* out; int ldc; const float* gate; int gate_stride; int rows_per_batch;
    __device__ __forceinline__ void operator()(const f32x4 (&acc)[2][2][4][2], const Unit& u, int wr, int wc, int fr, int fq) const {
        const int col0 = u.pn * BM + wc * 32 + 4 * fq; const int b = (u.pm * BM) / rows_per_batch;
        f32x4 gv[2][2];
#pragma unroll
        for (int bj = 0; bj < 2; ++bj)
#pragma unroll
            for (int n = 0; n < 2; ++n) gv[bj][n] = *(const f32x4*)(gate + (size_t)b * gate_stride + col0 + bj * HALF + n * 16);
#pragma unroll
        for (int ai = 0; ai < 2; ++ai)
#pragma unroll
            for (int m = 0; m < 4; ++m) { const size_t off = (size_t)(u.pm * BM + ai * HALF + wr * 64 + m * 16 + fr) * ldc + col0;
#pragma unroll
                for (int bj = 0; bj < 2; ++bj)
#pragma unroll
                    for (int n = 0; n < 2; ++n) { const f32x4 bs = *(const f32x4*)(base + off + bj * HALF + n * 16);
                        *(f32x4*)(out + off + bj * HALF + n * 16) = bs + gv[bj][n] * acc[ai][bj][m][n]; }
                if (m & 1) asm volatile("" ::: "memory"); }
    }
};

struct EpiBf16Nrm {
    static constexpr bool PERM = true, AFTER_DRAIN = false;
    bf16_t* O; int ldc; unsigned* nq; unsigned* nk; int q_pn0, k_pn0, rows_per_batch;
    __device__ __forceinline__ void operator()(const f32x4 (&acc)[2][2][4][2], const Unit& u, int wr, int wc, int fr, int fq) const {
        const int row0 = u.pm * BM + wr * 64 + fr; const int col0 = u.pn * BM + wc * 32 + 8 * fq;
#pragma unroll
        for (int ai = 0; ai < 2; ++ai)
#pragma unroll
            for (int m = 0; m < 4; ++m) { bf16_t* rowp = O + (size_t)(row0 + ai * HALF + m * 16) * ldc + col0;
#pragma unroll
                for (int bj = 0; bj < 2; ++bj) { const f32x4 v0 = acc[ai][bj][m][0], v1 = acc[ai][bj][m][1];
                    u32x4 w; w.x = cvt_pk_bf16(v0[0], v0[1]); w.y = cvt_pk_bf16(v0[2], v0[3]); w.z = cvt_pk_bf16(v1[0], v1[1]); w.w = cvt_pk_bf16(v1[2], v1[3]);
                    *(u32x4*)(rowp + bj * HALF) = w; } }
        unsigned* dst = nullptr; int h0 = 0;
        if (u.pn >= q_pn0 && u.pn < q_pn0 + 8) { dst = nq; h0 = (u.pn - q_pn0) * 2; } else if (u.pn >= k_pn0 && u.pn < k_pn0 + 8) { dst = nk; h0 = (u.pn - k_pn0) * 2; }
        if (dst) {
            const int rt = u.pm * BM + wr * 64, b = rt / rows_per_batch;
#pragma unroll
            for (int ai = 0; ai < 2; ++ai)
#pragma unroll
                for (int bj = 0; bj < 2; ++bj) { float mx = 0.f;
#pragma unroll
                    for (int m = 0; m < 4; ++m) { const f32x4 a = acc[ai][bj][m][0], c = acc[ai][bj][m][1];
                        float s = (a[0] * a[0] + a[1] * a[1]) + (a[2] * a[2] + a[3] * a[3]) + (c[0] * c[0] + c[1] * c[1]) + (c[2] * c[2] + c[3] * c[3]);
                        s += __shfl_xor(s, 16); s += __shfl_xor(s, 32); mx = fmaxf(mx, s); }
                    mx = fmaxf(mx, __shfl_xor(mx, 1)); mx = fmaxf(mx, __shfl_xor(mx, 2)); mx = fmaxf(mx, __shfl_xor(mx, 4)); mx = fmaxf(mx, __shfl_xor(mx, 8));
                    if (fr == 0 && fq == 0) { const int t64 = ((rt + ai * HALF) % rows_per_batch) / 64;
                        atomicMax(dst + (((size_t)(b * 16 + h0 + bj)) * 128 + t64) * 4 + wc, __float_as_uint(mx)); } }
        }
    }
};

struct EpiGateBf16 {
    static constexpr bool PERM = true, AFTER_DRAIN = false;
    bf16_t* O; int ldc; const float* gate; int gate_stride; int rows_per_batch;
    __device__ __forceinline__ void operator()(const f32x4 (&acc)[2][2][4][2], const Unit& u, int wr, int wc, int fr, int fq) const {
        const int row0 = u.pm * BM + wr * 64 + fr; const int col0 = u.pn * BM + wc * 32 + 8 * fq; const int b = (u.pm * BM) / rows_per_batch;
        f32x4 gv[2][2];
#pragma unroll
        for (int bj = 0; bj < 2; ++bj)
#pragma unroll
            for (int n = 0; n < 2; ++n) gv[bj][n] = *(const f32x4*)(gate + (size_t)b * gate_stride + col0 + bj * HALF + 4 * n);
#pragma unroll
        for (int ai = 0; ai < 2; ++ai)
#pragma unroll
            for (int m = 0; m < 4; ++m) { bf16_t* rowp = O + (size_t)(row0 + ai * HALF + m * 16) * ldc + col0;
#pragma unroll
                for (int bj = 0; bj < 2; ++bj) { const f32x4 v0 = acc[ai][bj][m][0] * gv[bj][0], v1 = acc[ai][bj][m][1] * gv[bj][1];
                    u32x4 w; w.x = cvt_pk_bf16(v0[0], v0[1]); w.y = cvt_pk_bf16(v0[2], v0[3]); w.z = cvt_pk_bf16(v1[0], v1[1]); w.w = cvt_pk_bf16(v1[2], v1[3]);
                    *(u32x4*)(rowp + bj * HALF) = w; } }
    }
};

template <class Epi, class Sched, bool ALIGN_EPI = false, bool SP2 = false>
__device__ __forceinline__ void gemm_phase(PG8_LAS unsigned char* lds, const Gemm g, const Sched& S, const Epi& E) {
    const int tid = threadIdx.x, wid = __builtin_amdgcn_readfirstlane(tid >> 6), lane = tid & 63, wr = wid >> 2, wc = wid & 3, fr = lane & 15, fq = lane >> 4;
    const int K = g.K, nt = K / BK;
    unsigned voffA[2], voffB[2];
#pragma unroll
    for (int i = 0; i < 2; ++i) { int R, C; stage_rc(tid * 16 + i * 8192, R, C); const int Rb = Epi::PERM ? ((R & ~31) + perm32(R & 31)) : R;
        voffA[i] = (unsigned)(R * K + C) * 2u; voffB[i] = (unsigned)(Rb * K + C) * 2u; }
    const size_t kstep = (size_t)(BK * 2);
    const size_t hstep = (size_t)HALF * K * 2;
    const size_t tstep = 2 * hstep;
    const unsigned ldsw = (unsigned)wid * 1024u;
    const int aoff = lds_byte(wr * 64 + fr, fq * 8), boff = lds_byte(wc * 32 + fr, fq * 8);
#define PG8_SA(b, h) (((b) * 2 + (h)) * HTB)
#define PG8_SB(b, h) ((4 + (b) * 2 + (h)) * HTB)
#define PG8_STAGE(bufoff, gbase, voff) do { _Pragma("unroll") for (int _i = 0; _i < 2; ++_i) \
        __builtin_amdgcn_global_load_lds((const unsigned*)((const char*)(gbase) + (voff)[_i]), (PG8_LAS unsigned*)(lds + (bufoff) + ldsw + _i * 8192), 16, 0, 0); } while (0)
#define PG8_LDA(dst, b, h) do { _Pragma("unroll") for (int m = 0; m < 4; ++m) _Pragma("unroll") for (int k = 0; k < 2; ++k) dst[m][k] = *(const PG8_LAS bf16x8*)(lds + PG8_SA(b, h) + aoff + m * 2048 + k * 1024); } while (0)
#define PG8_LDB(dst, b, h) do { _Pragma("unroll") for (int n = 0; n < 2; ++n) _Pragma("unroll") for (int k = 0; k < 2; ++k) dst[n][k] = *(const PG8_LAS bf16x8*)(lds + PG8_SB(b, h) + boff + n * 2048 + k * 1024); } while (0)
#define PG8_MMA(ai, bj, At, Bt) do { __builtin_amdgcn_s_setprio(1); _Pragma("unroll") for (int m = 0; m < 4; ++m) _Pragma("unroll") for (int n = 0; n < 2; ++n) _Pragma("unroll") for (int k = 0; k < 2; ++k) \
        acc[ai][bj][m][n] = __builtin_amdgcn_mfma_f32_16x16x32_bf16(Bt[n][k], At[m][k], acc[ai][bj][m][n], 0, 0, 0); __builtin_amdgcn_s_setprio(0); } while (0)
#define PG8_WAIT_V(n) asm volatile("s_waitcnt vmcnt(" #n ")" ::: "memory")
#define PG8_WAIT_L(n) asm volatile("s_waitcnt lgkmcnt(" #n ")" ::: "memory")
#define PG8_BAR __builtin_amdgcn_s_barrier()
#define PG8_SCHED __builtin_amdgcn_sched_barrier(0)
    Unit cur, nxt; int ui = 0;
    if (!S.next(0, cur)) return;
    f32x4 acc[2][2][4][2];
#pragma unroll
    for (int a = 0; a < 2; ++a)
#pragma unroll
        for (int b = 0; b < 2; ++b)
#pragma unroll
            for (int m = 0; m < 4; ++m)
#pragma unroll
                for (int n = 0; n < 2; ++n) acc[a][b][m][n] = (f32x4){0.f, 0.f, 0.f, 0.f};
    bf16x8 At[4][2], B0[2][2], B1[2][2];
    const char* cA = (const char*)g.A + (size_t)cur.pm * tstep; const char* cB = (const char*)g.Bt + (size_t)cur.pn * tstep;
    S.a_ready(cur);
    if constexpr (SP2) {
        PG8_STAGE(PG8_SB(0, 0), cB, voffB); PG8_STAGE(PG8_SB(0, 1), cB + hstep, voffB); PG8_STAGE(PG8_SA(0, 0), cA, voffA); PG8_STAGE(PG8_SA(0, 1), cA + hstep, voffA);
        if (wr == 1) PG8_BAR;
        PG8_WAIT_V(2); PG8_BAR;
        PG8_STAGE(PG8_SB(1, 0), cB + kstep, voffB); PG8_STAGE(PG8_SA(1, 0), cA + kstep, voffA); PG8_STAGE(PG8_SB(1, 1), cB + hstep + kstep, voffB);
        PG8_WAIT_V(6); PG8_BAR;
    } else {
        PG8_STAGE(PG8_SB(0, 0), cB, voffB); PG8_STAGE(PG8_SA(0, 0), cA, voffA); PG8_STAGE(PG8_SB(0, 1), cB + hstep, voffB); PG8_STAGE(PG8_SA(0, 1), cA + hstep, voffA);
        if (wr == 1) PG8_BAR;
        PG8_WAIT_V(4); PG8_BAR;
        PG8_STAGE(PG8_SB(1, 0), cB + kstep, voffB); PG8_STAGE(PG8_SA(1, 0), cA + kstep, voffA); PG8_STAGE(PG8_SB(1, 1), cB + hstep + kstep, voffB);
        PG8_WAIT_V(6); PG8_BAR;
    }
    for (;;) {
        const bool has_next = S.next(ui + 1, nxt);
        const char* nA = has_next ? (const char*)g.A + (size_t)nxt.pm * tstep : cA; const char* nB = has_next ? (const char*)g.Bt + (size_t)nxt.pn * tstep : cB;
        for (int t = 0; t < nt; t += 2) {
            const bool last = (t == nt - 2);
            const char* a1 = cA + (size_t)(t + 1) * kstep;
            const char* a2 = last ? nA : cA + (size_t)(t + 2) * kstep; const char* b2 = last ? nB : cB + (size_t)(t + 2) * kstep;
            const char* a3 = a2 + kstep; const char* b3 = b2 + kstep;
            if (last && has_next) S.a_ready(nxt);
            if constexpr (SP2) {
            PG8_LDB(B0, 0, 0); PG8_LDB(B1, 0, 1); PG8_SCHED; PG8_LDA(At, 0, 0); PG8_STAGE(PG8_SA(1, 1), a1 + hstep, voffA);
            PG8_WAIT_V(8); PG8_WAIT_L(0); PG8_BAR; PG8_MMA(0, 0, At, B0); PG8_MMA(0, 1, At, B1); PG8_BAR; PG8_SCHED;
            PG8_LDA(At, 0, 1); PG8_STAGE(PG8_SB(0, 0), b2, voffB); PG8_STAGE(PG8_SB(0, 1), b2 + hstep, voffB); PG8_STAGE(PG8_SA(0, 0), a2, voffA);
            PG8_WAIT_V(8); PG8_WAIT_L(0); PG8_BAR; PG8_MMA(1, 0, At, B0); PG8_MMA(1, 1, At, B1); PG8_BAR; PG8_SCHED;
            PG8_LDB(B0, 1, 0); PG8_LDB(B1, 1, 1); PG8_SCHED; PG8_LDA(At, 1, 0); PG8_STAGE(PG8_SA(0, 1), a2 + hstep, voffA);
            PG8_WAIT_V(8); PG8_WAIT_L(0); PG8_BAR; PG8_MMA(0, 0, At, B0); PG8_MMA(0, 1, At, B1); PG8_BAR; PG8_SCHED;
            PG8_LDA(At, 1, 1); PG8_STAGE(PG8_SB(1, 0), b3, voffB); PG8_STAGE(PG8_SB(1, 1), b3 + hstep, voffB); PG8_STAGE(PG8_SA(1, 0), a3, voffA);
            PG8_WAIT_V(8); PG8_WAIT_L(0); PG8_BAR; PG8_MMA(1, 0, At, B0); PG8_MMA(1, 1, At, B1); PG8_BAR; PG8_SCHED;
            } else {
            PG8_LDB(B0, 0, 0); PG8_SCHED; PG8_LDA(At, 0, 0); PG8_STAGE(PG8_SA(1, 1), a1 + hstep, voffA);
            PG8_WAIT_L(8); PG8_BAR; PG8_WAIT_L(0); PG8_MMA(0, 0, At, B0); PG8_BAR; PG8_SCHED;
            PG8_LDB(B1, 0, 1); PG8_STAGE(PG8_SB(0, 0), b2, voffB);
            PG8_BAR; PG8_WAIT_L(0); PG8_MMA(0, 1, At, B1); PG8_BAR;
            PG8_LDA(At, 0, 1); PG8_STAGE(PG8_SA(0, 0), a2, voffA);
            PG8_BAR; PG8_WAIT_L(0); PG8_MMA(1, 0, At, B0); PG8_BAR; PG8_SCHED;
            PG8_STAGE(PG8_SB(0, 1), b2 + hstep, voffB);
            PG8_WAIT_V(6); PG8_BAR; PG8_MMA(1, 1, At, B1); PG8_BAR;
            PG8_LDB(B0, 1, 0); PG8_SCHED; PG8_LDA(At, 1, 0); PG8_STAGE(PG8_SA(0, 1), a2 + hstep, voffA);
            PG8_WAIT_L(8); PG8_BAR; PG8_WAIT_L(0); PG8_MMA(0, 0, At, B0); PG8_BAR; PG8_SCHED;
            PG8_LDB(B1, 1, 1); PG8_STAGE(PG8_SB(1, 0), b3, voffB);
            PG8_BAR; PG8_WAIT_L(0); PG8_MMA(0, 1, At, B1); PG8_BAR;
            PG8_LDA(At, 1, 1); PG8_STAGE(PG8_SA(1, 0), a3, voffA);
            PG8_BAR; PG8_WAIT_L(0); PG8_MMA(1, 0, At, B0); PG8_BAR; PG8_SCHED;
            PG8_STAGE(PG8_SB(1, 1), b3 + hstep, voffB);
            PG8_WAIT_V(6); PG8_BAR; PG8_MMA(1, 1, At, B1); PG8_BAR;
            }
        }
        if constexpr (ALIGN_EPI) { if (wr == 0) PG8_BAR; }
        if constexpr (!Epi::AFTER_DRAIN) { E(acc, cur, wr, wc, fr, fq); S.done(cur); }
        if (!has_next) break;
#pragma unroll
        for (int a = 0; a < 2; ++a)
#pragma unroll
            for (int b = 0; b < 2; ++b)
#pragma unroll
                for (int m = 0; m < 4; ++m)
#pragma unroll
                    for (int n = 0; n < 2; ++n) acc[a][b][m][n] = (f32x4){0.f, 0.f, 0.f, 0.f};
        cur = nxt; cA = nA; cB = nB; ++ui;
        if constexpr (ALIGN_EPI) { if (wr == 1) PG8_BAR; }
    }
    PG8_WAIT_V(0);
    if constexpr (!ALIGN_EPI) { if (wr == 0) PG8_BAR; }
    PG8_BAR;
    if constexpr (Epi::AFTER_DRAIN) { E.fused(acc, cur, wr, wc, fr, fq, lds, wid, lane); S.done(cur); }
#undef PG8_SA
#undef PG8_SB
#undef PG8_STAGE
#undef PG8_LDA
#undef PG8_LDB
#undef PG8_MMA
#undef PG8_WAIT_V
#undef PG8_WAIT_L
#undef PG8_BAR
#undef PG8_SCHED
}
}
namespace at {
typedef unsigned short bf16_t;
typedef short bf16x8 __attribute__((ext_vector_type(8)));
typedef short s16x4 __attribute__((ext_vector_type(4)));
typedef float f32x16 __attribute__((ext_vector_type(16)));
typedef float f32x4 __attribute__((ext_vector_type(4)));
typedef unsigned u32x4 __attribute__((ext_vector_type(4)));
enum { K_DIL = 0, K_FOX = 1, K_MLA = 2 };
constexpr int NW = 8, QBLK = 32, KVBLK = 64, QB = NW * QBLK, D = 128;
constexpr int SHM_V = KVBLK * D * 2, K_ROW = 272, SHM_K = KVBLK * K_ROW, KR_ROW = 144, SHM_KR = KVBLK * KR_ROW;
constexpr int OFF_V = 0, OFF_K = 2 * SHM_V, OFF_KR = OFF_K + 2 * SHM_K, OFF_WS = OFF_KR + 2 * SHM_KR, OFF_BIAS = OFF_WS + NW * 64 * 4, BIAS_BYTES = 32768, LDS_BYTES = OFF_BIAS + BIAS_BYTES;
constexpr int DIL_W = 129, TBL_N = 640, TBL_TOP = 383;
template <int KIND> struct Cfg;
template <> struct Cfg<K_DIL> { static constexpr float SCALE = 0.08838834764831845f; static constexpr int NQ = 8; static constexpr bool SK = true; };
template <> struct Cfg<K_FOX> { static constexpr float SCALE = 0.08838834764831845f; static constexpr int NQ = 8; static constexpr bool SK = false; };
template <> struct Cfg<K_MLA> { static constexpr float SCALE = 0.07216878364870322f; static constexpr int NQ = 12; static constexpr bool SK = false; };
constexpr float THR = 8.f;

#define KSWZ(row, colB) ((row) * K_ROW + (colB))
#define SBAR() __builtin_amdgcn_sched_barrier(0)
__device__ __forceinline__ int v_st(int k, int c) { const int kk = (k & ~0xC) | ((k & 4) << 1) | ((k & 8) >> 1); return ((kk >> 3) * 4 + (c >> 5)) * 512 + ((kk & 7) * 32 + (c & 31)) * 2; }
__device__ __forceinline__ int v_rd_base(int lane) { return ((lane & 3) << 3) | (((lane >> 2) & 3) << 6) | (((lane >> 4) & 1) << 5) | (((lane >> 5) & 1) << 8); }
constexpr int v_rd_off(int d0, int ks, int half) { return d0 * 512 + ks * 4096 + half * 2048; }
__device__ __forceinline__ int crow(int r, int hi) { return (r & 3) + 8 * (r >> 2) + 4 * hi; }
typedef float f32x2_t __attribute__((ext_vector_type(2))); typedef __bf16 bf16x2_t __attribute__((ext_vector_type(2)));
__device__ __forceinline__ unsigned cvtpk(float lo, float hi) { f32x2_t v = {lo, hi}; bf16x2_t b = __builtin_convertvector(v, bf16x2_t); return __builtin_bit_cast(unsigned, b); }
__device__ __forceinline__ bf16x8 ld8(const bf16_t* p) { return *reinterpret_cast<const bf16x8*>(p); }
__device__ __forceinline__ float bf2f(unsigned short h) { return __uint_as_float(((unsigned)h) << 16); }
__device__ __forceinline__ void mask_tile(f32x16& p0, f32x16& p1, int dq, unsigned W) {
    const float NEG = -__builtin_inff();
#pragma unroll
    for (int r = 0; r < 16; ++r) {
        const int c = (r & 3) + 8 * (r >> 2);
        if ((unsigned)(dq - c) >= W) p0[r] = NEG;
        if ((unsigned)(dq - c - 32) >= W) p1[r] = NEG;
    }
}
template <int KIND, bool NOEXP = false>
__device__ __forceinline__ void partialSM(f32x16& p0, f32x16& p1, float& m_reg, float& mn, float& alpha) {
    constexpr float SCALE = Cfg<KIND>::SCALE;
    float ma = p0[0], mb = p0[8], mc = p1[0], md = p1[8];
#pragma unroll
    for (int r = 1; r < 8; ++r) { ma = fmaxf(ma, p0[r]); mb = fmaxf(mb, p0[8 + r]); mc = fmaxf(mc, p1[r]); md = fmaxf(md, p1[8 + r]); }
    float pmax = fmaxf(fmaxf(ma, mb), fmaxf(mc, md));
    constexpr float C2 = 1.4426950408889634f * SCALE;
    if (__builtin_expect(__all((pmax - m_reg) * SCALE <= THR), 1)) { mn = m_reg; alpha = 1.f; }
    else { { auto rr = __builtin_amdgcn_permlane32_swap(__float_as_uint(pmax), __float_as_uint(pmax), false, false); pmax = fmaxf(__uint_as_float(rr[0]), __uint_as_float(rr[1])); }
           mn = fmaxf(m_reg, pmax); alpha = __builtin_amdgcn_exp2f((m_reg - mn) * C2); m_reg = mn; }
    const float mnL = -mn * C2;
    for (int r = 0; r < 16; ++r) p0[r] = fmaf(p0[r], C2, mnL); for (int r = 0; r < 16; ++r) p1[r] = fmaf(p1[r], C2, mnL);
    if constexpr (!NOEXP) { for (int r = 0; r < 16; ++r) p0[r] = __builtin_amdgcn_exp2f(p0[r]); }
}
template <bool NOEXP = false>
__device__ __forceinline__ void finishSM(f32x16& p0, f32x16& p1, bf16x8& pa0, bf16x8& pa1, bf16x8& pa2, bf16x8& pa3) {
    if constexpr (!NOEXP) { for (int r = 0; r < 16; ++r) p1[r] = __builtin_amdgcn_exp2f(p1[r]); }
#define PK4(P, B_, OUT) do { unsigned a0 = cvtpk(P[B_+0], P[B_+1]), a1 = cvtpk(P[B_+2], P[B_+3]);                          \
        unsigned b0 = cvtpk(P[B_+4], P[B_+5]), b1 = cvtpk(P[B_+6], P[B_+7]);                                             \
        auto r0 = __builtin_amdgcn_permlane32_swap(a0, b0, false, false); auto r1 = __builtin_amdgcn_permlane32_swap(a1, b1, false, false); \
        u32x4 w = {r0[0], r1[0], r0[1], r1[1]}; OUT = *reinterpret_cast<bf16x8*>(&w); } while (0)
    PK4(p0, 0, pa0); PK4(p0, 8, pa1); PK4(p1, 0, pa2); PK4(p1, 8, pa3);
#undef PK4
}
template <int KIND, int KB, bool NOROPE = false>
__device__ __forceinline__ void qkt(f32x16& p0, f32x16& p1, const char* lds, int r32, int hi, const bf16x8* qr, bool act, int bofs) {
    constexpr bool SK = Cfg<KIND>::SK;
    if (SK && !act) { const float NEG = -__builtin_inff();
#pragma unroll
        for (int r = 0; r < 16; ++r) { p0[r] = NEG; p1[r] = NEG; } return; }
    if constexpr (KIND == K_FOX) { const float* bp = reinterpret_cast<const float*>(lds + OFF_BIAS) + bofs;
#pragma unroll
        for (int g = 0; g < 4; ++g) { const f32x4 a = *reinterpret_cast<const f32x4*>(bp + 8 * g), b = *reinterpret_cast<const f32x4*>(bp + 32 + 8 * g);
            p0[4 * g] = a[0]; p0[4 * g + 1] = a[1]; p0[4 * g + 2] = a[2]; p0[4 * g + 3] = a[3]; p1[4 * g] = b[0]; p1[4 * g + 1] = b[1]; p1[4 * g + 2] = b[2]; p1[4 * g + 3] = b[3]; } }
    else if constexpr (KIND == K_DIL) { const float* bp = reinterpret_cast<const float*>(lds + OFF_BIAS) + bofs;
#pragma unroll
        for (int r = 0; r < 16; ++r) { const int c = (r & 3) + 8 * (r >> 2); p0[r] = bp[c]; p1[r] = bp[c + 32]; } }
    else { p0 = f32x16{}; p1 = f32x16{}; }
    const char* kbp = lds + OFF_K + KB * SHM_K + r32 * K_ROW + hi * 16;
#pragma unroll
    for (int d0 = 0; d0 < 8; ++d0) { const char* a = kbp + d0 * 32;
        bf16x8 b0 = *reinterpret_cast<const bf16x8*>(a);
        bf16x8 b1 = *reinterpret_cast<const bf16x8*>(a + 32 * K_ROW);
        p0 = __builtin_amdgcn_mfma_f32_32x32x16_bf16(b0, qr[d0], p0, 0, 0, 0);
        p1 = __builtin_amdgcn_mfma_f32_32x32x16_bf16(b1, qr[d0], p1, 0, 0, 0); }
    if constexpr (KIND == K_MLA && !NOROPE) {
        const char* krb = lds + OFF_KR + KB * SHM_KR + r32 * KR_ROW + hi * 16;
#pragma unroll
        for (int d0 = 0; d0 < 4; ++d0) { const char* a = krb + d0 * 32;
            bf16x8 b0 = *reinterpret_cast<const bf16x8*>(a);
            bf16x8 b1 = *reinterpret_cast<const bf16x8*>(a + 32 * KR_ROW);
            const bf16x8 qf = *reinterpret_cast<const bf16x8*>(lds + OFF_BIAS + bofs + d0 * 1024);
            p0 = __builtin_amdgcn_mfma_f32_32x32x16_bf16(b0, qf, p0, 0, 0, 0);
            p1 = __builtin_amdgcn_mfma_f32_32x32x16_bf16(b1, qf, p1, 0, 0, 0); } }
#define SGB(mask, n) __builtin_amdgcn_sched_group_barrier(mask, n, 0)
    constexpr int LA = 3;
    if constexpr (KIND == K_FOX) SGB(0x100, 8);
    SGB(0x100, 2 * LA);
#pragma unroll
    for (int i = 0; i < 8 - LA; ++i) { SGB(0x008, 2); SGB(0x100, 2); }
    if constexpr (KIND == K_MLA && !NOROPE) {
#pragma unroll
        for (int i = 0; i < 4; ++i) { SGB(0x008, 2); SGB(0x100, 3); }
    }
    SGB(0x008, 2 * LA);
#undef SGB
}
template <int VB, bool SK>
__device__ __forceinline__ void pv_tile(f32x16* o, f32x16& ol, int vb0, bf16x8 pa0, bf16x8 pa1, bf16x8 pa2, bf16x8 pa3, bool act) {
    if (SK && !act) return;
#define TRRD(dst, off) asm volatile("ds_read_b64_tr_b16 %0, %1 offset:%2" : "=&v"(dst) : "v"(vb0), "i"(off) : "memory")
#define PV_D0(d0) do { s16x4 l0, l1, l2, l3, h0, h1, h2, h3; constexpr int b_ = OFF_V + VB * SHM_V + v_rd_off(d0, 0, 0);   \
        TRRD(l0, b_); TRRD(h0, b_ + 2048); TRRD(l1, b_ + 4096); TRRD(h1, b_ + 6144); TRRD(l2, b_ + 8192); TRRD(h2, b_ + 10240); TRRD(l3, b_ + 12288); TRRD(h3, b_ + 14336); \
        asm volatile("s_waitcnt lgkmcnt(0)" ::: "memory"); SBAR();   \
        o[d0] = __builtin_amdgcn_mfma_f32_32x32x16_bf16(pa0, (bf16x8){l0[0], l0[1], l0[2], l0[3], h0[0], h0[1], h0[2], h0[3]}, o[d0], 0, 0, 0);   \
        o[d0] = __builtin_amdgcn_mfma_f32_32x32x16_bf16(pa1, (bf16x8){l1[0], l1[1], l1[2], l1[3], h1[0], h1[1], h1[2], h1[3]}, o[d0], 0, 0, 0);   \
        o[d0] = __builtin_amdgcn_mfma_f32_32x32x16_bf16(pa2, (bf16x8){l2[0], l2[1], l2[2], l2[3], h2[0], h2[1], h2[2], h2[3]}, o[d0], 0, 0, 0);   \
        o[d0] = __builtin_amdgcn_mfma_f32_32x32x16_bf16(pa3, (bf16x8){l3[0], l3[1], l3[2], l3[3], h3[0], h3[1], h3[2], h3[3]}, o[d0], 0, 0, 0); } while (0)
    PV_D0(0); PV_D0(1); PV_D0(2); PV_D0(3);
    { const bf16x8 ones = (bf16x8){0x3F80, 0x3F80, 0x3F80, 0x3F80, 0x3F80, 0x3F80, 0x3F80, 0x3F80};
      ol = __builtin_amdgcn_mfma_f32_32x32x16_bf16(pa0, ones, ol, 0, 0, 0); ol = __builtin_amdgcn_mfma_f32_32x32x16_bf16(pa1, ones, ol, 0, 0, 0);
      ol = __builtin_amdgcn_mfma_f32_32x32x16_bf16(pa2, ones, ol, 0, 0, 0); ol = __builtin_amdgcn_mfma_f32_32x32x16_bf16(pa3, ones, ol, 0, 0, 0); }
#undef PV_D0
#undef TRRD
}

struct Ref { const bf16_t* Q; const bf16_t* K; const bf16_t* V; const bf16_t* Qr; const bf16_t* Kr; int qs, ks; int P0; int dir; int jlo; bf16_t* O; int os; const bf16_t* Z; int zs; float* LSE; int ls; };
template <int KIND> struct Seam { bf16x8 qr[Cfg<KIND>::NQ]; bf16x8 st_v0, st_v1, st_k0, st_k1, st_kr; };
__device__ __forceinline__ int swa_jlo(int P0, int W) { const int lowk = P0 - W + 1; return lowk > 0 ? lowk / KVBLK : 0; }
#define VMW() asm volatile("s_waitcnt vmcnt(0)" ::: "memory")
#define VMWN(n) asm volatile("s_waitcnt vmcnt(%0)" :: "i"(n) : "memory")
#define SLOAD_K(R, k0, TO, TID) do { const bf16_t* kb_ = (R).K + (size_t)(k0) * (R).ks; S.st_k0 = ld8(kb_ + (TO)); S.st_k1 = ld8(kb_ + (size_t)32 * (R).ks + (TO));   \
                            if constexpr (KIND == K_MLA) S.st_kr = ld8((R).Kr + (size_t)(k0) * 64 + (TID) * 8); } while (0)
#define SLOAD_V(R, k0, TO) do { const bf16_t* vb_ = (R).V + (size_t)(k0) * (R).ks; S.st_v0 = ld8(vb_ + (TO)); S.st_v1 = ld8(vb_ + (size_t)32 * (R).ks + (TO)); } while (0)
#define SW_OFFS() int tw_ = tid; asm volatile("" : "+v"(tw_)); const int sr_ = tw_ >> 4, sc_ = (tw_ & 15) * 8; (void)sr_; (void)sc_
#define SWRITE_HK(bf) do { SW_OFFS(); const int kws_ = KSWZ(sr_, sc_ * 2); *(bf16x8*)(K_lds + (bf) * SHM_K + kws_) = S.st_k0; *(bf16x8*)(K_lds + (bf) * SHM_K + kws_ + 32 * K_ROW) = S.st_k1;                 \
                           if constexpr (KIND == K_MLA) *(bf16x8*)(KR_lds + (bf) * SHM_KR + (tw_ >> 3) * KR_ROW + (tw_ & 7) * 16) = S.st_kr; } while (0)
#define SWRITE_HV(bf) do { SW_OFFS(); *(bf16x8*)(V_lds + (bf) * SHM_V + v_st(sr_, sc_)) = S.st_v0; *(bf16x8*)(V_lds + (bf) * SHM_V + v_st(32 + sr_, sc_)) = S.st_v1; } while (0)
#define QLOAD(R, R32, HI) do { const bf16_t* qb_ = (R).Q + (size_t)(wid * QBLK) * (R).qs; const unsigned qo_ = (unsigned)((R32) * (R).qs + (HI) * 8);                             \
                      _Pragma("unroll") for (int d0 = 0; d0 < 8; ++d0) S.qr[d0] = ld8(qb_ + qo_ + d0 * 16); } while (0)
#define QLOAD_R(R, R32, HI) do { if constexpr (KIND == K_MLA) { const bf16_t* qb_ = (R).Qr + (size_t)(wid * QBLK) * (R).qs; const unsigned qo_ = (unsigned)((R32) * (R).qs + (HI) * 8);     \
                      _Pragma("unroll") for (int d0 = 0; d0 < 4; ++d0) S.qr[8 + d0] = ld8(qb_ + qo_ + d0 * 16); } } while (0)
#define BAR() do { asm volatile("s_waitcnt lgkmcnt(0)" ::: "memory"); __builtin_amdgcn_s_barrier(); asm volatile("" ::: "memory"); } while (0)
struct Blk { int a, b, c; };
#define LAUNDER_BLK(x) asm volatile("" : "+s"((x).a), "+s"((x).b), "+s"((x).c))
template <int KIND, class MK>
__device__ __forceinline__ void attn_prime(const Blk cb, const MK& mk, int W, char* lds, Seam<KIND>& S) {
    const int tid = threadIdx.x, wid = __builtin_amdgcn_readfirstlane(tid >> 6), lane = tid & 63, r32 = lane & 31, hi = lane >> 5;
    const int sr = tid >> 4, sc = (tid & 15) * 8;
    char* K_lds = lds + OFF_K; char* KR_lds = lds + OFF_KR; (void)KR_lds;
    Ref cur; mk(cb, cur);
    const int kb0 = cur.dir ? ((cur.P0 + QB - 1) / KVBLK) * KVBLK : (KIND == K_FOX ? cur.jlo : swa_jlo(cur.P0, W)) * KVBLK, kb1 = cur.dir ? kb0 - KVBLK : kb0 + KVBLK; const unsigned toff = (unsigned)(sr * cur.ks + sc);
    QLOAD(cur, r32, hi); QLOAD_R(cur, r32, hi);
    SLOAD_K(cur, kb0, toff, tid); VMW(); SWRITE_HK(0);
    SLOAD_K(cur, kb1, toff, tid); SLOAD_V(cur, kb0, toff);
    __syncthreads();
}
template <int KIND, int VAR = 0, class MK>
__device__ __forceinline__ void attn_block(const Blk cb, const Blk nb, const MK& mk, int skv, int W, char* lds, Seam<KIND>& S) {
    constexpr bool SK = Cfg<KIND>::SK; constexpr float SCALE = Cfg<KIND>::SCALE; constexpr int NQL = Cfg<KIND>::NQ;
    constexpr bool NOGATE = (VAR & 1) != 0, NOEXP = (VAR & 4) != 0, NOROPE = (VAR & 8) != 0, NOPV = (VAR & 16) != 0, NOSM = (VAR & 32) != 0, NOSTAGE = (VAR & 128) != 0, NOQK = (VAR & 256) != 0;
    const int tid = threadIdx.x, wid = __builtin_amdgcn_readfirstlane(tid >> 6), lane = tid & 63, r32 = lane & 31, hi = lane >> 5;
    const int grp = wid >> 2;
    Ref cur; mk(cb, cur);
    const int j_lo = KIND == K_FOX ? cur.jlo : swa_jlo(cur.P0, W);
    int j_hi = (cur.P0 + QB - 1) / KVBLK + 1; if (j_hi > skv / KVBLK) j_hi = skv / KVBLK;
    const int NT = j_hi - j_lo;
    const int qlo = cur.P0 + wid * QBLK, qm = qlo + r32 - 4 * hi;
    char* V_lds = lds + OFF_V; char* K_lds = lds + OFF_K; char* KR_lds = lds + OFF_KR; (void)KR_lds;
    float* ws = (float*)(lds + OFF_WS) + wid * 64; float* li_l = ws, * al_l = ws + 32;
    float m_reg = -1e30f; f32x16 o[4] = {}; f32x16 ol = {};
    const int sr = tid >> 4, sc = (tid & 15) * 8;
    const int vb0 = (int)(uintptr_t)V_lds + v_rd_base(lane);
    const unsigned toff = (unsigned)(sr * cur.ks + sc);
    int tq_ = tid; asm volatile("" : "+v"(tq_));
    const int qrofs = wid * 4096 + (tq_ & 63) * 16;
#define RESC(a) do { if (__any((a) < 1.f)) { if (hi == 0) al_l[r32] = (a); asm volatile("s_waitcnt lgkmcnt(0)" ::: "memory");              \
                     for (int r = 0; r < 16; ++r) { const float a_ = al_l[crow(r, hi)]; ol[r] *= a_; for (int d_ = 0; d_ < 4; ++d_) o[d_][r] *= a_; } } } while (0)
#define KBASE(t) ((cur.dir ? j_hi - 1 - (t) : j_lo + (t)) * KVBLK)
#define ACT(t) (KBASE(t) <= qlo + QBLK - 1 && KBASE(t) + KVBLK - 1 >= qlo - W + 1)
#define BOFS(t) (KIND == K_FOX ? KBASE(t) + 4 * hi : (KIND == K_DIL ? TBL_TOP - (qm - KBASE(t)) : qrofs))
#define MASKT(P0_, P1_, t) do { if constexpr (KIND != K_DIL) { const int kb_ = KBASE(t); if ((!SK || ACT(t)) && (kb_ + KVBLK - 1 > qlo || kb_ <= qlo + QBLK - 1 - W)) mask_tile(P0_, P1_, qm - kb_, (unsigned)W); } } while (0)
    f32x16 p0 = {}, p1 = {}; float mn, al; bf16x8 pa0 = {}, pa1 = {}, pa2 = {}, pa3 = {};
#define SLOT(i) do { if constexpr (NOSTAGE) break; VMW(); { SW_OFFS(); const int vst_ = v_st(sr_, sc_), kws_ = KSWZ(sr_, sc_ * 2);     \
                     if ((i) < NT) { *(bf16x8*)(V_lds + ((i) & 1) * SHM_V + vst_) = S.st_v0; *(bf16x8*)(V_lds + ((i) & 1) * SHM_V + vst_ + 8192) = S.st_v1; }                       \
                     if ((i) + 1 < NT) { *(bf16x8*)(K_lds + (((i) + 1) & 1) * SHM_K + kws_) = S.st_k0; *(bf16x8*)(K_lds + (((i) + 1) & 1) * SHM_K + kws_ + 32 * K_ROW) = S.st_k1;          \
                         if constexpr (KIND == K_MLA) *(bf16x8*)(KR_lds + (((i) + 1) & 1) * SHM_KR + (tw_ >> 3) * KR_ROW + (tw_ & 7) * 16) = S.st_kr; } } SBAR();                       \
                     if ((i) + 1 < NT) SLOAD_V(cur, KBASE((i) + 1), toff); if ((i) + 2 < NT) SLOAD_K(cur, KBASE((i) + 2), toff, tid); SBAR(); } while (0)
#define SMSEG(t) do { if constexpr (NOSM) break; SBAR(); if (!SK || ACT(t)) { MASKT(p0, p1, (t)); partialSM<KIND, NOEXP>(p0, p1, m_reg, mn, al); SBAR(); finishSM<NOEXP>(p0, p1, pa0, pa1, pa2, pa3); SBAR(); RESC(al); } SBAR(); } while (0)
#define MSEG(t, KB, VB) do { SBAR(); if constexpr (!NOPV) { if ((t) > 0) pv_tile<VB, SK>(o, ol, vb0, pa0, pa1, pa2, pa3, ACT((t) - 1)); } SBAR();         \
                             if constexpr (!NOQK) qkt<KIND, KB, NOROPE>(p0, p1, lds, r32, hi, S.qr, ACT(t), BOFS(t)); SBAR(); } while (0)
#define STEP(t, KB, VB) do { MSEG(t, KB, VB); BAR(); SLOT((t) + grp); SMSEG(t); BAR(); } while (0)
    if constexpr (KIND == K_MLA) {
#pragma unroll
        for (int d0 = 0; d0 < 4; ++d0) *(bf16x8*)(lds + OFF_BIAS + qrofs + d0 * 1024) = S.qr[8 + d0]; }
    if (grp) { SLOT(0); BAR(); }
    int t = 0;
    for (; t + 1 < NT; t += 2) { STEP(t, 0, 1); STEP(t + 1, 1, 0); }
    if (t < NT) { STEP(t, 0, 1); }
    int tid_t = tid; asm volatile("" : "+v"(tid_t));
    Blk nb2 = nb; LAUNDER_BLK(nb2); Ref nxt; mk(nb2, nxt);
    const int kbn0 = nxt.dir ? ((nxt.P0 + QB - 1) / KVBLK) * KVBLK : (KIND == K_FOX ? nxt.jlo : swa_jlo(nxt.P0, W)) * KVBLK, kbn1 = nxt.dir ? kbn0 - KVBLK : kbn0 + KVBLK;
    const int r32t = tid_t & 31, hit = (tid_t >> 5) & 1; const unsigned toffn = (unsigned)((tid_t >> 4) * nxt.ks + (tid_t & 15) * 8);
    if constexpr (!NOPV) { if (((NT - 1) & 1) != 0) pv_tile<1, SK>(o, ol, vb0, pa0, pa1, pa2, pa3, ACT(NT - 1)); else pv_tile<0, SK>(o, ol, vb0, pa0, pa1, pa2, pa3, ACT(NT - 1)); }
    SBAR(); SLOAD_K(nxt, kbn0, toffn, tid_t); SBAR(); QLOAD(nxt, r32t, hit); QLOAD_R(nxt, r32t, hit); SBAR();
    BAR();
    VMWN(NQL); SWRITE_HK(0); SBAR(); SLOAD_K(nxt, kbn1, toffn, tid_t); SLOAD_V(nxt, kbn0, toffn); SBAR();
    BAR();
    if (grp == 0) BAR();
    Blk cb2 = cb; LAUNDER_BLK(cb2); Ref ce; mk(cb2, ce);
    if constexpr (KIND == K_DIL) {
        if (r32t == 0) {
#pragma unroll
            for (int r = 0; r < 16; ++r) li_l[crow(r, hit)] = ol[r]; }
        asm volatile("s_waitcnt lgkmcnt(0)" ::: "memory");
        if (hit == 0) ce.LSE[(size_t)(wid * QBLK + r32t) * ce.ls] = m_reg * SCALE + logf(li_l[r32t]); }
    float rli[16];
#pragma unroll
    for (int r = 0; r < 16; ++r) rli[r] = __builtin_amdgcn_rcpf(ol[r]);
    char* stg = lds + OFF_V + wid * 4096;
    const int srow = (tid_t >> 3) & 7, sch = tid_t & 7;
    bf16_t* Ow = ce.O + (size_t)(wid * QBLK) * ce.os; const unsigned ooff = (unsigned)(srow * ce.os + sch * 4);
    const bf16_t* Zw = ce.Z + (size_t)(wid * QBLK) * ce.zs; const unsigned zoff = (unsigned)(srow * ce.zs + sch * 4); (void)Zw; (void)zoff;
#pragma unroll
    for (int d0 = 0; d0 < 4; ++d0) {
#pragma unroll
        for (int r = 0; r < 16; ++r) *(float*)(stg + crow(r, hit) * 128 + r32t * 4) = o[d0][r] * rli[r];
        asm volatile("s_waitcnt lgkmcnt(0)" ::: "memory");
#pragma unroll
        for (int i = 0; i < 4; ++i) { f32x4 v = *(const f32x4*)(stg + (srow + 8 * i) * 128 + sch * 16);
            if constexpr (KIND != K_DIL && !NOGATE) { const uint2 zz = *(const uint2*)(Zw + (size_t)(8 * i) * ce.zs + zoff + d0 * 32);
                const float z0 = __uint_as_float(zz.x << 16), z1 = __uint_as_float(zz.x & 0xffff0000u), z2 = __uint_as_float(zz.y << 16), z3 = __uint_as_float(zz.y & 0xffff0000u);
                v[0] = v[0] * z0 / (1.f + __expf(-z0)); v[1] = v[1] * z1 / (1.f + __expf(-z1)); v[2] = v[2] * z2 / (1.f + __expf(-z2)); v[3] = v[3] * z3 / (1.f + __expf(-z3)); }
            uint2 w; w.x = cvtpk(v[0], v[1]); w.y = cvtpk(v[2], v[3]);
            *(uint2*)(Ow + (size_t)(8 * i) * ce.os + ooff + d0 * 32) = w; }
        asm volatile("s_waitcnt lgkmcnt(0)" ::: "memory");
    }
    BAR();
#undef RESC
#undef KBASE
#undef ACT
#undef BOFS
#undef MASKT
#undef SLOT
#undef SMSEG
#undef MSEG
#undef STEP
}
#undef VMW
#undef VMWN
#undef SLOAD_K
#undef SLOAD_V
#undef SWRITE_HK
#undef SWRITE_HV
#undef QLOAD
#undef QLOAD_R
#undef KSWZ
}

namespace t32 {
using at::bf16_t; using at::bf16x8; using at::s16x4; using at::f32x4; using at::f32x16; using at::u32x4; using at::Ref; using at::Blk; using at::cvtpk; using at::ld8;
constexpr int NW = 8, QBLK = 32, KVBLK = 64, QB = NW * QBLK;
constexpr int SHM_V = 16384, K_ROW = 272, SHM_K = KVBLK * K_ROW, KR_ROW = 144, SHM_KR = KVBLK * KR_ROW;
constexpr int OFF_V = 0, OFF_K = 2 * SHM_V, OFF_KR = OFF_K + 2 * SHM_K, OFF_QR = OFF_KR + 2 * SHM_KR, LDS_BYTES = OFF_QR + NW * 4096;
static_assert(K_ROW == 272 && KR_ROW == 144, "KWS / KRWS");
constexpr float QMUL = 1.4426950408889634f * 0.07216878364870322f, THR2 = 8.f * 1.4426950408889634f;
struct Seam { bf16x8 qr[12]; bf16x8 st_v0, st_v1, st_k0, st_k1, st_kr; };
#define SBAR() __builtin_amdgcn_sched_barrier(0)
#define SGB(mask, n) __builtin_amdgcn_sched_group_barrier(mask, n, 0)
#define MF32(a, b, c) __builtin_amdgcn_mfma_f32_32x32x16_bf16(a, b, c, 0, 0, 0)
#define VMW() asm volatile("s_waitcnt vmcnt(0)" ::: "memory")
#define VMWN(n) asm volatile("s_waitcnt vmcnt(%0)" :: "i"(n) : "memory")
#define BAR() do { asm volatile("s_waitcnt lgkmcnt(0)" ::: "memory"); __builtin_amdgcn_s_barrier(); asm volatile("" ::: "memory"); } while (0)
#define LAUNDER_BLK(x) asm volatile("" : "+s"((x).a), "+s"((x).b), "+s"((x).c))
#define KWS(tw_) (((tw_) + ((tw_) >> 4)) << 4)
#define KRWS(tw_) (((tw_) + ((tw_) >> 3)) << 4)
#define VROW(tw_) (4 * ((tw_) >> 6) + (((tw_) >> 2) & 3))
#define VCH(tw_) (4 * (((tw_) >> 4) & 3) + ((tw_) & 3))
#define VWS(tw_) ((tw_) << 4)
#define SLOAD_K(R, k0, TOK, TID) do { const bf16_t* kb_ = (R).K + (size_t)(k0) * (R).ks; S.st_k0 = ld8(kb_ + (TOK)); S.st_k1 = ld8(kb_ + (size_t)32 * (R).ks + (TOK)); S.st_kr = ld8((R).Kr + (size_t)(k0) * 64 + (TID) * 8); } while (0)
#define SLOAD_V(R, k0, TOV) do { const bf16_t* vb_ = (R).V + (size_t)(k0) * (R).ks; S.st_v0 = ld8(vb_ + (TOV)); S.st_v1 = ld8(vb_ + (size_t)32 * (R).ks + (TOV)); } while (0)
#define SWRITE_HK(bf, tw_) do { const int kws_ = KWS(tw_); *(bf16x8*)(K_lds + (bf) * SHM_K + kws_) = S.st_k0; *(bf16x8*)(K_lds + (bf) * SHM_K + kws_ + 32 * K_ROW) = S.st_k1;   \
                                *(bf16x8*)(KR_lds + (bf) * SHM_KR + KRWS(tw_)) = S.st_kr; } while (0)
#define QLOAD(R, R32, HI) do { const bf16_t* qb_ = (R).Q + (size_t)(wid * QBLK) * (R).qs; const bf16_t* qrb_ = (R).Qr + (size_t)(wid * QBLK) * (R).qs; const unsigned qo_ = (unsigned)((R32) * (R).qs + (HI) * 8);   \
                      _Pragma("unroll") for (int d_ = 0; d_ < 8; ++d_) S.qr[d_] = ld8(qb_ + qo_ + d_ * 16);                                                                                              \
                      _Pragma("unroll") for (int d_ = 0; d_ < 4; ++d_) S.qr[8 + d_] = ld8(qrb_ + qo_ + d_ * 16); } while (0)

template <class MK>
__device__ __forceinline__ void attn_prime(const Blk cb, const MK& mk, char* lds, Seam& S) {
    const int tid = threadIdx.x, wid = __builtin_amdgcn_readfirstlane(tid >> 6), lane = tid & 63;
    char* K_lds = lds + OFF_K; char* KR_lds = lds + OFF_KR;
    Ref cur; mk(cb, cur);
    const int kb0 = cur.dir ? ((cur.P0 + QB - 1) / KVBLK) * KVBLK : 0, kb1 = cur.dir ? kb0 - KVBLK : kb0 + KVBLK;
    const unsigned tok = (unsigned)((tid >> 4) * cur.ks + (tid & 15) * 8), tov = (unsigned)(VROW(tid) * cur.ks + VCH(tid) * 8);
    QLOAD(cur, lane & 31, lane >> 5);
    SLOAD_K(cur, kb0, tok, tid); VMW(); SWRITE_HK(0, tid);
    SLOAD_K(cur, kb1, tok, tid); SLOAD_V(cur, kb0, tov);
    __syncthreads();
}

template <int KB>
__device__ __forceinline__ void qkt(f32x16& p0, f32x16& p1, const f32x16& ci, const char* lds, int r32, int hi, int qrofs, const bf16x8* qr) {
    const char* kbp = lds + OFF_K + KB * SHM_K + r32 * K_ROW + hi * 16;
#pragma unroll
    for (int d0 = 0; d0 < 8; ++d0) { const char* a = kbp + d0 * 32;
        const bf16x8 b0 = *reinterpret_cast<const bf16x8*>(a), b1 = *reinterpret_cast<const bf16x8*>(a + 32 * K_ROW);
        p0 = MF32(b0, qr[d0], d0 == 0 ? ci : p0); p1 = MF32(b1, qr[d0], d0 == 0 ? ci : p1); }
    const char* krb = lds + OFF_KR + KB * SHM_KR + r32 * KR_ROW + hi * 16;
#pragma unroll
    for (int d0 = 0; d0 < 4; ++d0) { const char* a = krb + d0 * 32;
        const bf16x8 b0 = *reinterpret_cast<const bf16x8*>(a), b1 = *reinterpret_cast<const bf16x8*>(a + 32 * KR_ROW);
        const bf16x8 qf = *reinterpret_cast<const bf16x8*>(lds + OFF_QR + qrofs + d0 * 1024);
        p0 = MF32(b0, qf, p0); p1 = MF32(b1, qf, p1); }
    constexpr int LA = 3;
    SGB(0x100, 2 * LA);
#pragma unroll
    for (int i = 0; i < 8 - LA; ++i) { SGB(0x008, 2); SGB(0x100, 2); }
#pragma unroll
    for (int i = 0; i < 4; ++i) { SGB(0x008, 2); SGB(0x100, 3); }
    SGB(0x008, 2 * LA);
}
template <int VB>
__device__ __forceinline__ void pv_tile(f32x16 (&o)[4], f32x16& ol, int vb0, const bf16x8 (&pa)[4]) {
#define TRRD(dst, off) asm volatile("ds_read_b64_tr_b16 %0, %1 offset:%2" : "=&v"(dst) : "v"(vb0), "i"(off) : "memory")
#define PV_K(ks) do { s16x4 l0, h0, l1, h1, l2, h2, l3, h3; constexpr int b_ = OFF_V + VB * SHM_V + (ks) * 4096;                                                      \
        TRRD(l0, b_); TRRD(h0, b_ + 2048); TRRD(l1, b_ + 256); TRRD(h1, b_ + 256 + 2048); TRRD(l2, b_ + 512); TRRD(h2, b_ + 512 + 2048); TRRD(l3, b_ + 768); TRRD(h3, b_ + 768 + 2048);   \
        asm volatile("s_waitcnt lgkmcnt(0)" ::: "memory"); SBAR();                                                                                                 \
        o[0] = MF32(((bf16x8){l0[0], l0[1], l0[2], l0[3], h0[0], h0[1], h0[2], h0[3]}), pa[ks], o[0]);                                                             \
        o[1] = MF32(((bf16x8){l1[0], l1[1], l1[2], l1[3], h1[0], h1[1], h1[2], h1[3]}), pa[ks], o[1]);                                                             \
        o[2] = MF32(((bf16x8){l2[0], l2[1], l2[2], l2[3], h2[0], h2[1], h2[2], h2[3]}), pa[ks], o[2]);                                                             \
        o[3] = MF32(((bf16x8){l3[0], l3[1], l3[2], l3[3], h3[0], h3[1], h3[2], h3[3]}), pa[ks], o[3]); } while (0)
    PV_K(0); PV_K(1); PV_K(2); PV_K(3);
    { const bf16x8 ones = (bf16x8){0x3F80, 0x3F80, 0x3F80, 0x3F80, 0x3F80, 0x3F80, 0x3F80, 0x3F80};
      ol = MF32(ones, pa[0], ol); ol = MF32(ones, pa[1], ol); ol = MF32(ones, pa[2], ol); ol = MF32(ones, pa[3], ol); }
#undef PV_K
#undef TRRD
}

template <class MK>
__device__ __forceinline__ void attn_block(const Blk cb, const Blk nb, const MK& mk, int skv, char* lds, Seam& S) {
    const int W = 1 << 30;
    const int tid = threadIdx.x, wid = __builtin_amdgcn_readfirstlane(tid >> 6), lane = tid & 63, r32 = lane & 31, hi = lane >> 5;
    const int grp = wid >> 2;
    Ref cur; mk(cb, cur);
    const int j_lo = 0;
    int j_hi = (cur.P0 + QB - 1) / KVBLK + 1; if (j_hi > skv / KVBLK) j_hi = skv / KVBLK;
    const int NT = j_hi - j_lo;
    const int qlo = cur.P0 + wid * QBLK, qm = qlo + r32 - 4 * hi;
    char* V_lds = lds + OFF_V; char* K_lds = lds + OFF_K; char* KR_lds = lds + OFF_KR;
    float m = -1e30f; f32x16 o[4] = {}; f32x16 ol = {};
    f32x16 ci = {}; bool inited = false;
    const int vb0 = (int)(uintptr_t)V_lds + hi * 1024 + ((lane >> 2) & 3) * 64 + ((lane >> 4) & 1) * 32 + (lane & 3) * 8;
    const unsigned tok = (unsigned)((tid >> 4) * cur.ks + (tid & 15) * 8), tov = (unsigned)(VROW(tid) * cur.ks + VCH(tid) * 8);
    int tq_ = tid; asm volatile("" : "+v"(tq_));
    const int qrofs = wid * 4096 + (tq_ & 63) * 16;
#define KBASE(t) ((cur.dir ? j_hi - 1 - (t) : j_lo + (t)) * KVBLK)
    f32x16 p0 = {}, p1 = {}; bf16x8 pa[4] = {};
#define SLOT(i) do { VMW(); { int tw_ = tid; asm volatile("" : "+v"(tw_)); const int vst_ = VWS(tw_);                                                              \
                     if ((i) < NT) { *(bf16x8*)(V_lds + ((i) & 1) * SHM_V + vst_) = S.st_v0; *(bf16x8*)(V_lds + ((i) & 1) * SHM_V + vst_ + 8192) = S.st_v1; }       \
                     if ((i) + 1 < NT) { SWRITE_HK(((i) + 1) & 1, tw_); } } SBAR();                                                                                \
                     if ((i) + 1 < NT) SLOAD_V(cur, KBASE((i) + 1), tov); if ((i) + 2 < NT) SLOAD_K(cur, KBASE((i) + 2), tok, tid); SBAR(); } while (0)
#define SMSEG(t) do { SBAR(); { const int kb_ = KBASE(t); if (kb_ + KVBLK - 1 > qlo || kb_ <= qlo + QBLK - 1 - W) at::mask_tile(p0, p1, qm - kb_, (unsigned)W); }                \
        float ma = p0[0], mb = p0[8], mc = p1[0], md = p1[8];                                                                                                      \
        _Pragma("unroll") for (int r = 1; r < 8; ++r) { ma = fmaxf(ma, p0[r]); mb = fmaxf(mb, p0[8 + r]); mc = fmaxf(mc, p1[r]); md = fmaxf(md, p1[8 + r]); }        \
        float pm = fmaxf(fmaxf(ma, mb), fmaxf(mc, md));                                                                                                            \
        if (!__builtin_expect(inited && __all(pm <= THR2), 1)) {                         \
            pm = fmaxf(pm, __shfl_xor(pm, 32));                                                                                                                    \
            const float u = -ci[0];                                                          \
            const float n = fmaxf(m, pm + u), al = __builtin_amdgcn_exp2f(m - n), sb = n - u;                                                                      \
            _Pragma("unroll") for (int r = 0; r < 16; ++r) { p0[r] -= sb; p1[r] -= sb; ol[r] *= al; o[0][r] *= al; o[1][r] *= al; o[2][r] *= al; o[3][r] *= al; }    \
            m = n; const float c_ = n > -1e29f ? -n : 0.f; _Pragma("unroll") for (int r = 0; r < 16; ++r) ci[r] = c_;                                              \
            inited = __all(n > -1e29f) != 0; }                                                                                                                     \
        _Pragma("unroll") for (int r = 0; r < 16; ++r) { p0[r] = __builtin_amdgcn_exp2f(p0[r]); p1[r] = __builtin_amdgcn_exp2f(p1[r]); }                            \
        { u32x4 w0_ = {cvtpk(p0[0], p0[1]), cvtpk(p0[2], p0[3]), cvtpk(p0[4], p0[5]), cvtpk(p0[6], p0[7])}, w1_ = {cvtpk(p0[8], p0[9]), cvtpk(p0[10], p0[11]), cvtpk(p0[12], p0[13]), cvtpk(p0[14], p0[15])};   \
          u32x4 w2_ = {cvtpk(p1[0], p1[1]), cvtpk(p1[2], p1[3]), cvtpk(p1[4], p1[5]), cvtpk(p1[6], p1[7])}, w3_ = {cvtpk(p1[8], p1[9]), cvtpk(p1[10], p1[11]), cvtpk(p1[12], p1[13]), cvtpk(p1[14], p1[15])};   \
          pa[0] = *reinterpret_cast<bf16x8*>(&w0_); pa[1] = *reinterpret_cast<bf16x8*>(&w1_); pa[2] = *reinterpret_cast<bf16x8*>(&w2_); pa[3] = *reinterpret_cast<bf16x8*>(&w3_); }   \
        SBAR(); } while (0)
#define MSEG(t, KB, VB) do { SBAR(); if ((t) > 0) pv_tile<VB>(o, ol, vb0, pa); SBAR(); qkt<KB>(p0, p1, ci, lds, r32, hi, qrofs, S.qr); SBAR(); } while (0)
#define STEP(t, KB, VB) do { MSEG(t, KB, VB); BAR(); SLOT((t) + grp); SMSEG(t); BAR(); } while (0)
#pragma unroll
    for (int f = 0; f < 4; ++f) *(bf16x8*)(lds + OFF_QR + qrofs + f * 1024) = S.qr[8 + f];
    if (grp) { SLOT(0); BAR(); }
    int t = 0;
    for (; t + 1 < NT; t += 2) { STEP(t, 0, 1); STEP(t + 1, 1, 0); }
    if (t < NT) { STEP(t, 0, 1); }
    int tid_t = tid; asm volatile("" : "+v"(tid_t));
    Blk nb2 = nb; LAUNDER_BLK(nb2); Ref nxt; mk(nb2, nxt);
    const int kbn0 = nxt.dir ? ((nxt.P0 + QB - 1) / KVBLK) * KVBLK : 0, kbn1 = nxt.dir ? kbn0 - KVBLK : kbn0 + KVBLK;
    const unsigned tokn = (unsigned)((tid_t >> 4) * nxt.ks + (tid_t & 15) * 8), tovn = (unsigned)(VROW(tid_t) * nxt.ks + VCH(tid_t) * 8);
    if (((NT - 1) & 1) != 0) pv_tile<1>(o, ol, vb0, pa); else pv_tile<0>(o, ol, vb0, pa);
    SBAR(); SLOAD_K(nxt, kbn0, tokn, tid_t); SBAR(); QLOAD(nxt, tid_t & 31, (tid_t >> 5) & 1); SBAR();
    BAR();
    VMWN(12); SWRITE_HK(0, tid_t); SBAR(); SLOAD_K(nxt, kbn1, tokn, tid_t); SLOAD_V(nxt, kbn0, tovn); SBAR();
    BAR();
    if (grp == 0) BAR();
    Blk cb2 = cb; LAUNDER_BLK(cb2); Ref ce; mk(cb2, ce);
    const int qt_ = tid_t & 31, ht_ = (tid_t >> 5) & 1;
    bf16_t* Ow = ce.O + (size_t)(wid * QBLK) * ce.os; const bf16_t* Zw = ce.Z + (size_t)(wid * QBLK) * ce.zs;
    const float rl = __builtin_amdgcn_rcpf(ol[0]);
    const unsigned ooff = (unsigned)(qt_ * ce.os + 4 * ht_), zoff = (unsigned)(qt_ * ce.zs + 4 * ht_);
#pragma unroll
    for (int c = 0; c < 4; ++c) {
        uint2 zz[4];
#pragma unroll
        for (int rr = 0; rr < 4; ++rr) zz[rr] = *(const uint2*)(Zw + zoff + 32 * c + 8 * rr);
#pragma unroll
        for (int rr = 0; rr < 4; ++rr) {
            const float z0 = __uint_as_float(zz[rr].x << 16), z1 = __uint_as_float(zz[rr].x & 0xffff0000u), z2 = __uint_as_float(zz[rr].y << 16), z3 = __uint_as_float(zz[rr].y & 0xffff0000u);
            const float v0 = o[c][4 * rr] * rl, v1 = o[c][4 * rr + 1] * rl, v2 = o[c][4 * rr + 2] * rl, v3 = o[c][4 * rr + 3] * rl;
            uint2 w; w.x = cvtpk(v0 * z0 / (1.f + __expf(-z0)), v1 * z1 / (1.f + __expf(-z1))); w.y = cvtpk(v2 * z2 / (1.f + __expf(-z2)), v3 * z3 / (1.f + __expf(-z3)));
            *(uint2*)(Ow + ooff + 32 * c + 8 * rr) = w; }
    }
    BAR();
#undef KBASE
#undef SLOT
#undef SMSEG
#undef MSEG
#undef STEP
}
#undef SBAR
#undef SGB
#undef MF32
#undef VMW
#undef VMWN
#undef BAR
#undef LAUNDER_BLK
#undef KWS
#undef KRWS
#undef VROW
#undef VCH
#undef VWS
#undef SLOAD_K
#undef SLOAD_V
#undef SWRITE_HK
#undef QLOAD
}

#define GAS __attribute__((address_space(1)))
#define LAS __attribute__((address_space(3)))
typedef unsigned short bf16;
typedef unsigned v4u __attribute__((ext_vector_type(4)));
typedef float f32x4 __attribute__((ext_vector_type(4)));
typedef short bf16x8 __attribute__((ext_vector_type(8)));
typedef GAS unsigned gu32;
typedef GAS unsigned long long gu64;
#define RLX_AGENT __ATOMIC_RELAXED, __HIP_MEMORY_SCOPE_AGENT
#define LDS_WAIT() asm volatile("s_waitcnt lgkmcnt(0)" ::: "memory")
#define VM_WAIT() asm volatile("s_waitcnt vmcnt(0)" ::: "memory")
__device__ __forceinline__ unsigned long long rt() { return __builtin_amdgcn_s_memrealtime(); }
__device__ __forceinline__ unsigned f2bf(float f) { unsigned u = __builtin_bit_cast(unsigned, f); return (u + 0x7fffu + ((u >> 16) & 1u)) >> 16; }
__device__ __forceinline__ unsigned pk2(float lo, float hi) { return f2bf(lo) | (f2bf(hi) << 16); }

#define XB_TMO      128
#define XB_XCNT(j)  (256  + 64 * (j))
#define XB_XSUB(j)  (1280 + 64 * (j))
#define XB_XGEN(j)  (2304 + 64 * (j))
#define XB_TOP      3328
#define XB_TOPGEN   3392
#define XCD_BAR_WORDS 3456
#define XB_SPIN_CAP (1u << 18)

__device__ __forceinline__ unsigned xb_ld(unsigned* p)              { return __hip_atomic_load(p, __ATOMIC_RELAXED, __HIP_MEMORY_SCOPE_AGENT); }
__device__ __forceinline__ unsigned xb_add(unsigned* p, unsigned v) { return __hip_atomic_fetch_add(p, v, __ATOMIC_RELAXED, __HIP_MEMORY_SCOPE_AGENT); }
__device__ __forceinline__ unsigned xb_xcc_id() { return (unsigned)__builtin_amdgcn_s_getreg((3 << 11) | 20) & 0xFu; }
#define XB_SPIN(cond, bar) do { unsigned _sp = 0; while (cond) { __builtin_amdgcn_s_sleep(1); \
    if ((++_sp & 255u) == 0u) { if (xb_ld(&(bar)[XB_TMO])) break; if (_sp > XB_SPIN_CAP) { atomicAdd(&(bar)[XB_TMO], 1u); break; } } } } while (0)

struct XcdBarrier {
    unsigned* bar; unsigned x;
    volatile LAS unsigned* st;
};

__device__ __forceinline__ XcdBarrier xcd_barrier_post(unsigned* bar, volatile LAS unsigned* st) {
    XcdBarrier b; b.bar = bar; b.x = xb_xcc_id(); b.st = st;
    if (threadIdx.x == 0) (void)xb_add(&bar[XB_XCNT(b.x)], 1u);
    return b;
}
__device__ __forceinline__ void xcd_barrier_complete(unsigned* bar, unsigned x, unsigned& nloc, unsigned& nx) {
    const unsigned G = gridDim.x * gridDim.y * gridDim.z;
    unsigned sum, cnt, mine, sp = 0u;
    for (;;) {
        sum = 0u; cnt = 0u; mine = 0u;
#pragma unroll
        for (unsigned j = 0; j < 16; ++j) { const unsigned c = xb_ld(&bar[XB_XCNT(j)]); sum += c; cnt += (c > 0u) ? 1u : 0u; mine = (j == x) ? c : mine; }
        if (sum == G) break;
        __builtin_amdgcn_s_sleep(1);
        if ((++sp & 255u) == 0u) { if (xb_ld(&bar[XB_TMO])) break; if (sp > XB_SPIN_CAP) { atomicAdd(&bar[XB_TMO], 1u); break; } }
    }
    nloc = mine > 0u ? mine : 1u; nx = cnt > 0u ? cnt : 1u;
}

__device__ __forceinline__ void xcd_barrier(const XcdBarrier& b) {
    asm volatile("s_waitcnt vmcnt(0)" ::: "memory");
    __syncthreads();
    if (threadIdx.x == 0) {
        unsigned* bar = b.bar;
        __builtin_amdgcn_s_waitcnt(0);
        unsigned nloc = b.st[0], nx = b.st[1];
        if (nloc == 0u) { xcd_barrier_complete(bar, b.x, nloc, nx); b.st[0] = nloc; b.st[1] = nx; }
        const unsigned old = xb_add(&bar[XB_XSUB(b.x)], 1u);
        const unsigned gen = old / nloc;
        if (old + 1u == (gen + 1u) * nloc) {
            __builtin_amdgcn_fence(__ATOMIC_RELEASE, "agent");
            asm volatile("s_waitcnt vmcnt(0)" ::: "memory");
            const unsigned og = xb_add(&bar[XB_TOP], 1u);
            const unsigned tg = og / nx;
            if (og + 1u == (tg + 1u) * nx) xb_add(&bar[XB_TOPGEN], 1u);
            else XB_SPIN(xb_ld(&bar[XB_TOPGEN]) == tg, bar);
            __builtin_amdgcn_fence(__ATOMIC_ACQUIRE, "agent");
            xb_add(&bar[XB_XGEN(b.x)], 1u);
            asm volatile("s_waitcnt vmcnt(0)" ::: "memory");
        } else {
            XB_SPIN(xb_ld(&bar[XB_XGEN(b.x)]) == gen, bar);
            __builtin_amdgcn_fence(__ATOMIC_ACQUIRE, "agent");
            asm volatile("s_waitcnt vmcnt(0)" ::: "memory");
        }
    }
    __syncthreads();
}

constexpr int BATCH = 2, SEQ = 8192, DM = 4096, M = BATCH * SEQ, HD = 128;
constexpr int NHA = 16, NHB = 16, NHC = 32;
constexpr int IN_EVEN = 16400, IN_ODD = 5696, Q_LORA = 1024, KV_LORA = 512, QK_ROPE = 64;
constexpr int N0 = 16384;
constexpr int C_QA = 0, C_KA = 2048, C_VA = 4096, C_QB = 6144, C_KB = 8192, C_VB = 10240, C_Z0 = 12288;
constexpr int N1 = 5888;
constexpr int C1_Z = 0, C1_CQ = 4096, C1_CKV = 5120, C1_KR = 5632;
constexpr int NQ = 6144;
constexpr int NKV = 8192;
constexpr float EPS = 1e-6f;
constexpr int NWAVES = 8;
#ifndef MK_PER_PHASE
#define MK_PER_PHASE 0
#endif
constexpr int N_PHASES = 13;

constexpr size_t MiB = 1u << 20;
constexpr size_t WS_CTL = 0, CTL_ZERO_BYTES = 1 * MiB;
constexpr size_t WS_MOD = 1 * MiB;
constexpr size_t WS_FLOGIT = 2 * MiB;
constexpr size_t WS_CS = 4 * MiB;
constexpr size_t WS_LSE = 8 * MiB;
constexpr size_t WS_WFT = 12 * MiB;
constexpr size_t WS_BT0 = 16 * MiB;
constexpr size_t WS_WO0 = 144 * MiB;
constexpr size_t WS_BT1 = 176 * MiB;
constexpr size_t WS_WQB = 222 * MiB;
constexpr size_t WS_WKVB = 234 * MiB;
constexpr size_t WS_WO1 = 242 * MiB;
constexpr size_t WS_XN = 274 * MiB;
constexpr size_t WS_PROJ0 = 402 * MiB;
constexpr size_t WS_OP = 914 * MiB;
constexpr size_t WS_G = 1106 * MiB;
constexpr size_t WS_END = 1234 * MiB;
constexpr size_t WS_Y1 = 16 * MiB, WS_Y2 = 828 * MiB;
constexpr size_t WS_PROJ1 = 402 * MiB;
constexpr size_t WS_CQN = 586 * MiB;
constexpr size_t WS_CKVN = 618 * MiB;
constexpr size_t WS_KROPE = 634 * MiB;
constexpr size_t WS_QBUF = 636 * MiB;
constexpr size_t WS_KVBUF = 828 * MiB;
static_assert(WS_KVBUF + (size_t)M * NKV * 2 <= WS_G && WS_PROJ1 + (size_t)M * N1 * 2 <= WS_CQN && WS_QBUF + (size_t)M * NQ * 2 <= WS_KVBUF, "d_ws map");
constexpr int CW_BAR = 4096;
constexpr int CW_QUEUE = 64;
constexpr size_t WS_NRMQ = 256 * 1024, WS_NRMK = 320 * 1024;

constexpr int RING_OFF = 0, RING_BYTES = 131072;
constexpr int LDSCTL_OFF = RING_BYTES, MISC_OFF = LDSCTL_OFF + 320;
constexpr int LDS_BYTES = 147456;
static_assert(MISC_OFF + 128 <= LDS_BYTES && at::LDS_BYTES <= RING_BYTES && t32::LDS_BYTES <= RING_BYTES && pg8::STAGE_BYTES <= RING_BYTES, "LDS map");

struct Args { const void* in[17]; float* out; unsigned char* ws; int ph_lo, ph_hi; };

struct Ctx {
    LAS unsigned char* lds; int tid, lane, wave, vcu, G;
    const __attribute__((address_space(4))) Args* A;
    float* out; unsigned char* ws;
};
__device__ __forceinline__ const __attribute__((address_space(4))) Args* late(const __attribute__((address_space(4))) Args* a) { asm volatile("" : "+s"(a)); return a; }
#define IN_X(F)        ((const float*)late((F).A)->in[0])
#define IN_C(F)        ((const float*)late((F).A)->in[1])
#define IN_POS(F)      ((const int*)late((F).A)->in[2])
#define IN_GNORM(F)    ((const float*)late((F).A)->in[3])
#define IN_WADA(F)     ((const float*)late((F).A)->in[4])
#define IN_BADA(F)     ((const float*)late((F).A)->in[5])
#define IN_RELB(F)     ((const float*)late((F).A)->in[6])
#define IN_WINE(F)     ((const float*)late((F).A)->in[7])
#define IN_BF(F)       ((const float*)late((F).A)->in[8])
#define IN_WOE(F)      ((const float*)late((F).A)->in[9])
#define IN_WINO(F)     ((const float*)late((F).A)->in[10])
#define IN_GQ(F)       ((const float*)late((F).A)->in[11])
#define IN_GKV(F)      ((const float*)late((F).A)->in[12])
#define IN_WQB(F)      ((const float*)late((F).A)->in[13])
#define IN_WKVB(F)     ((const float*)late((F).A)->in[14])
#define IN_WOO(F)      ((const float*)late((F).A)->in[15])
#define IN_GFIN(F)     ((const float*)late((F).A)->in[16])
__device__ __forceinline__ float wave_sum(float v) {
#pragma unroll
    for (int o = 1; o < 64; o <<= 1) v += __shfl_xor(v, o);
    return v;
}
__device__ __forceinline__ float bf2f(unsigned short h) { return __uint_as_float(((unsigned)h) << 16); }
__device__ __forceinline__ float silu_f(float z) { return z / (1.f + __expf(-z)); }

__device__ __forceinline__ void transpose_item(const float* W, int ldw, int K, int kb, int n0, bf16* WT, int drow0, int rmul, LAS float* scr, int lane) {
    const int k0 = 64 * kb;
#pragma unroll 8
    for (int i = 0; i < 32; ++i) { const int kk = 2 * i + (lane >> 5); scr[kk * 33 + (lane & 31)] = W[(size_t)(k0 + kk) * ldw + n0 + (lane & 31)]; }
    LDS_WAIT(); asm volatile("" ::: "memory");
    const int cch = lane & 7;
#pragma unroll
    for (int j = 0; j < 4; ++j) { const int n = (lane >> 3) + 8 * j; const LAS float* s = scr + (8 * cch) * 33 + n;
        v4u o; o.x = pk2(s[0 * 33], s[1 * 33]); o.y = pk2(s[2 * 33], s[3 * 33]); o.z = pk2(s[4 * 33], s[5 * 33]); o.w = pk2(s[6 * 33], s[7 * 33]);
        *(GAS v4u*)(WT + (size_t)(drow0 + rmul * n) * K + k0 + 8 * cch) = o; }
    LDS_WAIT(); asm volatile("" ::: "memory");
}
__device__ __forceinline__ void map_in_odd(int nb, int& drow0, int& rmul) { rmul = 1;
    if (nb < 32) drow0 = C1_CQ + 32 * nb; else if (nb < 48) drow0 = C1_CKV + 32 * (nb - 32); else if (nb < 50) { drow0 = C1_KR + (nb - 48); rmul = 2; } else drow0 = C1_Z + 32 * (nb - 50); }
__device__ __forceinline__ void map_qb(int nb, int& drow0, int& rmul) { const int h = nb / 6, part = nb % 6; rmul = 1;
    if (part < 4) drow0 = h * 128 + part * 32; else { drow0 = 4096 + h * 64 + (part - 4); rmul = 2; } }
__device__ __forceinline__ void map_kvb(int nb, int& drow0, int& rmul) { const int h = nb / 8, part = nb % 8; rmul = 1;
    drow0 = part < 4 ? h * 128 + part * 32 : 4096 + h * 128 + (part - 4) * 32; }

__device__ __forceinline__ void p0_prologue(Ctx& F) {
    const int gw = F.vcu * NWAVES + F.wave, NGW = F.G * NWAVES, gt = gw * 64 + F.lane, NGT = NGW * 64;
    float* cs = (float*)(F.ws + WS_CS);
    for (int i = gt; i < M * 32; i += NGT) { const int row = i >> 5, j = i & 31;
        const float inv = powf(10000.0f, -(float)j / 32.0f); const float ang = (float)IN_POS(F)[row] * inv; float sn, cn; sincosf(ang, &sn, &cn);
        cs[(size_t)row * 64 + j] = cn; cs[(size_t)row * 64 + 32 + j] = sn; }
    bf16* wft = (bf16*)(F.ws + WS_WFT);
    for (int i = gt; i < 16 * DM; i += NGT) { const int n = i >> 12, k = i & 4095; wft[i] = (bf16)f2bf(IN_WINE(F)[(size_t)k * IN_EVEN + N0 + n]); }
    { v4u* pad = (v4u*)((bf16*)(F.ws + WS_BT1) + (size_t)IN_ODD * DM); const int npad = (N1 - IN_ODD) * DM / 8;
      for (int i = gt; i < npad; i += NGT) pad[i] = (v4u){0u, 0u, 0u, 0u}; }
    LAS float* scr = (LAS float*)(F.lds + RING_OFF + F.wave * 16384);
    constexpr int KB4 = DM / 64;
    constexpr int I_IN0 = KB4 * (N0 / 32), I_WO = KB4 * (DM / 32), I_IN1 = KB4 * (IN_ODD / 32), I_QB = (Q_LORA / 64) * (NQ / 32), I_KVB = (KV_LORA / 64) * (NKV / 32);
    constexpr int NITEMS = I_IN0 + 2 * I_WO + I_IN1 + I_QB + I_KVB;
    for (int it = gw; it < NITEMS; it += NGW) {
        int r = it, drow0, rmul;
        if (r < I_IN0) { const int nblk = N0 / 32; transpose_item(IN_WINE(F), IN_EVEN, DM, r / nblk, 32 * (r % nblk), (bf16*)(F.ws + WS_BT0), 32 * (r % nblk), 1, scr, F.lane); continue; } r -= I_IN0;
        if (r < I_WO) { const int nblk = DM / 32; transpose_item(IN_WOE(F), DM, DM, r / nblk, 32 * (r % nblk), (bf16*)(F.ws + WS_WO0), 32 * (r % nblk), 1, scr, F.lane); continue; } r -= I_WO;
        if (r < I_WO) { const int nblk = DM / 32; transpose_item(IN_WOO(F), DM, DM, r / nblk, 32 * (r % nblk), (bf16*)(F.ws + WS_WO1), 32 * (r % nblk), 1, scr, F.lane); continue; } r -= I_WO;
        if (r < I_IN1) { const int nblk = IN_ODD / 32; map_in_odd(r % nblk, drow0, rmul); transpose_item(IN_WINO(F), IN_ODD, DM, r / nblk, 32 * (r % nblk), (bf16*)(F.ws + WS_BT1), drow0, rmul, scr, F.lane); continue; } r -= I_IN1;
        if (r < I_QB) { const int nblk = NQ / 32; map_qb(r % nblk, drow0, rmul); transpose_item(IN_WQB(F), NQ, Q_LORA, r / nblk, 32 * (r % nblk), (bf16*)(F.ws + WS_WQB), drow0, rmul, scr, F.lane); continue; } r -= I_QB;
        { const int nblk = NKV / 32; map_kvb(r % nblk, drow0, rmul); transpose_item(IN_WKVB(F), NKV, KV_LORA, r / nblk, 32 * (r % nblk), (bf16*)(F.ws + WS_WKVB), drow0, rmul, scr, F.lane); }
    }
    __syncthreads();
    LAS float* sc = (LAS float*)(F.lds + RING_OFF);
    LAS float* red = (LAS float*)(F.lds + RING_OFF + 32768);
    for (int i = F.tid; i < BATCH * DM; i += NWAVES * 64) sc[i] = silu_f(IN_C(F)[i]);
    __syncthreads();
    float* mod = (float*)(F.ws + WS_MOD);
    const int c4 = F.tid & 7, kl = F.tid >> 3;
    for (int it = F.vcu; it < 2 * (3 * DM / 32); it += F.G) {
        const int l = it / (3 * DM / 32), n0 = 32 * (it % (3 * DM / 32));
        const float* wp = IN_WADA(F) + ((size_t)l * DM) * (3 * DM) + n0 + 4 * c4;
        f32x4 a0 = (f32x4){0.f, 0.f, 0.f, 0.f}, a1 = a0;
#pragma unroll 8
        for (int i = 0; i < 64; ++i) { const int k = kl + 64 * i; const f32x4 w = *(const GAS f32x4*)(wp + (size_t)k * (3 * DM)); a0 += w * sc[k]; a1 += w * sc[DM + k]; }
        LAS float* rp = red + (kl * 8 + c4) * 8;
        rp[0] = a0[0]; rp[1] = a0[1]; rp[2] = a0[2]; rp[3] = a0[3]; rp[4] = a1[0]; rp[5] = a1[1]; rp[6] = a1[2]; rp[7] = a1[3];
        __syncthreads();
        if (F.tid < 64) { const int b = F.tid >> 5, n = F.tid & 31; float s = 0.f;
            for (int q = 0; q < 64; ++q) s += red[(q * 8 + (n >> 2)) * 8 + b * 4 + (n & 3)];
            mod[((size_t)l * BATCH + b) * (3 * DM) + n0 + n] = s + IN_BADA(F)[(size_t)l * (3 * DM) + n0 + n]; }
        __syncthreads();
    }
}

__device__ __forceinline__ void adaln_rows(Ctx& F, const float* X, const float* g, const float* mod  , bf16* XN) {
    const int gw = F.vcu * NWAVES + F.wave, NGW = F.G * NWAVES;
    for (int m = gw; m < M; m += NGW) {
        const int b = m / SEQ;
        const GAS f32x4* xr = (const GAS f32x4*)(X + (size_t)m * DM) + F.lane;
        f32x4 v[16]; float s = 0.f;
#pragma unroll
        for (int j = 0; j < 16; ++j) { v[j] = xr[64 * j]; s += (v[j].x * v[j].x + v[j].y * v[j].y) + (v[j].z * v[j].z + v[j].w * v[j].w); }
        const float rstd = 1.0f / sqrtf(wave_sum(s) * (1.f / DM) + EPS);
        const f32x4* g4 = (const f32x4*)g + F.lane; const f32x4* sh4 = (const f32x4*)(mod + (size_t)b * 3 * DM) + F.lane; const f32x4* sc4 = (const f32x4*)(mod + (size_t)b * 3 * DM + DM) + F.lane;
        GAS unsigned long long* o8 = (GAS unsigned long long*)(XN + (size_t)m * DM) + F.lane;
#pragma unroll
        for (int j = 0; j < 16; ++j) { const f32x4 y = (v[j] * rstd) * g4[64 * j] * (sc4[64 * j] + 1.0f) + sh4[64 * j];
            o8[64 * j] = (unsigned long long)pk2(y.x, y.y) | ((unsigned long long)pk2(y.z, y.w) << 32); }
    }
}
__device__ __forceinline__ void adaln_add_rows(Ctx& F, const float* X, const bf16* Y, const float* g, const float* mod  , bf16* XN) {
    const int gw = F.vcu * NWAVES + F.wave, NGW = F.G * NWAVES;
    for (int m = gw; m < M; m += NGW) {
        const int b = m / SEQ;
        const GAS f32x4* xr = (const GAS f32x4*)(X + (size_t)m * DM) + F.lane; const GAS unsigned long long* yr = (const GAS unsigned long long*)(Y + (size_t)m * DM) + F.lane;
        f32x4 v[16]; float s = 0.f;
#pragma unroll
        for (int j = 0; j < 16; ++j) { const unsigned long long y8 = yr[64 * j]; const unsigned ylo = (unsigned)y8, yhi = (unsigned)(y8 >> 32);
            v[j] = xr[64 * j] + (f32x4){__uint_as_float(ylo << 16), __uint_as_float(ylo & 0xffff0000u), __uint_as_float(yhi << 16), __uint_as_float(yhi & 0xffff0000u)};
            s += (v[j].x * v[j].x + v[j].y * v[j].y) + (v[j].z * v[j].z + v[j].w * v[j].w); }
        const float rstd = 1.0f / sqrtf(wave_sum(s) * (1.f / DM) + EPS);
        const f32x4* g4 = (const f32x4*)g + F.lane; const f32x4* sh4 = (const f32x4*)(mod + (size_t)b * 3 * DM) + F.lane; const f32x4* sc4 = (const f32x4*)(mod + (size_t)b * 3 * DM + DM) + F.lane;
        GAS unsigned long long* o8 = (GAS unsigned long long*)(XN + (size_t)m * DM) + F.lane;
#pragma unroll
        for (int j = 0; j < 16; ++j) { const f32x4 y = (v[j] * rstd) * g4[64 * j] * (sc4[64 * j] + 1.0f) + sh4[64 * j];
            o8[64 * j] = (unsigned long long)pk2(y.x, y.y) | ((unsigned long long)pk2(y.z, y.w) << 32); }
    }
}
__device__ __forceinline__ void final_rows(Ctx& F) {
    const int gw = F.vcu * NWAVES + F.wave, NGW = F.G * NWAVES;
    int ln = threadIdx.x; asm volatile("" : "+v"(ln)); ln &= 63;
    for (int m = gw; m < M; m += NGW) {
        GAS f32x4* xr = (GAS f32x4*)(F.out + (size_t)m * DM) + ln; const GAS f32x4* xin = (const GAS f32x4*)(IN_X(F) + (size_t)m * DM) + ln;
        const GAS unsigned long long* yr = (const GAS unsigned long long*)((const bf16*)(F.ws + WS_Y2) + (size_t)m * DM) + ln; const GAS unsigned long long* y1r = (const GAS unsigned long long*)((const bf16*)(F.ws + WS_Y1) + (size_t)m * DM) + ln;
        f32x4 v[16]; float s = 0.f;
#pragma unroll
        for (int j = 0; j < 16; ++j) { const unsigned long long y8 = yr[64 * j], z8 = y1r[64 * j]; const unsigned ylo = (unsigned)y8, yhi = (unsigned)(y8 >> 32), zlo = (unsigned)z8, zhi = (unsigned)(z8 >> 32);
            v[j] = (xin[64 * j] + (f32x4){__uint_as_float(zlo << 16), __uint_as_float(zlo & 0xffff0000u), __uint_as_float(zhi << 16), __uint_as_float(zhi & 0xffff0000u)})
                 + (f32x4){__uint_as_float(ylo << 16), __uint_as_float(ylo & 0xffff0000u), __uint_as_float(yhi << 16), __uint_as_float(yhi & 0xffff0000u)};
            s += (v[j].x * v[j].x + v[j].y * v[j].y) + (v[j].z * v[j].z + v[j].w * v[j].w); }
        const float rstd = 1.0f / sqrtf(wave_sum(s) * (1.f / DM) + EPS);
        const f32x4* g4 = (const f32x4*)IN_GFIN(F) + ln;
#pragma unroll
        for (int j = 0; j < 16; ++j) xr[64 * j] = (v[j] * rstd) * g4[64 * j];
    }
}
__device__ __forceinline__ void flogit_rows(Ctx& F) {
    typedef float f4 __attribute__((ext_vector_type(4)));
    const bf16* XN = (const bf16*)(F.ws + WS_XN); const bf16* WFT = (const bf16*)(F.ws + WS_WFT); float* FL = (float*)(F.ws + WS_FLOGIT);
    LAS f4* red = (LAS f4*)(F.lds + RING_OFF);
    const int r = F.lane & 15, kg = F.lane >> 4, kh = F.wave >> 2;
    for (int c0 = F.vcu; c0 < M / 64; c0 += F.G) {
        const int row0 = c0 * 64 + 16 * (F.wave & 3);
        const bf16* ap = XN + (size_t)(row0 + r) * DM + kh * 2048 + 8 * kg; const bf16* bp = WFT + (size_t)r * DM + kh * 2048 + 8 * kg;
        f4 acc = (f4){0.f, 0.f, 0.f, 0.f};
#pragma unroll 8
        for (int s = 0; s < 64; ++s) { const bf16x8 a = *(const GAS bf16x8*)(ap + 32 * s), b = *(const GAS bf16x8*)(bp + 32 * s);
            acc = __builtin_amdgcn_mfma_f32_16x16x32_bf16(a, b, acc, 0, 0, 0); }
        if (kh == 1) red[(F.wave & 3) * 64 + F.lane] = acc;
        __syncthreads();
        if (kh == 0) { const f4 o = acc + red[(F.wave & 3) * 64 + F.lane];
#pragma unroll
            for (int v = 0; v < 4; ++v) FL[(size_t)(row0 + 4 * kg + v) * 16 + r] = o[v]; }
        __syncthreads();
    }
}
__device__ __forceinline__ void combine_rows(Ctx& F) {
    const int gw = F.vcu * NWAVES + F.wave, NGW = F.G * NWAVES;
    const bf16* OP = (const bf16*)(F.ws + WS_OP); const float* LSE = (const float*)(F.ws + WS_LSE); const bf16* PR = (const bf16*)(F.ws + WS_PROJ0); bf16* G = (bf16*)(F.ws + WS_G);
    for (int m = gw; m < M; m += NGW) {
#pragma unroll
        for (int cc = 0; cc < 4; ++cc) { const int col = (cc * 64 + F.lane) * 8, h = col >> 7;
            const float l0 = LSE[(size_t)m * 16 + h], l1 = LSE[((size_t)M + m) * 16 + h], l2 = LSE[((size_t)2 * M + m) * 16 + h];
            const float mx = fmaxf(l0, fmaxf(l1, l2)); const float e0 = __expf(l0 - mx), e1 = __expf(l1 - mx), e2 = __expf(l2 - mx); const float inv = 1.f / (e0 + e1 + e2);
            const float w0 = e0 * inv, w1 = e1 * inv, w2 = e2 * inv;
            const v4u a = *(const GAS v4u*)(OP + (size_t)m * 2048 + col), b = *(const GAS v4u*)(OP + ((size_t)M + m) * 2048 + col), c = *(const GAS v4u*)(OP + ((size_t)2 * M + m) * 2048 + col);
            const v4u z = *(const GAS v4u*)(PR + (size_t)m * N0 + C_Z0 + col);
            v4u o;
#pragma unroll
            for (int q = 0; q < 4; ++q) { const unsigned ua = a[q], ub = b[q], uc = c[q], uz = z[q];
                const float lo = w0 * __uint_as_float(ua << 16) + w1 * __uint_as_float(ub << 16) + w2 * __uint_as_float(uc << 16);
                const float hi = w0 * __uint_as_float(ua & 0xffff0000u) + w1 * __uint_as_float(ub & 0xffff0000u) + w2 * __uint_as_float(uc & 0xffff0000u);
                o[q] = pk2(lo * silu_f(__uint_as_float(uz << 16)), hi * silu_f(__uint_as_float(uz & 0xffff0000u))); }
            *(GAS v4u*)(G + (size_t)m * DM + col) = o; }
    }
}
__device__ __forceinline__ void mla_norm_rows(Ctx& F) {
    const int gw = F.vcu * NWAVES + F.wave, NGW = F.G * NWAVES;
    const bf16* PR = (const bf16*)(F.ws + WS_PROJ1); bf16* CQN = (bf16*)(F.ws + WS_CQN); bf16* CKVN = (bf16*)(F.ws + WS_CKVN); bf16* KR = (bf16*)(F.ws + WS_KROPE); const float* cs = (const float*)(F.ws + WS_CS);
    const float* gq = IN_GQ(F); const float* gkv = IN_GKV(F);
    for (int m = gw; m < M; m += NGW) {
        const bf16* pr = PR + (size_t)m * N1;
        const v4u q0 = *(const GAS v4u*)(pr + C1_CQ + 8 * F.lane), q1 = *(const GAS v4u*)(pr + C1_CQ + 512 + 8 * F.lane), kv = *(const GAS v4u*)(pr + C1_CKV + 8 * F.lane);
        float fq[16], fk[8]; float sq = 0.f, sk = 0.f;
#pragma unroll
        for (int i = 0; i < 4; ++i) { fq[2 * i] = __uint_as_float(q0[i] << 16); fq[2 * i + 1] = __uint_as_float(q0[i] & 0xffff0000u); fq[8 + 2 * i] = __uint_as_float(q1[i] << 16); fq[8 + 2 * i + 1] = __uint_as_float(q1[i] & 0xffff0000u);
            fk[2 * i] = __uint_as_float(kv[i] << 16); fk[2 * i + 1] = __uint_as_float(kv[i] & 0xffff0000u); }
#pragma unroll
        for (int i = 0; i < 16; ++i) sq += fq[i] * fq[i];
#pragma unroll
        for (int i = 0; i < 8; ++i) sk += fk[i] * fk[i];
        const float rq = 1.0f / sqrtf(wave_sum(sq) * (1.f / Q_LORA) + EPS), rk = 1.0f / sqrtf(wave_sum(sk) * (1.f / KV_LORA) + EPS);
        const f32x4 g0a = *(const f32x4*)(gq + 8 * F.lane), g0b = *(const f32x4*)(gq + 8 * F.lane + 4), g1a = *(const f32x4*)(gq + 512 + 8 * F.lane), g1b = *(const f32x4*)(gq + 512 + 8 * F.lane + 4);
        const f32x4 gka = *(const f32x4*)(gkv + 8 * F.lane), gkb = *(const f32x4*)(gkv + 8 * F.lane + 4);
        v4u o0, o1, ok;
        o0.x = pk2(fq[0] * rq * g0a[0], fq[1] * rq * g0a[1]); o0.y = pk2(fq[2] * rq * g0a[2], fq[3] * rq * g0a[3]); o0.z = pk2(fq[4] * rq * g0b[0], fq[5] * rq * g0b[1]); o0.w = pk2(fq[6] * rq * g0b[2], fq[7] * rq * g0b[3]);
        o1.x = pk2(fq[8] * rq * g1a[0], fq[9] * rq * g1a[1]); o1.y = pk2(fq[10] * rq * g1a[2], fq[11] * rq * g1a[3]); o1.z = pk2(fq[12] * rq * g1b[0], fq[13] * rq * g1b[1]); o1.w = pk2(fq[14] * rq * g1b[2], fq[15] * rq * g1b[3]);
        ok.x = pk2(fk[0] * rk * gka[0], fk[1] * rk * gka[1]); ok.y = pk2(fk[2] * rk * gka[2], fk[3] * rk * gka[3]); ok.z = pk2(fk[4] * rk * gkb[0], fk[5] * rk * gkb[1]); ok.w = pk2(fk[6] * rk * gkb[2], fk[7] * rk * gkb[3]);
        *(GAS v4u*)(CQN + (size_t)m * Q_LORA + 8 * F.lane) = o0; *(GAS v4u*)(CQN + (size_t)m * Q_LORA + 512 + 8 * F.lane) = o1; *(GAS v4u*)(CKVN + (size_t)m * KV_LORA + 8 * F.lane) = ok;
        if (F.lane < 32) { const unsigned u = *(const GAS unsigned*)(pr + C1_KR + 2 * F.lane); const float x1 = __uint_as_float(u << 16), x2 = __uint_as_float(u & 0xffff0000u);
            const float cn = cs[(size_t)m * 64 + F.lane], sn = cs[(size_t)m * 64 + 32 + F.lane];
            *(GAS unsigned*)(KR + (size_t)m * 64 + 2 * F.lane) = pk2(x1 * cn - x2 * sn, x1 * sn + x2 * cn); }
    }
}

__device__ __forceinline__ int t5_bucket(int n) {
    if (n < 16) return n;
    const float nf = (float)(n > 1 ? n : 1);
    int large = 16 + (int)(logf(nf / 16.0f) / 4.852030263919617f * 16.0f);
    return large < 31 ? large : 31;
}
__device__ __forceinline__ void dil_ref(unsigned char* ws, int id, at::Ref& R) {
    const int j = id & 31, h = (id >> 5) & 15, b = (id >> 9) & 1, p = id >> 10; const int d = p == 0 ? 1 : (p == 1 ? 4 : 16);
    const int nblk = 32 / d, res = j / nblk, n = j % nblk;
    const at::bf16_t* pr = (const at::bf16_t*)(ws + WS_PROJ0) + ((size_t)b * SEQ + res) * N0 + h * HD;
    const long st = (long)d * N0;
    R.K = pr + C_KA; R.V = pr + C_VA; R.Q = pr + C_QA + (size_t)(256 * n) * st; R.Qr = nullptr; R.Kr = nullptr; R.qs = (int)st; R.ks = (int)st; R.P0 = 256 * n; R.dir = 0; R.jlo = 0;
    const size_t orow = (size_t)b * SEQ + res + (size_t)d * 256 * n;
    R.O = (at::bf16_t*)(ws + WS_OP) + ((size_t)p * M + orow) * 2048 + h * HD; R.os = d * 2048; R.Z = nullptr; R.zs = 0;
    R.LSE = (float*)(ws + WS_LSE) + ((size_t)p * M + orow) * 16 + h; R.ls = d * 16;
}
struct MkDil { unsigned char* ws; __device__ __forceinline__ void operator()(const at::Blk& k, at::Ref& R) const { dil_ref(ws, k.a, R); } };
__device__ __forceinline__ void dilated_phase(Ctx& F) {
    char* lds = (char*)F.lds + RING_OFF;
    const int total = 3 * BATCH * NHA * 32, chunk = (total + F.G - 1) / F.G; int id = F.vcu * chunk; const int end = (id + chunk < total) ? id + chunk : total;
    if (id >= end) return;
    const MkDil mk{F.ws}; int key = -1;
    at::Seam<at::K_DIL> S;
    at::attn_prime<at::K_DIL>(at::Blk{id, 0, 0}, mk, at::DIL_W, lds, S);
    for (;;) {
        const int kcur = ((id >> 10) << 4) | ((id >> 5) & 15);
        if (kcur != key) {
            key = kcur; const int p = key >> 4, h = key & 15, d = p == 0 ? 1 : (p == 1 ? 4 : 16);
            float* tbl = (float*)(lds + at::OFF_BIAS); const float* relb = IN_RELB(F);
            for (int u = F.tid; u < at::TBL_N; u += NWAVES * 64) { const int dist = at::TBL_TOP - u;
                tbl[u] = (dist >= 0 && dist <= 128) ? relb[t5_bucket(dist * d) * NHA + h] * 11.313708498984761f : -__builtin_inff(); }
            __syncthreads();
        }
        const bool last = id + 1 >= end;
        const int dcur = (id >> 10) == 0 ? 1 : ((id >> 10) == 1 ? 4 : 16);
        at::attn_block<at::K_DIL, 0>(at::Blk{id, 0, 0}, at::Blk{last ? id : id + 1, 0, 0}, mk, SEQ / dcur, at::DIL_W, lds, S);
        if (last) break;
        ++id;
    }
}
__device__ __forceinline__ bool causal_sched(const Ctx& F, int s, int npairs_total, int& bh, int& qb, int& dir) {
    if (F.G == 256) { const int x = F.vcu >> 5, i = F.vcu & 31, per = npairs_total / 8, r = s >> 1; if (r >= per) return false;
        bh = 2 * (x * per + r) + (s & 1); qb = (s & 1) ? 31 - i : i; dir = s & 1; return true; }
    const int item = F.vcu + (s >> 1) * F.G; if (item >= npairs_total * 32) return false;
    bh = item >> 4; qb = (s & 1) ? 31 - (item & 15) : (item & 15); dir = 0; return true;
}
__device__ __forceinline__ void fox_ref(unsigned char* ws, int bh, int qb, int jlo, at::Ref& R) {
    const int b = bh >> 4, h = bh & 15;
    const at::bf16_t* pr = (const at::bf16_t*)(ws + WS_PROJ0) + (size_t)b * SEQ * N0 + h * HD;
    R.K = pr + C_KB; R.V = pr + C_VB; R.Q = pr + C_QB + (size_t)(256 * qb) * N0; R.Qr = nullptr; R.Kr = nullptr; R.qs = N0; R.ks = N0; R.P0 = 256 * qb; R.dir = 1  ; R.jlo = jlo;
    const size_t orow = (size_t)b * SEQ + 256 * qb;
    R.O = (at::bf16_t*)(ws + WS_G) + orow * DM + 2048 + h * HD; R.os = DM; R.Z = pr + C_Z0 + 2048 + (size_t)(256 * qb) * N0; R.zs = N0; R.LSE = nullptr; R.ls = 0;
}
struct MkFox { unsigned char* ws; __device__ __forceinline__ void operator()(const at::Blk& k, at::Ref& R) const { fox_ref(ws, k.a, k.b, k.c, R); } };
__device__ __forceinline__ void fox_bias(Ctx& F, int bh, char* lds) {
    int tl = F.tid; asm volatile("" : "+v"(tl));
    const int ll = tl & 63;
    const int b = bh >> 4, h = bh & 15; const float* fl = (const float*)(F.ws + WS_FLOGIT) + ((size_t)b * SEQ + 16 * tl) * 16 + h; const float bf = IN_BF(F)[h];
    float ls[16]; double run = 0.0;
#pragma unroll
    for (int i = 0; i < 16; ++i) { const float xv = fl[i * 16] + bf; ls[i] = (xv >= 0.f) ? -log1pf(expf(-xv)) : xv - log1pf(expf(xv)); run += (double)ls[i]; }
    double inc = run;
#pragma unroll
    for (int o = 1; o < 64; o <<= 1) { const double t = __shfl_up(inc, o); if (ll >= o) inc += t; }
    LAS double* wt = (LAS double*)(lds + at::OFF_WS);
    if (ll == 63) wt[F.wave] = inc;
    __syncthreads();
    double pre = inc - run;
    for (int w = 0; w < F.wave; ++w) pre += wt[w];
    float* bias = (float*)(lds + at::OFF_BIAS) + 16 * tl;
#pragma unroll
    for (int i = 0; i < 16; ++i) { pre += (double)ls[i]; bias[i] = (float)(-pre * 11.313708498984761); }
    __syncthreads();
}
__device__ __forceinline__ int fox_jlo(Ctx& F, int bh, int qb, char* lds) {
    int tl = F.tid; asm volatile("" : "+v"(tl));
    const unsigned* nk = (const unsigned*)(F.ws + WS_NRMK) + (size_t)bh * 512;
    const float* bias = (const float*)(lds + at::OFF_BIAS);
    LAS float* sc = (LAS float*)(lds + at::OFF_WS);
    float sd = 3.0e38f, qn = 0.f;
    if (tl < 256) { const int b = bh >> 4, h = bh & 15;
        const at::bf16_t* rowp = (const at::bf16_t*)(F.ws + WS_PROJ0) + ((size_t)b * SEQ + 256 * qb + tl) * N0 + h * HD;
        float a = 0.f;
#pragma unroll
        for (int c = 0; c < 16; ++c) { const v4u q8 = *(const GAS v4u*)(rowp + C_QB + 8 * c), k8 = *(const GAS v4u*)(rowp + C_KB + 8 * c);
#pragma unroll
            for (int e = 0; e < 4; ++e) { const float ql = __uint_as_float(q8[e] << 16), qh = __uint_as_float(q8[e] & 0xffff0000u);
                a += ql * __uint_as_float(k8[e] << 16); a += qh * __uint_as_float(k8[e] & 0xffff0000u); qn += ql * ql; qn += qh * qh; } }
        sd = a;
#pragma unroll
        for (int o = 1; o < 64; o <<= 1) { sd = fminf(sd, __shfl_xor(sd, o)); qn = fmaxf(qn, __shfl_xor(qn, o)); }
        if ((tl & 63) == 0) { sc[4 + (tl >> 6)] = sd; sc[8 + (tl >> 6)] = qn; } }
    __syncthreads();
    int first = 999; float e = 0.f; bool cand = false;
    if (tl < 128) { const float smin = fminf(fminf(sc[4], sc[5]), fminf(sc[6], sc[7]));
        const uint4 wk = *(const uint4*)(nk + 4 * tl); const float k2 = __uint_as_float(wk.x) + __uint_as_float(wk.y) + __uint_as_float(wk.z) + __uint_as_float(wk.w);
        const float q2 = fmaxf(fmaxf(sc[8], sc[9]), fmaxf(sc[10], sc[11]));
        const float qk = (1.02f * sqrtf(q2) * sqrtf(k2) - smin) * 0.08838834764831845f + 0.01f;
        const float Ft0 = -bias[256 * qb] * 0.08838834764831845f, Fe = -bias[64 * tl + 63] * 0.08838834764831845f;
        cand = tl < 4 * qb;
        e = cand ? 64.0f * __expf(fminf(qk + (Ft0 - Fe), 0.f)) : 1.0f;
#pragma unroll
        for (int o = 1; o < 64; o <<= 1) { const float v = __shfl_up(e, o); if ((tl & 63) >= o) e += v; }
        if ((tl & 63) == 63) sc[12 + (tl >> 6)] = e; }
    __syncthreads();
    if (tl < 128) { const float pre = e + ((tl >> 6) ? sc[12] : 0.f);
        const bool prune = cand && pre < 5.0e-8f;
        const unsigned long long keep = __ballot(!prune);
        first = (tl & 64) + (keep ? __ffsll((long long)keep) - 1 : 64);
        if ((tl & 63) == 0) sc[2 + (tl >> 6)] = __int_as_float(first); }
    __syncthreads();
    const int f0 = __float_as_int(sc[2]), f1 = __float_as_int(sc[3]);
    const int jlo = f0 < 64 ? f0 : f1;
    __syncthreads();
    return __builtin_amdgcn_readfirstlane(jlo);
}
__device__ __forceinline__ void fox_phase(Ctx& F) {
    char* lds = (char*)F.lds + RING_OFF;
    int bias_bh = -1;
    const MkFox mk{F.ws};
    at::Seam<at::K_FOX> S;
    gu32* qh = (gu32*)(F.ws + WS_CTL) + CW_QUEUE;
    LAS int* tick = (LAS int*)(lds + at::OFF_WS + 64);
    for (;;) {
        if (F.tid == 0) *tick = (int)__hip_atomic_fetch_add(qh, 1u, __ATOMIC_RELAXED, __HIP_MEMORY_SCOPE_AGENT);
        __syncthreads();
        const int t = __builtin_amdgcn_readfirstlane(*tick);
        __syncthreads();
        if (t >= BATCH * NHB * 32) break;
        const int qb = 31 - (t >> 5), bh = t & 31;
        if (bh != bias_bh) { fox_bias(F, bh, lds); bias_bh = bh; }
        const int jlo = fox_jlo(F, bh, qb, lds);
        const at::Blk cur{bh, qb, jlo};
        at::attn_prime<at::K_FOX>(cur, mk, 1 << 30, lds, S);
        at::attn_block<at::K_FOX, 0>(cur, cur, mk, SEQ, 1 << 30, lds, S);
    }
}
template <int VAR>
__device__ __forceinline__ void mla_ref(unsigned char* ws, int bh, int qb, int dir, at::Ref& R) {
    const int b = bh >> 5, h = bh & 31;
    const at::bf16_t* qp = (const at::bf16_t*)(ws + WS_QBUF) + ((size_t)b * SEQ + 256 * qb) * NQ; const at::bf16_t* kvp = (const at::bf16_t*)(ws + WS_KVBUF) + (size_t)b * SEQ * NKV;
    R.Q = qp + h * HD; R.Qr = qp + 4096 + h * 64; R.K = kvp + h * HD; R.V = kvp + 4096 + h * HD; R.Kr = (const at::bf16_t*)(ws + WS_KROPE) + (size_t)b * SEQ * 64; R.qs = NQ; R.ks = NKV; R.P0 = 256 * qb; R.dir = dir; R.jlo = 0;
    const size_t orow = (size_t)b * SEQ + 256 * qb;
    R.O = (at::bf16_t*)(ws + WS_G) + orow * DM + h * HD; R.os = DM; R.Z = (const at::bf16_t*)(ws + WS_PROJ1) + orow * N1 + C1_Z + h * HD; R.zs = N1; R.LSE = nullptr; R.ls = 0;
}
template <int VAR> struct MkMla { unsigned char* ws; __device__ __forceinline__ void operator()(const at::Blk& k, at::Ref& R) const { mla_ref<VAR>(ws, k.a, k.b, k.c, R); } };
template <int VAR>
__device__ __forceinline__ void mla_phase(Ctx& F) {
    char* lds = (char*)F.lds + RING_OFF;
    int s = 0; at::Blk cur, nxt;
    if (!causal_sched(F, 0, BATCH * NHC / 2, cur.a, cur.b, cur.c)) return;
    const MkMla<VAR> mk{F.ws};
    t32::Seam S;
    t32::attn_prime(cur, mk, lds, S);
    for (;;) {
        const bool last = !causal_sched(F, s + 1, BATCH * NHC / 2, nxt.a, nxt.b, nxt.c);
        if (last) nxt = cur;
        t32::attn_block(cur, nxt, mk, SEQ, lds, S);
        if (last) break;
        cur = nxt; ++s;
    }
}

__global__ void __launch_bounds__(NWAVES * 64, 2) fwd_kernel(Args args) {
    extern __shared__ __attribute__((aligned(16))) unsigned char lds[];
    Ctx F;
    F.lds = (LAS unsigned char*)lds;
    volatile LAS unsigned* MISC = (volatile LAS unsigned*)(F.lds + MISC_OFF);
    F.tid = threadIdx.x; F.lane = F.tid & 63; F.wave = __builtin_amdgcn_readfirstlane(F.tid >> 6);
    F.G = gridDim.x; { const int bx = blockIdx.x; F.vcu = (F.G % 8 == 0) ? (bx % 8) * (F.G / 8) + bx / 8 : bx; }
    F.A = (const __attribute__((address_space(4))) Args*)__builtin_amdgcn_kernarg_segment_ptr();
    F.out = args.out; F.ws = args.ws;
    unsigned char* ws = args.ws;
    gu32* ctl = (gu32*)(ws + WS_CTL);
    for (int u = F.tid; u < (LDS_BYTES - LDSCTL_OFF) / 4; u += NWAVES * 64) ((LAS unsigned*)(F.lds + LDSCTL_OFF))[u] = 0u;
    __syncthreads();
    XcdBarrier bar; bar.bar = (unsigned*)(ctl + CW_BAR); bar.x = 0; bar.st = nullptr;
    if (!MK_PER_PHASE) bar = xcd_barrier_post((unsigned*)(ctl + CW_BAR), MISC + 8);
    const int lo = args.ph_lo, hi = args.ph_hi;
#define IN(k) (lo <= (k) && (k) < hi)
#define SEAM(k) do { if (IN(k) && IN((k) + 1)) xcd_barrier(bar); } while (0)
    float* mod = (float*)(ws + WS_MOD);
    bf16* XN = (bf16*)(ws + WS_XN); bf16* G = (bf16*)(ws + WS_G);

#define PH0 { p0_prologue(F); }
#define PH1 { adaln_rows(F, IN_X(F), IN_GNORM(F), mod, XN); }
#define PH2 { flogit_rows(F); \
        pg8::Gemm g{XN, (const bf16*)(ws + WS_BT0), M, N0, DM}; pg8::StaticOrder S; S.init(M, N0, F.G, (int)blockIdx.x); \
        pg8::EpiBf16Nrm E{(bf16*)(ws + WS_PROJ0), N0, (unsigned*)(ws + WS_NRMQ), (unsigned*)(ws + WS_NRMK), 1 << 20  , C_KB / 256, SEQ}; \
        pg8::gemm_phase<pg8::EpiBf16Nrm, pg8::StaticOrder, true, true>(F.lds + RING_OFF, g, S, E); }
#define PH3 { dilated_phase(F); __syncthreads(); fox_phase(F); }
#define PH4 { combine_rows(F); }
#define PH5 { pg8::Gemm g{G, (const bf16*)(ws + WS_WO0), M, DM, DM}; pg8::StaticOrder S; S.init(M, DM, F.G, (int)blockIdx.x); \
        pg8::EpiGateBf16 E{(bf16*)(ws + WS_Y1), DM, mod + 2 * DM, 3 * DM, SEQ}; \
        pg8::gemm_phase<pg8::EpiGateBf16, pg8::StaticOrder, true, true>(F.lds + RING_OFF, g, S, E); }
#define PH6 { adaln_add_rows(F, IN_X(F), (const bf16*)(ws + WS_Y1), IN_GNORM(F) + DM, mod + BATCH * 3 * DM, XN); }
#define PH7 { pg8::Gemm g{XN, (const bf16*)(ws + WS_BT1), M, N1, DM}; pg8::StaticOrder S; S.init(M, N1, F.G, (int)blockIdx.x); \
        pg8::EpiBf16<0> E{(bf16*)(ws + WS_PROJ1), N1, nullptr, 0, 0, 1.f}; \
        pg8::gemm_phase<pg8::EpiBf16<0>, pg8::StaticOrder, true, true>(F.lds + RING_OFF, g, S, E); }
#define PH8 { mla_norm_rows(F); }
#define PH9 { { pg8::Gemm g{(const bf16*)(ws + WS_CQN), (const bf16*)(ws + WS_WQB), M, NQ, Q_LORA}; pg8::StaticOrder S; S.init(M, NQ, F.G, (int)blockIdx.x); \
          pg8::EpiQRope E{(bf16*)(ws + WS_QBUF), NQ, (const float*)(ws + WS_CS), 4096, t32::QMUL}; \
          pg8::gemm_phase<pg8::EpiQRope, pg8::StaticOrder, true, true>(F.lds + RING_OFF, g, S, E); } \
        __syncthreads(); \
        { pg8::Gemm g{(const bf16*)(ws + WS_CKVN), (const bf16*)(ws + WS_WKVB), M, NKV, KV_LORA}; pg8::StaticOrder S; S.init(M, NKV, F.G, (int)blockIdx.x); \
          pg8::EpiBf16<0> E{(bf16*)(ws + WS_KVBUF), NKV, nullptr, 0, 0, 1.f}; \
          pg8::gemm_phase<pg8::EpiBf16<0>, pg8::StaticOrder, true, true>(F.lds + RING_OFF, g, S, E); } }
#define PH10 { mla_phase<0>(F); }
#define PH11 { pg8::Gemm g{G, (const bf16*)(ws + WS_WO1), M, DM, DM}; pg8::StaticOrder S; S.init(M, DM, F.G, (int)blockIdx.x); \
        pg8::EpiGateBf16 E{(bf16*)(ws + WS_Y2), DM, mod + BATCH * 3 * DM + 2 * DM, 3 * DM, SEQ}; \
        pg8::gemm_phase<pg8::EpiGateBf16, pg8::StaticOrder, true, true>(F.lds + RING_OFF, g, S, E); }
#define PH12 { final_rows(F); }
#define RUN(k, BODY) do { if (IN(k)) { BODY } SEAM(k); } while (0)
    RUN(0, PH0); RUN(1, PH1); RUN(2, PH2); RUN(3, PH3); RUN(4, PH4); RUN(5, PH5); RUN(6, PH6); RUN(7, PH7); RUN(8, PH8); RUN(9, PH9); RUN(10, PH10);
    if (IN(11)) PH11 SEAM(11);
    if (IN(12)) PH12
#undef IN
#undef SEAM
}

extern "C" void kernel_launch(void* const* d_in, const int* in_sizes, int n_in, void* d_out, int out_size, void* d_ws, size_t ws_size, hipStream_t stream) {
    static int grid = 0;
    if (grid == 0) {
        if (n_in != 17 || in_sizes[0] != M * DM || out_size != M * DM || ws_size < WS_END) { fprintf(stderr, "kernel_launch: unexpected shapes (n_in %d, in0 %d, out %d, ws %zu, need %zu); nothing launched\n", n_in, n_in > 0 ? in_sizes[0] : -1, out_size, ws_size, (size_t)WS_END); grid = -1; return; }
        int dev = 0, cus = 0, per_cu = 0;
        if (hipGetDevice(&dev) != hipSuccess || hipDeviceGetAttribute(&cus, hipDeviceAttributeMultiprocessorCount, dev) != hipSuccess) { grid = -1; return; }
        if (hipFuncSetAttribute((const void*)fwd_kernel, hipFuncAttributeMaxDynamicSharedMemorySize, LDS_BYTES) != hipSuccess) { fprintf(stderr, "kernel_launch: hipFuncSetAttribute failed\n"); grid = -1; return; }
        if (hipOccupancyMaxActiveBlocksPerMultiprocessor(&per_cu, (const void*)fwd_kernel, NWAVES * 64, LDS_BYTES) != hipSuccess || per_cu < 1) { fprintf(stderr, "kernel_launch: occupancy query says %d\n", per_cu); }
        (void)hipGetLastError();
        grid = cus;
    }
    if (grid < 0) return;
    if (hipMemsetAsync((char*)d_ws + WS_CTL, 0, CTL_ZERO_BYTES, stream) != hipSuccess) return;
    Args a{};
    for (int i = 0; i < 17; ++i) a.in[i] = d_in[i];
    a.out = (float*)d_out; a.ws = (unsigned char*)d_ws;
#if MK_PER_PHASE
    for (int p = 0; p < N_PHASES; ++p) { a.ph_lo = p; a.ph_hi = p + 1; hipLaunchKernelGGL(fwd_kernel, dim3(grid), dim3(NWAVES * 64), LDS_BYTES, stream, a); }
#else
    a.ph_lo = 0; a.ph_hi = N_PHASES;
    hipLaunchKernelGGL(fwd_kernel, dim3(grid), dim3(NWAVES * 64), LDS_BYTES, stream, a);
#endif
    const hipError_t le = hipPeekAtLastError();
    if (le != hipSuccess) fprintf(stderr, "kernel_launch: launch failed: %s\n", hipGetErrorName(le));
}
```

```cpp
#include <hip/hip_runtime.h>

#include <cstdio>
#include <cstdint>
#include <cmath>
namespace pg8 {
#define PG8_LAS __attribute__((address_space(3)))
typedef unsigned short bf16_t;
typedef short bf16x8 __attribute__((ext_vector_type(8)));
typedef float f32x4 __attribute__((ext_vector_type(4)));
typedef unsigned u32x4 __attribute__((ext_vector_type(4)));
constexpr int BM = 256, BK = 64, HALF = 128, HTB = HALF * BK * 2  , STAGE_BYTES = 8 * HTB, NXCD = 8, WGM = 8;

__host__ __device__ __forceinline__ int lds_byte(int r, int c) { const int st = (r >> 4) * 2 + (c >> 5), rr = r & 15, cc = c & 31, ob = rr * 64 + cc * 2; return st * 1024 + (ob ^ (((ob >> 9) & 1) << 5)); }
__host__ __device__ __forceinline__ void stage_rc(int b, int& R, int& C) { const int st = b / 1024, sb = b % 1024, swz = sb ^ (((sb >> 9) & 1) << 5); R = (st >> 1) * 16 + swz / 64; C = (st & 1) * 32 + (swz % 64) / 2; }
__host__ __device__ __forceinline__ int perm32(int rho) { const int n = rho >> 4, i = rho & 15; return 8 * (i >> 2) + 4 * n + (i & 3); }

struct Unit { int pm, pn; };
struct Gemm { const bf16_t* A; const bf16_t* Bt; int M, N, K; };

struct StaticOrder {
    int nM, nN, nwg, G, c;
    __host__ __device__ void init(int M, int N, int G_, int c_) { nM = M / BM; nN = N / BM; nwg = nM * nN; G = G_; c = c_; }
    __host__ __device__ bool next(int i, Unit& u) const {
        const long L = (long)i * G + c; if (L >= nwg) return false;
        int wgid = (int)L; { const int q = nwg / NXCD, r = nwg % NXCD, xcd = wgid % NXCD, off = wgid / NXCD; wgid = (xcd < r ? xcd * (q + 1) : r * (q + 1) + (xcd - r) * q) + off; }
        const int nig = WGM * nN, gid = wgid / nig, fm = gid * WGM, gsz = (nM - fm) < WGM ? (nM - fm) : WGM;
        u.pm = fm + ((wgid % nig) % gsz); u.pn = (wgid % nig) / gsz; return true;
    }
    __device__ __forceinline__ void a_ready(const Unit&) const {}
    __device__ __forceinline__ void done(const Unit&) const {}
};

__device__ __forceinline__ unsigned cvt_pk_bf16(float lo, float hi) { unsigned r; asm volatile("v_cvt_pk_bf16_f32 %0, %1, %2" : "=v"(r) : "v"(lo), "v"(hi)); return r; }
typedef float f32x2 __attribute__((ext_vector_type(2)));
__device__ __forceinline__ f32x2 gelu_pk(f32x2 v) {
    const f32x2 av = __builtin_elementwise_abs(v), d = av * 0.2316418882f + 1.0f;
    f32x2 t; t.x = __builtin_amdgcn_rcpf(d.x); t.y = __builtin_amdgcn_rcpf(d.y);
    f32x2 q = t * 0.5307027145f + (-0.7265760135f); q = q * t + 0.7107068705f; q = q * t + (-0.142248368f); q = q * t + 0.127414796f; q = q * t;
    const f32x2 s = (v * v) * (-0.72134752044f);
    f32x2 e; e.x = __builtin_amdgcn_exp2f(s.x); e.y = __builtin_amdgcn_exp2f(s.y);
    const f32x2 m = v * (q * e), r = v - m;
    f32x2 o; o.x = v.x < 0.f ? m.x : r.x; o.y = v.y < 0.f ? m.y : r.y; return o;
}

template <int ACT  > struct EpiBf16 {
    static constexpr bool PERM = true, AFTER_DRAIN = false; static_assert(ACT == 0 || ACT == 1, "EpiBf16: ACT is 0 (none) or 1 (gelu_pk)");
    bf16_t* O; int ldc; const float* bias; int split_cols; size_t split_stride; float scale0;
    __device__ __forceinline__ void operator()(const f32x4 (&acc)[2][2][4][2], const Unit& u, int wr, int wc, int fr, int fq) const {
        const int row0 = u.pm * BM + wr * 64 + fr; int colt = u.pn * BM; bf16_t* base = O;
        float sc = 1.f; if (split_cols) { const int t = colt / split_cols; base += (size_t)t * split_stride; colt -= t * split_cols; if (t == 0) sc = scale0; }
        const int col0 = colt + wc * 32 + 8 * fq, bcol0 = u.pn * BM + wc * 32 + 8 * fq;
        f32x4 bv[2][2];
#pragma unroll
        for (int bj = 0; bj < 2; ++bj)
#pragma unroll
            for (int n = 0; n < 2; ++n) bv[bj][n] = bias ? *(const f32x4*)(bias + bcol0 + bj * HALF + 4 * n) : (f32x4){0.f, 0.f, 0.f, 0.f};
#pragma unroll
        for (int ai = 0; ai < 2; ++ai)
#pragma unroll
            for (int m = 0; m < 4; ++m) { bf16_t* rowp = base + (size_t)(row0 + ai * HALF + m * 16) * ldc + col0;
#pragma unroll
                for (int bj = 0; bj < 2; ++bj) { f32x4 v0 = acc[ai][bj][m][0] + bv[bj][0], v1 = acc[ai][bj][m][1] + bv[bj][1];
                    if (ACT == 1) { f32x2 a = gelu_pk((f32x2){v0[0], v0[1]}), b = gelu_pk((f32x2){v0[2], v0[3]}), c = gelu_pk((f32x2){v1[0], v1[1]}), d = gelu_pk((f32x2){v1[2], v1[3]});
                        v0 = (f32x4){a.x, a.y, b.x, b.y}; v1 = (f32x4){c.x, c.y, d.x, d.y}; }
                    v0 = v0 * sc; v1 = v1 * sc; u32x4 w; w.x = cvt_pk_bf16(v0[0], v0[1]); w.y = cvt_pk_bf16(v0[2], v0[3]); w.z = cvt_pk_bf16(v1[0], v1[1]); w.w = cvt_pk_bf16(v1[2], v1[3]);
                    *(u32x4*)(rowp + bj * HALF) = w; } }
    }
};
struct EpiQRope {
    static constexpr bool PERM = true, AFTER_DRAIN = false;
    bf16_t* O; int ldc; const float* cs; int rope_col0; float qmul;
    __device__ __forceinline__ void operator()(const f32x4 (&acc)[2][2][4][2], const Unit& u, int wr, int wc, int fr, int fq) const {
        const int row0 = u.pm * BM + wr * 64 + fr; const int colt = u.pn * BM;
        const int col0 = colt + wc * 32 + 8 * fq;
        const bool rope = colt >= rope_col0;
        const int j0 = ((wc & 1) * 32 + 8 * fq) >> 1;
#pragma unroll
        for (int ai = 0; ai < 2; ++ai)
#pragma unroll
            for (int m = 0; m < 4; ++m) { const int row = row0 + ai * HALF + m * 16; bf16_t* rowp = O + (size_t)row * ldc + col0;
                f32x4 c = (f32x4){1.f, 1.f, 1.f, 1.f}, s = (f32x4){0.f, 0.f, 0.f, 0.f};
                if (rope) { c = *(const f32x4*)(cs + (size_t)row * 64 + j0); s = *(const f32x4*)(cs + (size_t)row * 64 + 32 + j0); }
                c *= qmul; s *= qmul;
#pragma unroll
                for (int bj = 0; bj < 2; ++bj) { const f32x4 v0 = acc[ai][bj][m][0], v1 = acc[ai][bj][m][1];
                    u32x4 w;
                    w.x = cvt_pk_bf16(v0[0] * c[0] - v0[1] * s[0], v0[0] * s[0] + v0[1] * c[0]);
                    w.y = cvt_pk_bf16(v0[2] * c[1] - v0[3] * s[1], v0[2] * s[1] + v0[3] * c[1]);
                    w.z = cvt_pk_bf16(v1[0] * c[2] - v1[1] * s[2], v1[0] * s[2] + v1[1] * c[2]);
                    w.w = cvt_pk_bf16(v1[2] * c[3] - v1[3] * s[3], v1[2] * s[3] + v1[3] * c[3]);
                    *(u32x4*)(rowp + bj * HALF) = w; } }
    }
};
struct EpiResGate {
    static constexpr bool PERM = false, AFTER_DRAIN = false;
    const float* base; float* out; int ldc; const float* gate; int gate_stride; int rows_per_batch;
    __device__ __forceinline__ void operator()(const f32x4 (&acc)[2][2][4][2], const Unit& u, int wr, int wc, int fr, int fq) const {
        const int col0 = u.pn * BM + wc * 32 + 4 * fq; const int b = (u.pm * BM) / rows_per_batch;
        f32x4 gv[2][2];
#pragma unroll
        for (int bj = 0; bj < 2; ++bj)
#pragma unroll
            for (int n = 0; n < 2; ++n) gv[bj][n] = *(const f32x4*)(gate + (size_t)b * gate_stride + col0 + bj * HALF + n * 16);
#pragma unroll
        for (int ai = 0; ai < 2; ++ai)
#pragma unroll
            for (int m = 0; m < 4; ++m) { const size_t off = (size_t)(u.pm * BM + ai * HALF + wr * 64 + m * 16 + fr) * ldc + col0;
#pragma unroll
                for (int bj = 0; bj < 2; ++bj)
#pragma unroll
                    for (int n = 0; n < 2; ++n) { const f32x4 bs = *(const f32x4*)(base + off + bj * HALF + n * 16);
                        *(f32x4*)(out + off + bj * HALF + n * 16) = bs + gv[bj][n] * acc[ai][bj][m][n]; }
                if (m & 1) asm volatile("" ::: "memory"); }
    }
};

struct EpiBf16Nrm {
    static constexpr bool PERM = true, AFTER_DRAIN = false;
    bf16_t* O; int ldc; unsigned* nq; unsigned* nk; int q_pn0, k_pn0, rows_per_batch;
    __device__ __forceinline__ void operator()(const f32x4 (&acc)[2][2][4][2], const Unit& u, int wr, int wc, int fr, int fq) const {
        const int row0 = u.pm * BM + wr * 64 + fr; const int col0 = u.pn * BM + wc * 32 + 8 * fq;
#pragma unroll
        for (int ai = 0; ai < 2; ++ai)
#pragma unroll
            for (int m = 0; m < 4; ++m) { bf16_t* rowp = O + (size_t)(row0 + ai * HALF + m * 16) * ldc + col0;
#pragma unroll
                for (int bj = 0; bj < 2; ++bj) { const f32x4 v0 = acc[ai][bj][m][0], v1 = acc[ai][bj][m][1];
                    u32x4 w; w.x = cvt_pk_bf16(v0[0], v0[1]); w.y = cvt_pk_bf16(v0[2], v0[3]); w.z = cvt_pk_bf16(v1[0], v1[1]); w.w = cvt_pk_bf16(v1[2], v1[3]);
                    *(u32x4*)(rowp + bj * HALF) = w; } }
        unsigned* dst = nullptr; int h0 = 0;
        if (u.pn >= q_pn0 && u.pn < q_pn0 + 8) { dst = nq; h0 = (u.pn - q_pn0) * 2; } else if (u.pn >= k_pn0 && u.pn < k_pn0 + 8) { dst = nk; h0 = (u.pn - k_pn0) * 2; }
        if (dst) {
            const int rt = u.pm * BM + wr * 64, b = rt / rows_per_batch;
#pragma unroll
            for (int ai = 0; ai < 2; ++ai)
#pragma unroll
                for (int bj = 0; bj < 2; ++bj) { float mx = 0.f;
#pragma unroll
                    for (int m = 0; m < 4; ++m) { const f32x4 a = acc[ai][bj][m][0], c = acc[ai][bj][m][1];
                        float s = (a[0] * a[0] + a[1] * a[1]) + (a[2] * a[2] + a[3] * a[3]) + (c[0] * c[0] + c[1] * c[1]) + (c[2] * c[2] + c[3] * c[3]);
                        s += __shfl_xor(s, 16); s += __shfl_xor(s, 32); mx = fmaxf(mx, s); }
                    mx = fmaxf(mx, __shfl_xor(mx, 1)); mx = fmaxf(mx, __shfl_xor(mx, 2)); mx = fmaxf(mx, __shfl_xor(mx, 4)); mx = fmaxf(mx, __shfl_xor(mx, 8));
                    if (fr == 0 && fq == 0) { const int t64 = ((rt + ai * HALF) % rows_per_batch) / 64;
                        atomicMax(dst + (((size_t)(b * 16 + h0 + bj)) * 128 + t64) * 4 + wc, __float_as_uint(mx)); } }
        }
    }
};

struct EpiGateBf16 {
    static constexpr bool PERM = true, AFTER_DRAIN = false;
    bf16_t* O; int ldc; const float* gate; int gate_stride; int rows_per_batch;
    __device__ __forceinline__ void operator()(const f32x4 (&acc)[2][2][4][2], const Unit& u, int wr, int wc, int fr, int fq) const {
        const int row0 = u.pm * BM + wr * 64 + fr; const int col0 = u.pn * BM + wc * 32 + 8 * fq; const int b = (u.pm * BM) / rows_per_batch;
        f32x4 gv[2][2];
#pragma unroll
        for (int bj = 0; bj < 2; ++bj)
#pragma unroll
            for (int n = 0; n < 2; ++n) gv[bj][n] = *(const f32x4*)(gate + (size_t)b * gate_stride + col0 + bj * HALF + 4 * n);
#pragma unroll
        for (int ai = 0; ai < 2; ++ai)
#pragma unroll
            for (int m = 0; m < 4; ++m) { bf16_t* rowp = O + (size_t)(row0 + ai * HALF + m * 16) * ldc + col0;
#pragma unroll
                for (int bj = 0; bj < 2; ++bj) { const f32x4 v0 = acc[ai][bj][m][0] * gv[bj][0], v1 = acc[ai][bj][m][1] * gv[bj][1];
                    u32x4 w; w.x = cvt_pk_bf16(v0[0], v0[1]); w.y = cvt_pk_bf16(v0[2], v0[3]); w.z = cvt_pk_bf16(v1[0], v1[1]); w.w = cvt_pk_bf16(v1[2], v1[3]);
                    *(u32x4*)(rowp + bj * HALF) = w; } }
    }
};

template <class Epi, class Sched, bool ALIGN_EPI = false, bool SP2 = false>
__device__ __forceinline__ void gemm_phase(PG8_LAS unsigned char* lds, const Gemm g, const Sched& S, const Epi& E) {
    const int tid = threadIdx.x, wid = __builtin_amdgcn_readfirstlane(tid >> 6), lane = tid & 63, wr = wid >> 2, wc = wid & 3, fr = lane & 15, fq = lane >> 4;
    const int K = g.K, nt = K / BK;
    unsigned voffA[2], voffB[2];
#pragma unroll
    for (int i = 0; i < 2; ++i) { int R, C; stage_rc(tid * 16 + i * 8192, R, C); const int Rb = Epi::PERM ? ((R & ~31) + perm32(R & 31)) : R;
        voffA[i] = (unsigned)(R * K + C) * 2u; voffB[i] = (unsigned)(Rb * K + C) * 2u; }
    const size_t kstep = (size_t)(BK * 2);
    const size_t hstep = (size_t)HALF * K * 2;
    const size_t tstep = 2 * hstep;
    const unsigned ldsw = (unsigned)wid * 1024u;
    const int aoff = lds_byte(wr * 64 + fr, fq * 8), boff = lds_byte(wc * 32 + fr, fq * 8);
#define PG8_SA(b, h) (((b) * 2 + (h)) * HTB)
#define PG8_SB(b, h) ((4 + (b) * 2 + (h)) * HTB)
#define PG8_STAGE(bufoff, gbase, voff) do { _Pragma("unroll") for (int _i = 0; _i < 2; ++_i) \
        __builtin_amdgcn_global_load_lds((const unsigned*)((const char*)(gbase) + (voff)[_i]), (PG8_LAS unsigned*)(lds + (bufoff) + ldsw + _i * 8192), 16, 0, 0); } while (0)
#define PG8_LDA(dst, b, h) do { _Pragma("unroll") for (int m = 0; m < 4; ++m) _Pragma("unroll") for (int k = 0; k < 2; ++k) dst[m][k] = *(const PG8_LAS bf16x8*)(lds + PG8_SA(b, h) + aoff + m * 2048 + k * 1024); } while (0)
#define PG8_LDB(dst, b, h) do { _Pragma("unroll") for (int n = 0; n < 2; ++n) _Pragma("unroll") for (int k = 0; k < 2; ++k) dst[n][k] = *(const PG8_LAS bf16x8*)(lds + PG8_SB(b, h) + boff + n * 2048 + k * 1024); } while (0)
#define PG8_MMA(ai, bj, At, Bt) do { __builtin_amdgcn_s_setprio(1); _Pragma("unroll") for (int m = 0; m < 4; ++m) _Pragma("unroll") for (int n = 0; n < 2; ++n) _Pragma("unroll") for (int k = 0; k < 2; ++k) \
        acc[ai][bj][m][n] = __builtin_amdgcn_mfma_f32_16x16x32_bf16(Bt[n][k], At[m][k], acc[ai][bj][m][n], 0, 0, 0); __builtin_amdgcn_s_setprio(0); } while (0)
#define PG8_WAIT_V(n) asm volatile("s_waitcnt vmcnt(" #n ")" ::: "memory")
#define PG8_WAIT_L(n) asm volatile("s_waitcnt lgkmcnt(" #n ")" ::: "memory")
#define PG8_BAR __builtin_amdgcn_s_barrier()
#define PG8_SCHED __builtin_amdgcn_sched_barrier(0)
    Unit cur, nxt; int ui = 0;
    if (!S.next(0, cur)) return;
    f32x4 acc[2][2][4][2];
#pragma unroll
    for (int a = 0; a < 2; ++a)
#pragma unroll
        for (int b = 0; b < 2; ++b)
#pragma unroll
            for (int m = 0; m < 4; ++m)
#pragma unroll
                for (int n = 0; n < 2; ++n) acc[a][b][m][n] = (f32x4){0.f, 0.f, 0.f, 0.f};
    bf16x8 At[4][2], B0[2][2], B1[2][2];
    const char* cA = (const char*)g.A + (size_t)cur.pm * tstep; const char* cB = (const char*)g.Bt + (size_t)cur.pn * tstep;
    S.a_ready(cur);
    if constexpr (SP2) {
        PG8_STAGE(PG8_SB(0, 0), cB, voffB); PG8_STAGE(PG8_SB(0, 1), cB + hstep, voffB); PG8_STAGE(PG8_SA(0, 0), cA, voffA); PG8_STAGE(PG8_SA(0, 1), cA + hstep, voffA);
        if (wr == 1) PG8_BAR;
        PG8_WAIT_V(2); PG8_BAR;
        PG8_STAGE(PG8_SB(1, 0), cB + kstep, voffB); PG8_STAGE(PG8_SA(1, 0), cA + kstep, voffA); PG8_STAGE(PG8_SB(1, 1), cB + hstep + kstep, voffB);
        PG8_WAIT_V(6); PG8_BAR;
    } else {
        PG8_STAGE(PG8_SB(0, 0), cB, voffB); PG8_STAGE(PG8_SA(0, 0), cA, voffA); PG8_STAGE(PG8_SB(0, 1), cB + hstep, voffB); PG8_STAGE(PG8_SA(0, 1), cA + hstep, voffA);
        if (wr == 1) PG8_BAR;
        PG8_WAIT_V(4); PG8_BAR;
        PG8_STAGE(PG8_SB(1, 0), cB + kstep, voffB); PG8_STAGE(PG8_SA(1, 0), cA + kstep, voffA); PG8_STAGE(PG8_SB(1, 1), cB + hstep + kstep, voffB);
        PG8_WAIT_V(6); PG8_BAR;
    }
    for (;;) {
        const bool has_next = S.next(ui + 1, nxt);
        const char* nA = has_next ? (const char*)g.A + (size_t)nxt.pm * tstep : cA; const char* nB = has_next ? (const char*)g.Bt + (size_t)nxt.pn * tstep : cB;
        for (int t = 0; t < nt; t += 2) {
            const bool last = (t == nt - 2);
            const char* a1 = cA + (size_t)(t + 1) * kstep;
            const char* a2 = last ? nA : cA + (size_t)(t + 2) * kstep; const char* b2 = last ? nB : cB + (size_t)(t + 2) * kstep;
            const char* a3 = a2 + kstep; const char* b3 = b2 + kstep;
            if (last && has_next) S.a_ready(nxt);
            if constexpr (SP2) {
            PG8_LDB(B0, 0, 0); PG8_LDB(B1, 0, 1); PG8_SCHED; PG8_LDA(At, 0, 0); PG8_STAGE(PG8_SA(1, 1), a1 + hstep, voffA);
            PG8_WAIT_V(8); PG8_WAIT_L(0); PG8_BAR; PG8_MMA(0, 0, At, B0); PG8_MMA(0, 1, At, B1); PG8_BAR; PG8_SCHED;
            PG8_LDA(At, 0, 1); PG8_STAGE(PG8_SB(0, 0), b2, voffB); PG8_STAGE(PG8_SB(0, 1), b2 + hstep, voffB); PG8_STAGE(PG8_SA(0, 0), a2, voffA);
            PG8_WAIT_V(8); PG8_WAIT_L(0); PG8_BAR; PG8_MMA(1, 0, At, B0); PG8_MMA(1, 1, At, B1); PG8_BAR; PG8_SCHED;
            PG8_LDB(B0, 1, 0); PG8_LDB(B1, 1, 1); PG8_SCHED; PG8_LDA(At, 1, 0); PG8_STAGE(PG8_SA(0, 1), a2 + hstep, voffA);
            PG8_WAIT_V(8); PG8_WAIT_L(0); PG8_BAR; PG8_MMA(0, 0, At, B0); PG8_MMA(0, 1, At, B1); PG8_BAR; PG8_SCHED;
            PG8_LDA(At, 1, 1); PG8_STAGE(PG8_SB(1, 0), b3, voffB); PG8_STAGE(PG8_SB(1, 1), b3 + hstep, voffB); PG8_STAGE(PG8_SA(1, 0), a3, voffA);
            PG8_WAIT_V(8); PG8_WAIT_L(0); PG8_BAR; PG8_MMA(1, 0, At, B0); PG8_MMA(1, 1, At, B1); PG8_BAR; PG8_SCHED;
            } else {
            PG8_LDB(B0, 0, 0); PG8_SCHED; PG8_LDA(At, 0, 0); PG8_STAGE(PG8_SA(1, 1), a1 + hstep, voffA);
            PG8_WAIT_L(8); PG8_BAR; PG8_WAIT_L(0); PG8_MMA(0, 0, At, B0); PG8_BAR; PG8_SCHED;
            PG8_LDB(B1, 0, 1); PG8_STAGE(PG8_SB(0, 0), b2, voffB);
            PG8_BAR; PG8_WAIT_L(0); PG8_MMA(0, 1, At, B1); PG8_BAR;
            PG8_LDA(At, 0, 1); PG8_STAGE(PG8_SA(0, 0), a2, voffA);
            PG8_BAR; PG8_WAIT_L(0); PG8_MMA(1, 0, At, B0); PG8_BAR; PG8_SCHED;
            PG8_STAGE(PG8_SB(0, 1), b2 + hstep, voffB);
            PG8_WAIT_V(6); PG8_BAR; PG8_MMA(1, 1, At, B1); PG8_BAR;
            PG8_LDB(B0, 1, 0); PG8_SCHED; PG8_LDA(At, 1, 0); PG8_STAGE(PG8_SA(0, 1), a2 + hstep, voffA);
            PG8_WAIT_L(8); PG8_BAR; PG8_WAIT_L(0); PG8_MMA(0, 0, At, B0); PG8_BAR; PG8_SCHED;
            PG8_LDB(B1, 1, 1); PG8_STAGE(PG8_SB(1, 0), b3, voffB);
            PG8_BAR; PG8_WAIT_L(0); PG8_MMA(0, 1, At, B1); PG8_BAR;
            PG8_LDA(At, 1, 1); PG8_STAGE(PG8_SA(1, 0), a3, voffA);
            PG8_BAR; PG8_WAIT_L(0); PG8_MMA(1, 0, At, B0); PG8_BAR; PG8_SCHED;
            PG8_STAGE(PG8_SB(1, 1), b3 + hstep, voffB);
            PG8_WAIT_V(6); PG8_BAR; PG8_MMA(1, 1, At, B1); PG8_BAR;
            }
        }
        if constexpr (ALIGN_EPI) { if (wr == 0) PG8_BAR; }
        if constexpr (!Epi::AFTER_DRAIN) { E(acc, cur, wr, wc, fr, fq); S.done(cur); }
        if (!has_next) break;
#pragma unroll
        for (int a = 0; a < 2; ++a)
#pragma unroll
            for (int b = 0; b < 2; ++b)
#pragma unroll
                for (int m = 0; m < 4; ++m)
#pragma unroll
                    for (int n = 0; n < 2; ++n) acc[a][b][m][n] = (f32x4){0.f, 0.f, 0.f, 0.f};
        cur = nxt; cA = nA; cB = nB; ++ui;
        if constexpr (ALIGN_EPI) { if (wr == 1) PG8_BAR; }
    }
    PG8_WAIT_V(0);
    if constexpr (!ALIGN_EPI) { if (wr == 0) PG8_BAR; }
    PG8_BAR;
    if constexpr (Epi::AFTER_DRAIN) { E.fused(acc, cur, wr, wc, fr, fq, lds, wid, lane); S.done(cur); }
#undef PG8_SA
#undef PG8_SB
#undef PG8_STAGE
#undef PG8_LDA
#undef PG8_LDB
#undef PG8_MMA
#undef PG8_WAIT_V
#undef PG8_WAIT_L
#undef PG8_BAR
#undef PG8_SCHED
}
}
namespace at {
typedef unsigned short bf16_t;
typedef short bf16x8 __attribute__((ext_vector_type(8)));
typedef short s16x4 __attribute__((ext_vector_type(4)));
typedef float f32x16 __attribute__((ext_vector_type(16)));
typedef float f32x4 __attribute__((ext_vector_type(4)));
typedef unsigned u32x4 __attribute__((ext_vector_type(4)));
enum { K_DIL = 0, K_FOX = 1, K_MLA = 2 };
constexpr int NW = 8, QBLK = 32, KVBLK = 64, QB = NW * QBLK, D = 128;
constexpr int SHM_V = KVBLK * D * 2, K_ROW = 272, SHM_K = KVBLK * K_ROW, KR_ROW = 144, SHM_KR = KVBLK * KR_ROW;
constexpr int OFF_V = 0, OFF_K = 2 * SHM_V, OFF_KR = OFF_K + 2 * SHM_K, OFF_WS = OFF_KR + 2 * SHM_KR, OFF_BIAS = OFF_WS + NW * 64 * 4, BIAS_BYTES = 32768, LDS_BYTES = OFF_BIAS + BIAS_BYTES;
constexpr int DIL_W = 129, TBL_N = 640, TBL_TOP = 383;
template <int KIND> struct Cfg;
template <> struct Cfg<K_DIL> { static constexpr float SCALE = 0.08838834764831845f; static constexpr int NQ = 8; static constexpr bool SK = true; };
template <> struct Cfg<K_FOX> { static constexpr float SCALE = 0.08838834764831845f; static constexpr int NQ = 8; static constexpr bool SK = false; };
template <> struct Cfg<K_MLA> { static constexpr float SCALE = 0.07216878364870322f; static constexpr int NQ = 12; static constexpr bool SK = false; };
constexpr float THR = 8.f;

#define KSWZ(row, colB) ((row) * K_ROW + (colB))
#define SBAR() __builtin_amdgcn_sched_barrier(0)
__device__ __forceinline__ int v_st(int k, int c) { const int kk = (k & ~0xC) | ((k & 4) << 1) | ((k & 8) >> 1); return ((kk >> 3) * 4 + (c >> 5)) * 512 + ((kk & 7) * 32 + (c & 31)) * 2; }
__device__ __forceinline__ int v_rd_base(int lane) { return ((lane & 3) << 3) | (((lane >> 2) & 3) << 6) | (((lane >> 4) & 1) << 5) | (((lane >> 5) & 1) << 8); }
constexpr int v_rd_off(int d0, int ks, int half) { return d0 * 512 + ks * 4096 + half * 2048; }
__device__ __forceinline__ int crow(int r, int hi) { return (r & 3) + 8 * (r >> 2) + 4 * hi; }
typedef float f32x2_t __attribute__((ext_vector_type(2))); typedef __bf16 bf16x2_t __attribute__((ext_vector_type(2)));
__device__ __forceinline__ unsigned cvtpk(float lo, float hi) { f32x2_t v = {lo, hi}; bf16x2_t b = __builtin_convertvector(v, bf16x2_t); return __builtin_bit_cast(unsigned, b); }
__device__ __forceinline__ bf16x8 ld8(const bf16_t* p) { return *reinterpret_cast<const bf16x8*>(p); }
__device__ __forceinline__ float bf2f(unsigned short h) { return __uint_as_float(((unsigned)h) << 16); }
__device__ __forceinline__ void mask_tile(f32x16& p0, f32x16& p1, int dq, unsigned W) {
    const float NEG = -__builtin_inff();
#pragma unroll
    for (int r = 0; r < 16; ++r) {
        const int c = (r & 3) + 8 * (r >> 2);
        if ((unsigned)(dq - c) >= W) p0[r] = NEG;
        if ((unsigned)(dq - c - 32) >= W) p1[r] = NEG;
    }
}
template <int KIND, bool NOEXP = false>
__device__ __forceinline__ void partialSM(f32x16& p0, f32x16& p1, float& m_reg, float& mn, float& alpha) {
    constexpr float SCALE = Cfg<KIND>::SCALE;
    float ma = p0[0], mb = p0[8], mc = p1[0], md = p1[8];
#pragma unroll
    for (int r = 1; r < 8; ++r) { ma = fmaxf(ma, p0[r]); mb = fmaxf(mb, p0[8 + r]); mc = fmaxf(mc, p1[r]); md = fmaxf(md, p1[8 + r]); }
    float pmax = fmaxf(fmaxf(ma, mb), fmaxf(mc, md));
    constexpr float C2 = 1.4426950408889634f * SCALE;
    if (__builtin_expect(__all((pmax - m_reg) * SCALE <= THR), 1)) { mn = m_reg; alpha = 1.f; }
    else { { auto rr = __builtin_amdgcn_permlane32_swap(__float_as_uint(pmax), __float_as_uint(pmax), false, false); pmax = fmaxf(__uint_as_float(rr[0]), __uint_as_float(rr[1])); }
           mn = fmaxf(m_reg, pmax); alpha = __builtin_amdgcn_exp2f((m_reg - mn) * C2); m_reg = mn; }
    const float mnL = -mn * C2;
    for (int r = 0; r < 16; ++r) p0[r] = fmaf(p0[r], C2, mnL); for (int r = 0; r < 16; ++r) p1[r] = fmaf(p1[r], C2, mnL);
    if constexpr (!NOEXP) { for (int r = 0; r < 16; ++r) p0[r] = __builtin_amdgcn_exp2f(p0[r]); }
}
template <bool NOEXP = false>
__device__ __forceinline__ void finishSM(f32x16& p0, f32x16& p1, bf16x8& pa0, bf16x8& pa1, bf16x8& pa2, bf16x8& pa3) {
    if constexpr (!NOEXP) { for (int r = 0; r < 16; ++r) p1[r] = __builtin_amdgcn_exp2f(p1[r]); }
#define PK4(P, B_, OUT) do { unsigned a0 = cvtpk(P[B_+0], P[B_+1]), a1 = cvtpk(P[B_+2], P[B_+3]);                          \
        unsigned b0 = cvtpk(P[B_+4], P[B_+5]), b1 = cvtpk(P[B_+6], P[B_+7]);                                             \
        auto r0 = __builtin_amdgcn_permlane32_swap(a0, b0, false, false); auto r1 = __builtin_amdgcn_permlane32_swap(a1, b1, false, false); \
        u32x4 w = {r0[0], r1[0], r0[1], r1[1]}; OUT = *reinterpret_cast<bf16x8*>(&w); } while (0)
    PK4(p0, 0, pa0); PK4(p0, 8, pa1); PK4(p1, 0, pa2); PK4(p1, 8, pa3);
#undef PK4
}
template <int KIND, int KB, bool NOROPE = false>
__device__ __forceinline__ void qkt(f32x16& p0, f32x16& p1, const char* lds, int r32, int hi, const bf16x8* qr, bool act, int bofs) {
    constexpr bool SK = Cfg<KIND>::SK;
    if (SK && !act) { const float NEG = -__builtin_inff();
#pragma unroll
        for (int r = 0; r < 16; ++r) { p0[r] = NEG; p1[r] = NEG; } return; }
    if constexpr (KIND == K_FOX) { const float* bp = reinterpret_cast<const float*>(lds + OFF_BIAS) + bofs;
#pragma unroll
        for (int g = 0; g < 4; ++g) { const f32x4 a = *reinterpret_cast<const f32x4*>(bp + 8 * g), b = *reinterpret_cast<const f32x4*>(bp + 32 + 8 * g);
            p0[4 * g] = a[0]; p0[4 * g + 1] = a[1]; p0[4 * g + 2] = a[2]; p0[4 * g + 3] = a[3]; p1[4 * g] = b[0]; p1[4 * g + 1] = b[1]; p1[4 * g + 2] = b[2]; p1[4 * g + 3] = b[3]; } }
    else if constexpr (KIND == K_DIL) { const float* bp = reinterpret_cast<const float*>(lds + OFF_BIAS) + bofs;
#pragma unroll
        for (int r = 0; r < 16; ++r) { const int c = (r & 3) + 8 * (r >> 2); p0[r] = bp[c]; p1[r] = bp[c + 32]; } }
    else { p0 = f32x16{}; p1 = f32x16{}; }
    const char* kbp = lds + OFF_K + KB * SHM_K + r32 * K_ROW + hi * 16;
#pragma unroll
    for (int d0 = 0; d0 < 8; ++d0) { const char* a = kbp + d0 * 32;
        bf16x8 b0 = *reinterpret_cast<const bf16x8*>(a);
        bf16x8 b1 = *reinterpret_cast<const bf16x8*>(a + 32 * K_ROW);
        p0 = __builtin_amdgcn_mfma_f32_32x32x16_bf16(b0, qr[d0], p0, 0, 0, 0);
        p1 = __builtin_amdgcn_mfma_f32_32x32x16_bf16(b1, qr[d0], p1, 0, 0, 0); }
    if constexpr (KIND == K_MLA && !NOROPE) {
        const char* krb = lds + OFF_KR + KB * SHM_KR + r32 * KR_ROW + hi * 16;
#pragma unroll
        for (int d0 = 0; d0 < 4; ++d0) { const char* a = krb + d0 * 32;
            bf16x8 b0 = *reinterpret_cast<const bf16x8*>(a);
            bf16x8 b1 = *reinterpret_cast<const bf16x8*>(a + 32 * KR_ROW);
            const bf16x8 qf = *reinterpret_cast<const bf16x8*>(lds + OFF_BIAS + bofs + d0 * 1024);
            p0 = __builtin_amdgcn_mfma_f32_32x32x16_bf16(b0, qf, p0, 0, 0, 0);
            p1 = __builtin_amdgcn_mfma_f32_32x32x16_bf16(b1, qf, p1, 0, 0, 0); } }
#define SGB(mask, n) __builtin_amdgcn_sched_group_barrier(mask, n, 0)
    constexpr int LA = 3;
    if constexpr (KIND == K_FOX) SGB(0x100, 8);
    SGB(0x100, 2 * LA);
#pragma unroll
    for (int i = 0; i < 8 - LA; ++i) { SGB(0x008, 2); SGB(0x100, 2); }
    if constexpr (KIND == K_MLA && !NOROPE) {
#pragma unroll
        for (int i = 0; i < 4; ++i) { SGB(0x008, 2); SGB(0x100, 3); }
    }
    SGB(0x008, 2 * LA);
#undef SGB
}
template <int VB, bool SK>
__device__ __forceinline__ void pv_tile(f32x16* o, f32x16& ol, int vb0, bf16x8 pa0, bf16x8 pa1, bf16x8 pa2, bf16x8 pa3, bool act) {
    if (SK && !act) return;
#define TRRD(dst, off) asm volatile("ds_read_b64_tr_b16 %0, %1 offset:%2" : "=&v"(dst) : "v"(vb0), "i"(off) : "memory")
#define PV_D0(d0) do { s16x4 l0, l1, l2, l3, h0, h1, h2, h3; constexpr int b_ = OFF_V + VB * SHM_V + v_rd_off(d0, 0, 0);   \
        TRRD(l0, b_); TRRD(h0, b_ + 2048); TRRD(l1, b_ + 4096); TRRD(h1, b_ + 6144); TRRD(l2, b_ + 8192); TRRD(h2, b_ + 10240); TRRD(l3, b_ + 12288); TRRD(h3, b_ + 14336); \
        asm volatile("s_waitcnt lgkmcnt(0)" ::: "memory"); SBAR();   \
        o[d0] = __builtin_amdgcn_mfma_f32_32x32x16_bf16(pa0, (bf16x8){l0[0], l0[1], l0[2], l0[3], h0[0], h0[1], h0[2], h0[3]}, o[d0], 0, 0, 0);   \
        o[d0] = __builtin_amdgcn_mfma_f32_32x32x16_bf16(pa1, (bf16x8){l1[0], l1[1], l1[2], l1[3], h1[0], h1[1], h1[2], h1[3]}, o[d0], 0, 0, 0);   \
        o[d0] = __builtin_amdgcn_mfma_f32_32x32x16_bf16(pa2, (bf16x8){l2[0], l2[1], l2[2], l2[3], h2[0], h2[1], h2[2], h2[3]}, o[d0], 0, 0, 0);   \
        o[d0] = __builtin_amdgcn_mfma_f32_32x32x16_bf16(pa3, (bf16x8){l3[0], l3[1], l3[2], l3[3], h3[0], h3[1], h3[2], h3[3]}, o[d0], 0, 0, 0); } while (0)
    PV_D0(0); PV_D0(1); PV_D0(2); PV_D0(3);
    { const bf16x8 ones = (bf16x8){0x3F80, 0x3F80, 0x3F80, 0x3F80, 0x3F80, 0x3F80, 0x3F80, 0x3F80};
      ol = __builtin_amdgcn_mfma_f32_32x32x16_bf16(pa0, ones, ol, 0, 0, 0); ol = __builtin_amdgcn_mfma_f32_32x32x16_bf16(pa1, ones, ol, 0, 0, 0);
      ol = __builtin_amdgcn_mfma_f32_32x32x16_bf16(pa2, ones, ol, 0, 0, 0); ol = __builtin_amdgcn_mfma_f32_32x32x16_bf16(pa3, ones, ol, 0, 0, 0); }
#undef PV_D0
#undef TRRD
}

struct Ref { const bf16_t* Q; const bf16_t* K; const bf16_t* V; const bf16_t* Qr; const bf16_t* Kr; int qs, ks; int P0; int dir; int jlo; bf16_t* O; int os; const bf16_t* Z; int zs; float* LSE; int ls; };
template <int KIND> struct Seam { bf16x8 qr[Cfg<KIND>::NQ]; bf16x8 st_v0, st_v1, st_k0, st_k1, st_kr; };
__device__ __forceinline__ int swa_jlo(int P0, int W) { const int lowk = P0 - W + 1; return lowk > 0 ? lowk / KVBLK : 0; }
#define VMW() asm volatile("s_waitcnt vmcnt(0)" ::: "memory")
#define VMWN(n) asm volatile("s_waitcnt vmcnt(%0)" :: "i"(n) : "memory")
#define SLOAD_K(R, k0, TO, TID) do { const bf16_t* kb_ = (R).K + (size_t)(k0) * (R).ks; S.st_k0 = ld8(kb_ + (TO)); S.st_k1 = ld8(kb_ + (size_t)32 * (R).ks + (TO));   \
                            if constexpr (KIND == K_MLA) S.st_kr = ld8((R).Kr + (size_t)(k0) * 64 + (TID) * 8); } while (0)
#define SLOAD_V(R, k0, TO) do { const bf16_t* vb_ = (R).V + (size_t)(k0) * (R).ks; S.st_v0 = ld8(vb_ + (TO)); S.st_v1 = ld8(vb_ + (size_t)32 * (R).ks + (TO)); } while (0)
#define SW_OFFS() int tw_ = tid; asm volatile("" : "+v"(tw_)); const int sr_ = tw_ >> 4, sc_ = (tw_ & 15) * 8; (void)sr_; (void)sc_
#define SWRITE_HK(bf) do { SW_OFFS(); const int kws_ = KSWZ(sr_, sc_ * 2); *(bf16x8*)(K_lds + (bf) * SHM_K + kws_) = S.st_k0; *(bf16x8*)(K_lds + (bf) * SHM_K + kws_ + 32 * K_ROW) = S.st_k1;                 \
                           if constexpr (KIND == K_MLA) *(bf16x8*)(KR_lds + (bf) * SHM_KR + (tw_ >> 3) * KR_ROW + (tw_ & 7) * 16) = S.st_kr; } while (0)
#define SWRITE_HV(bf) do { SW_OFFS(); *(bf16x8*)(V_lds + (bf) * SHM_V + v_st(sr_, sc_)) = S.st_v0; *(bf16x8*)(V_lds + (bf) * SHM_V + v_st(32 + sr_, sc_)) = S.st_v1; } while (0)
#define QLOAD(R, R32, HI) do { const bf16_t* qb_ = (R).Q + (size_t)(wid * QBLK) * (R).qs; const unsigned qo_ = (unsigned)((R32) * (R).qs + (HI) * 8);                             \
                      _Pragma("unroll") for (int d0 = 0; d0 < 8; ++d0) S.qr[d0] = ld8(qb_ + qo_ + d0 * 16); } while (0)
#define QLOAD_R(R, R32, HI) do { if constexpr (KIND == K_MLA) { const bf16_t* qb_ = (R).Qr + (size_t)(wid * QBLK) * (R).qs; const unsigned qo_ = (unsigned)((R32) * (R).qs + (HI) * 8);     \
                      _Pragma("unroll") for (int d0 = 0; d0 < 4; ++d0) S.qr[8 + d0] = ld8(qb_ + qo_ + d0 * 16); } } while (0)
#define BAR() do { asm volatile("s_waitcnt lgkmcnt(0)" ::: "memory"); __builtin_amdgcn_s_barrier(); asm volatile("" ::: "memory"); } while (0)
struct Blk { int a, b, c; };
#define LAUNDER_BLK(x) asm volatile("" : "+s"((x).a), "+s"((x).b), "+s"((x).c))
template <int KIND, class MK>
__device__ __forceinline__ void attn_prime(const Blk cb, const MK& mk, int W, char* lds, Seam<KIND>& S) {
    const int tid = threadIdx.x, wid = __builtin_amdgcn_readfirstlane(tid >> 6), lane = tid & 63, r32 = lane & 31, hi = lane >> 5;
    const int sr = tid >> 4, sc = (tid & 15) * 8;
    char* K_lds = lds + OFF_K; char* KR_lds = lds + OFF_KR; (void)KR_lds;
    Ref cur; mk(cb, cur);
    const int kb0 = cur.dir ? ((cur.P0 + QB - 1) / KVBLK) * KVBLK : (KIND == K_FOX ? cur.jlo : swa_jlo(cur.P0, W)) * KVBLK, kb1 = cur.dir ? kb0 - KVBLK : kb0 + KVBLK; const unsigned toff = (unsigned)(sr * cur.ks + sc);
    QLOAD(cur, r32, hi); QLOAD_R(cur, r32, hi);
    SLOAD_K(cur, kb0, toff, tid); VMW(); SWRITE_HK(0);
    SLOAD_K(cur, kb1, toff, tid); SLOAD_V(cur, kb0, toff);
    __syncthreads();
}
template <int KIND, int VAR = 0, class MK>
__device__ __forceinline__ void attn_block(const Blk cb, const Blk nb, const MK& mk, int skv, int W, char* lds, Seam<KIND>& S) {
    constexpr bool SK = Cfg<KIND>::SK; constexpr float SCALE = Cfg<KIND>::SCALE; constexpr int NQL = Cfg<KIND>::NQ;
    constexpr bool NOGATE = (VAR & 1) != 0, NOEXP = (VAR & 4) != 0, NOROPE = (VAR & 8) != 0, NOPV = (VAR & 16) != 0, NOSM = (VAR & 32) != 0, NOSTAGE = (VAR & 128) != 0, NOQK = (VAR & 256) != 0;
    const int tid = threadIdx.x, wid = __builtin_amdgcn_readfirstlane(tid >> 6), lane = tid & 63, r32 = lane & 31, hi = lane >> 5;
    const int grp = wid >> 2;
    Ref cur; mk(cb, cur);
    const int j_lo = KIND == K_FOX ? cur.jlo : swa_jlo(cur.P0, W);
    int j_hi = (cur.P0 + QB - 1) / KVBLK + 1; if (j_hi > skv / KVBLK) j_hi = skv / KVBLK;
    const int NT = j_hi - j_lo;
    const int qlo = cur.P0 + wid * QBLK, qm = qlo + r32 - 4 * hi;
    char* V_lds = lds + OFF_V; char* K_lds = lds + OFF_K; char* KR_lds = lds + OFF_KR; (void)KR_lds;
    float* ws = (float*)(lds + OFF_WS) + wid * 64; float* li_l = ws, * al_l = ws + 32;
    float m_reg = -1e30f; f32x16 o[4] = {}; f32x16 ol = {};
    const int sr = tid >> 4, sc = (tid & 15) * 8;
    const int vb0 = (int)(uintptr_t)V_lds + v_rd_base(lane);
    const unsigned toff = (unsigned)(sr * cur.ks + sc);
    int tq_ = tid; asm volatile("" : "+v"(tq_));
    const int qrofs = wid * 4096 + (tq_ & 63) * 16;
#define RESC(a) do { if (__any((a) < 1.f)) { if (hi == 0) al_l[r32] = (a); asm volatile("s_waitcnt lgkmcnt(0)" ::: "memory");              \
                     for (int r = 0; r < 16; ++r) { const float a_ = al_l[crow(r, hi)]; ol[r] *= a_; for (int d_ = 0; d_ < 4; ++d_) o[d_][r] *= a_; } } } while (0)
#define KBASE(t) ((cur.dir ? j_hi - 1 - (t) : j_lo + (t)) * KVBLK)
#define ACT(t) (KBASE(t) <= qlo + QBLK - 1 && KBASE(t) + KVBLK - 1 >= qlo - W + 1)
#define BOFS(t) (KIND == K_FOX ? KBASE(t) + 4 * hi : (KIND == K_DIL ? TBL_TOP - (qm - KBASE(t)) : qrofs))
#define MASKT(P0_, P1_, t) do { if constexpr (KIND != K_DIL) { const int kb_ = KBASE(t); if ((!SK || ACT(t)) && (kb_ + KVBLK - 1 > qlo || kb_ <= qlo + QBLK - 1 - W)) mask_tile(P0_, P1_, qm - kb_, (unsigned)W); } } while (0)
    f32x16 p0 = {}, p1 = {}; float mn, al; bf16x8 pa0 = {}, pa1 = {}, pa2 = {}, pa3 = {};
#define SLOT(i) do { if constexpr (NOSTAGE) break; VMW(); { SW_OFFS(); const int vst_ = v_st(sr_, sc_), kws_ = (tw_ + (tw_ >> 4)) << 4  ;     \
                     if ((i) < NT) { *(bf16x8*)(V_lds + ((i) & 1) * SHM_V + vst_) = S.st_v0; *(bf16x8*)(V_lds + ((i) & 1) * SHM_V + vst_ + 8192) = S.st_v1; }                       \
                     if ((i) + 1 < NT) { *(bf16x8*)(K_lds + (((i) + 1) & 1) * SHM_K + kws_) = S.st_k0; *(bf16x8*)(K_lds + (((i) + 1) & 1) * SHM_K + kws_ + 32 * K_ROW) = S.st_k1;          \
                         if constexpr (KIND == K_MLA) *(bf16x8*)(KR_lds + (((i) + 1) & 1) * SHM_KR + (tw_ >> 3) * KR_ROW + (tw_ & 7) * 16) = S.st_kr; } } SBAR();                       \
                     if ((i) + 1 < NT) SLOAD_V(cur, KBASE((i) + 1), toff); if ((i) + 2 < NT) SLOAD_K(cur, KBASE((i) + 2), toff, tid); SBAR(); } while (0)
#define SMSEG(t) do { if constexpr (NOSM) break; SBAR(); if (!SK || ACT(t)) { MASKT(p0, p1, (t)); partialSM<KIND, NOEXP>(p0, p1, m_reg, mn, al); SBAR(); finishSM<NOEXP>(p0, p1, pa0, pa1, pa2, pa3); SBAR(); RESC(al); } SBAR(); } while (0)
#define MSEG(t, KB, VB) do { SBAR(); if constexpr (!NOPV) { if ((t) > 0) pv_tile<VB, SK>(o, ol, vb0, pa0, pa1, pa2, pa3, ACT((t) - 1)); } SBAR();         \
                             if constexpr (!NOQK) qkt<KIND, KB, NOROPE>(p0, p1, lds, r32, hi, S.qr, ACT(t), BOFS(t)); SBAR(); } while (0)
#define STEP(t, KB, VB) do { MSEG(t, KB, VB); BAR(); SLOT((t) + grp); SMSEG(t); BAR(); } while (0)
    if constexpr (KIND == K_MLA) {
#pragma unroll
        for (int d0 = 0; d0 < 4; ++d0) *(bf16x8*)(lds + OFF_BIAS + qrofs + d0 * 1024) = S.qr[8 + d0]; }
    if (grp) { SLOT(0); BAR(); }
    int t = 0;
    for (; t + 1 < NT; t += 2) { STEP(t, 0, 1); STEP(t + 1, 1, 0); }
    if (t < NT) { STEP(t, 0, 1); }
    int tid_t = tid; asm volatile("" : "+v"(tid_t));
    Blk nb2 = nb; LAUNDER_BLK(nb2); Ref nxt; mk(nb2, nxt);
    const int kbn0 = nxt.dir ? ((nxt.P0 + QB - 1) / KVBLK) * KVBLK : (KIND == K_FOX ? nxt.jlo : swa_jlo(nxt.P0, W)) * KVBLK, kbn1 = nxt.dir ? kbn0 - KVBLK : kbn0 + KVBLK;
    const int r32t = tid_t & 31, hit = (tid_t >> 5) & 1; const unsigned toffn = (unsigned)((tid_t >> 4) * nxt.ks + (tid_t & 15) * 8);
    if constexpr (!NOPV) { if (((NT - 1) & 1) != 0) pv_tile<1, SK>(o, ol, vb0, pa0, pa1, pa2, pa3, ACT(NT - 1)); else pv_tile<0, SK>(o, ol, vb0, pa0, pa1, pa2, pa3, ACT(NT - 1)); }
    SBAR(); SLOAD_K(nxt, kbn0, toffn, tid_t); SBAR(); QLOAD(nxt, r32t, hit); QLOAD_R(nxt, r32t, hit); SBAR();
    BAR();
    VMWN(NQL); SWRITE_HK(0); SBAR(); SLOAD_K(nxt, kbn1, toffn, tid_t); SLOAD_V(nxt, kbn0, toffn); SBAR();
    BAR();
    if (grp == 0) BAR();
    Blk cb2 = cb; LAUNDER_BLK(cb2); Ref ce; mk(cb2, ce);
    if constexpr (KIND == K_DIL) {
        if (r32t == 0) {
#pragma unroll
            for (int r = 0; r < 16; ++r) li_l[crow(r, hit)] = ol[r]; }
        asm volatile("s_waitcnt lgkmcnt(0)" ::: "memory");
        if (hit == 0) ce.LSE[(size_t)(wid * QBLK + r32t) * ce.ls] = m_reg * SCALE + logf(li_l[r32t]); }
    float rli[16];
#pragma unroll
    for (int r = 0; r < 16; ++r) rli[r] = __builtin_amdgcn_rcpf(ol[r]);
    char* stg = lds + OFF_V + wid * 4096;
    const int srow = (tid_t >> 3) & 7, sch = tid_t & 7;
    bf16_t* Ow = ce.O + (size_t)(wid * QBLK) * ce.os; const unsigned ooff = (unsigned)(srow * ce.os + sch * 4);
    const bf16_t* Zw = ce.Z + (size_t)(wid * QBLK) * ce.zs; const unsigned zoff = (unsigned)(srow * ce.zs + sch * 4); (void)Zw; (void)zoff;
#pragma unroll
    for (int d0 = 0; d0 < 4; ++d0) {
#pragma unroll
        for (int r = 0; r < 16; ++r) *(float*)(stg + crow(r, hit) * 128 + r32t * 4) = o[d0][r] * rli[r];
        asm volatile("s_waitcnt lgkmcnt(0)" ::: "memory");
#pragma unroll
        for (int i = 0; i < 4; ++i) { f32x4 v = *(const f32x4*)(stg + (srow + 8 * i) * 128 + sch * 16);
            if constexpr (KIND != K_DIL && !NOGATE) { const uint2 zz = *(const uint2*)(Zw + (size_t)(8 * i) * ce.zs + zoff + d0 * 32);
                const float z0 = __uint_as_float(zz.x << 16), z1 = __uint_as_float(zz.x & 0xffff0000u), z2 = __uint_as_float(zz.y << 16), z3 = __uint_as_float(zz.y & 0xffff0000u);
                v[0] = v[0] * z0 / (1.f + __expf(-z0)); v[1] = v[1] * z1 / (1.f + __expf(-z1)); v[2] = v[2] * z2 / (1.f + __expf(-z2)); v[3] = v[3] * z3 / (1.f + __expf(-z3)); }
            uint2 w; w.x = cvtpk(v[0], v[1]); w.y = cvtpk(v[2], v[3]);
            *(uint2*)(Ow + (size_t)(8 * i) * ce.os + ooff + d0 * 32) = w; }
        asm volatile("s_waitcnt lgkmcnt(0)" ::: "memory");
    }
    BAR();
#undef RESC
#undef KBASE
#undef ACT
#undef BOFS
#undef MASKT
#undef SLOT
#undef SMSEG
#undef MSEG
#undef STEP
}
#undef VMW
#undef VMWN
#undef SLOAD_K
#undef SLOAD_V
#undef SWRITE_HK
#undef SWRITE_HV
#undef QLOAD
#undef QLOAD_R
#undef KSWZ
}

namespace t32 {
using at::bf16_t; using at::bf16x8; using at::s16x4; using at::f32x4; using at::f32x16; using at::u32x4; using at::Ref; using at::Blk; using at::cvtpk; using at::ld8;
constexpr int NW = 8, QBLK = 32, KVBLK = 64, QB = NW * QBLK;
constexpr int SHM_V = 16384, K_ROW = 272, SHM_K = KVBLK * K_ROW, KR_ROW = 144, SHM_KR = KVBLK * KR_ROW;
constexpr int OFF_V = 0, OFF_K = 2 * SHM_V, OFF_KR = OFF_K + 2 * SHM_K, OFF_QR = OFF_KR + 2 * SHM_KR, LDS_BYTES = OFF_QR + NW * 4096;
static_assert(K_ROW == 272 && KR_ROW == 144, "KWS / KRWS");
constexpr float QMUL = 1.4426950408889634f * 0.07216878364870322f, THR2 = 8.f * 1.4426950408889634f;
struct Seam { bf16x8 qr[12]; bf16x8 st_v0, st_v1, st_k0, st_k1, st_kr; };
#define SBAR() __builtin_amdgcn_sched_barrier(0)
#define SGB(mask, n) __builtin_amdgcn_sched_group_barrier(mask, n, 0)
#define MF32(a, b, c) __builtin_amdgcn_mfma_f32_32x32x16_bf16(a, b, c, 0, 0, 0)
#define VMW() asm volatile("s_waitcnt vmcnt(0)" ::: "memory")
#define VMWN(n) asm volatile("s_waitcnt vmcnt(%0)" :: "i"(n) : "memory")
#define BAR() do { asm volatile("s_waitcnt lgkmcnt(0)" ::: "memory"); __builtin_amdgcn_s_barrier(); asm volatile("" ::: "memory"); } while (0)
#define LAUNDER_BLK(x) asm volatile("" : "+s"((x).a), "+s"((x).b), "+s"((x).c))
#define KWS(tw_) (((tw_) + ((tw_) >> 4)) << 4)
#define KRWS(tw_) (((tw_) + ((tw_) >> 3)) << 4)
#define VROW(tw_) (4 * ((tw_) >> 6) + (((tw_) >> 2) & 3))
#define VCH(tw_) (4 * (((tw_) >> 4) & 3) + ((tw_) & 3))
#define VWS(tw_) ((tw_) << 4)
#define SLOAD_K(R, k0, TOK, TID) do { const bf16_t* kb_ = (R).K + (size_t)(k0) * (R).ks; S.st_k0 = ld8(kb_ + (TOK)); S.st_k1 = ld8(kb_ + (size_t)32 * (R).ks + (TOK)); S.st_kr = ld8((R).Kr + (size_t)(k0) * 64 + (TID) * 8); } while (0)
#define SLOAD_V(R, k0, TOV) do { const bf16_t* vb_ = (R).V + (size_t)(k0) * (R).ks; S.st_v0 = ld8(vb_ + (TOV)); S.st_v1 = ld8(vb_ + (size_t)32 * (R).ks + (TOV)); } while (0)
#define SWRITE_HK(bf, tw_) do { const int kws_ = KWS(tw_); *(bf16x8*)(K_lds + (bf) * SHM_K + kws_) = S.st_k0; *(bf16x8*)(K_lds + (bf) * SHM_K + kws_ + 32 * K_ROW) = S.st_k1;   \
                                *(bf16x8*)(KR_lds + (bf) * SHM_KR + KRWS(tw_)) = S.st_kr; } while (0)
#define QLOAD(R, R32, HI) do { const bf16_t* qb_ = (R).Q + (size_t)(wid * QBLK) * (R).qs; const bf16_t* qrb_ = (R).Qr + (size_t)(wid * QBLK) * (R).qs; const unsigned qo_ = (unsigned)((R32) * (R).qs + (HI) * 8);   \
                      _Pragma("unroll") for (int d_ = 0; d_ < 8; ++d_) S.qr[d_] = ld8(qb_ + qo_ + d_ * 16);                                                                                              \
                      _Pragma("unroll") for (int d_ = 0; d_ < 4; ++d_) S.qr[8 + d_] = ld8(qrb_ + qo_ + d_ * 16); } while (0)

template <class MK>
__device__ __forceinline__ void attn_prime(const Blk cb, const MK& mk, char* lds, Seam& S) {
    const int tid = threadIdx.x, wid = __builtin_amdgcn_readfirstlane(tid >> 6), lane = tid & 63;
    char* K_lds = lds + OFF_K; char* KR_lds = lds + OFF_KR;
    Ref cur; mk(cb, cur);
    const int kb0 = cur.dir ? ((cur.P0 + QB - 1) / KVBLK) * KVBLK : 0, kb1 = cur.dir ? kb0 - KVBLK : kb0 + KVBLK;
    const unsigned tok = (unsigned)((tid >> 4) * cur.ks + (tid & 15) * 8), tov = (unsigned)(VROW(tid) * cur.ks + VCH(tid) * 8);
    QLOAD(cur, lane & 31, lane >> 5);
    SLOAD_K(cur, kb0, tok, tid); VMW(); SWRITE_HK(0, tid);
    SLOAD_K(cur, kb1, tok, tid); SLOAD_V(cur, kb0, tov);
    __syncthreads();
}

template <int KB>
__device__ __forceinline__ void qkt(f32x16& p0, f32x16& p1, const f32x16& ci, const char* lds, int r32, int hi, int qrofs, const bf16x8* qr) {
    const char* kbp = lds + OFF_K + KB * SHM_K + r32 * K_ROW + hi * 16;
#pragma unroll
    for (int d0 = 0; d0 < 8; ++d0) { const char* a = kbp + d0 * 32;
        const bf16x8 b0 = *reinterpret_cast<const bf16x8*>(a), b1 = *reinterpret_cast<const bf16x8*>(a + 32 * K_ROW);
        p0 = MF32(b0, qr[d0], d0 == 0 ? ci : p0); p1 = MF32(b1, qr[d0], d0 == 0 ? ci : p1); }
    const char* krb = lds + OFF_KR + KB * SHM_KR + r32 * KR_ROW + hi * 16;
#pragma unroll
    for (int d0 = 0; d0 < 4; ++d0) { const char* a = krb + d0 * 32;
        const bf16x8 b0 = *reinterpret_cast<const bf16x8*>(a), b1 = *reinterpret_cast<const bf16x8*>(a + 32 * KR_ROW);
        const bf16x8 qf = *reinterpret_cast<const bf16x8*>(lds + OFF_QR + qrofs + d0 * 1024);
        p0 = MF32(b0, qf, p0); p1 = MF32(b1, qf, p1); }
    constexpr int LA = 3;
    SGB(0x100, 2 * LA);
#pragma unroll
    for (int i = 0; i < 8 - LA; ++i) { SGB(0x008, 2); SGB(0x100, 2); }
#pragma unroll
    for (int i = 0; i < 4; ++i) { SGB(0x008, 2); SGB(0x100, 3); }
    SGB(0x008, 2 * LA);
}
template <int VB>
__device__ __forceinline__ void pv_tile(f32x16 (&o)[4], f32x16& ol, int vb0, const bf16x8 (&pa)[4]) {
#define TRRD(dst, off) asm volatile("ds_read_b64_tr_b16 %0, %1 offset:%2" : "=&v"(dst) : "v"(vb0), "i"(off) : "memory")
#define PV_K(ks) do { s16x4 l0, h0, l1, h1, l2, h2, l3, h3; constexpr int b_ = OFF_V + VB * SHM_V + (ks) * 4096;                                                      \
        TRRD(l0, b_); TRRD(h0, b_ + 2048); TRRD(l1, b_ + 256); TRRD(h1, b_ + 256 + 2048); TRRD(l2, b_ + 512); TRRD(h2, b_ + 512 + 2048); TRRD(l3, b_ + 768); TRRD(h3, b_ + 768 + 2048);   \
        asm volatile("s_waitcnt lgkmcnt(0)" ::: "memory"); SBAR();                                                                                                 \
        o[0] = MF32(((bf16x8){l0[0], l0[1], l0[2], l0[3], h0[0], h0[1], h0[2], h0[3]}), pa[ks], o[0]);                                                             \
        o[1] = MF32(((bf16x8){l1[0], l1[1], l1[2], l1[3], h1[0], h1[1], h1[2], h1[3]}), pa[ks], o[1]);                                                             \
        o[2] = MF32(((bf16x8){l2[0], l2[1], l2[2], l2[3], h2[0], h2[1], h2[2], h2[3]}), pa[ks], o[2]);                                                             \
        o[3] = MF32(((bf16x8){l3[0], l3[1], l3[2], l3[3], h3[0], h3[1], h3[2], h3[3]}), pa[ks], o[3]); } while (0)
    PV_K(0); PV_K(1); PV_K(2); PV_K(3);
    { const bf16x8 ones = (bf16x8){0x3F80, 0x3F80, 0x3F80, 0x3F80, 0x3F80, 0x3F80, 0x3F80, 0x3F80};
      ol = MF32(ones, pa[0], ol); ol = MF32(ones, pa[1], ol); ol = MF32(ones, pa[2], ol); ol = MF32(ones, pa[3], ol); }
#undef PV_K
#undef TRRD
}

template <class MK>
__device__ __forceinline__ void attn_block(const Blk cb, const Blk nb, const MK& mk, int skv, char* lds, Seam& S) {
    const int W = 1 << 30;
    const int tid = threadIdx.x, wid = __builtin_amdgcn_readfirstlane(tid >> 6), lane = tid & 63, r32 = lane & 31, hi = lane >> 5;
    const int grp = wid >> 2;
    Ref cur; mk(cb, cur);
    const int j_lo = 0;
    int j_hi = (cur.P0 + QB - 1) / KVBLK + 1; if (j_hi > skv / KVBLK) j_hi = skv / KVBLK;
    const int NT = j_hi - j_lo;
    const int qlo = cur.P0 + wid * QBLK, qm = qlo + r32 - 4 * hi;
    char* V_lds = lds + OFF_V; char* K_lds = lds + OFF_K; char* KR_lds = lds + OFF_KR;
    float m = -1e30f; f32x16 o[4] = {}; f32x16 ol = {};
    f32x16 ci = {}; bool inited = false;
    const int vb0 = (int)(uintptr_t)V_lds + hi * 1024 + ((lane >> 2) & 3) * 64 + ((lane >> 4) & 1) * 32 + (lane & 3) * 8;
    const unsigned tok = (unsigned)((tid >> 4) * cur.ks + (tid & 15) * 8), tov = (unsigned)(VROW(tid) * cur.ks + VCH(tid) * 8);
    int tq_ = tid; asm volatile("" : "+v"(tq_));
    const int qrofs = wid * 4096 + (tq_ & 63) * 16;
#define KBASE(t) ((cur.dir ? j_hi - 1 - (t) : j_lo + (t)) * KVBLK)
    f32x16 p0 = {}, p1 = {}; bf16x8 pa[4] = {};
#define SLOT(i) do { VMW(); { int tw_ = tid; asm volatile("" : "+v"(tw_)); const int vst_ = VWS(tw_);                                                              \
                     if ((i) < NT) { *(bf16x8*)(V_lds + ((i) & 1) * SHM_V + vst_) = S.st_v0; *(bf16x8*)(V_lds + ((i) & 1) * SHM_V + vst_ + 8192) = S.st_v1; }       \
                     if ((i) + 1 < NT) { SWRITE_HK(((i) + 1) & 1, tw_); } } SBAR();                                                                                \
                     if ((i) + 1 < NT) SLOAD_V(cur, KBASE((i) + 1), tov); if ((i) + 2 < NT) SLOAD_K(cur, KBASE((i) + 2), tok, tid); SBAR(); } while (0)
#define SMSEG(t) do { SBAR(); { const int kb_ = KBASE(t); if (kb_ + KVBLK - 1 > qlo || kb_ <= qlo + QBLK - 1 - W) at::mask_tile(p0, p1, qm - kb_, (unsigned)W); }                \
        float ma = p0[0], mb = p0[8], mc = p1[0], md = p1[8];                                                                                                      \
        _Pragma("unroll") for (int r = 1; r < 8; ++r) { ma = fmaxf(ma, p0[r]); mb = fmaxf(mb, p0[8 + r]); mc = fmaxf(mc, p1[r]); md = fmaxf(md, p1[8 + r]); }        \
        float pm = fmaxf(fmaxf(ma, mb), fmaxf(mc, md));                                                                                                            \
        if (!__builtin_expect(inited && __all(pm <= THR2), 1)) {                         \
            pm = fmaxf(pm, __shfl_xor(pm, 32));                                                                                                                    \
            const float u = -ci[0];                                                          \
            const float n = fmaxf(m, pm + u), al = __builtin_amdgcn_exp2f(m - n), sb = n - u;                                                                      \
            _Pragma("unroll") for (int r = 0; r < 16; ++r) { p0[r] -= sb; p1[r] -= sb; ol[r] *= al; o[0][r] *= al; o[1][r] *= al; o[2][r] *= al; o[3][r] *= al; }    \
            m = n; const float c_ = n > -1e29f ? -n : 0.f; _Pragma("unroll") for (int r = 0; r < 16; ++r) ci[r] = c_;                                              \
            inited = __all(n > -1e29f) != 0; }                                                                                                                     \
        _Pragma("unroll") for (int r = 0; r < 16; ++r) { p0[r] = __builtin_amdgcn_exp2f(p0[r]); p1[r] = __builtin_amdgcn_exp2f(p1[r]); }                            \
        { u32x4 w0_ = {cvtpk(p0[0], p0[1]), cvtpk(p0[2], p0[3]), cvtpk(p0[4], p0[5]), cvtpk(p0[6], p0[7])}, w1_ = {cvtpk(p0[8], p0[9]), cvtpk(p0[10], p0[11]), cvtpk(p0[12], p0[13]), cvtpk(p0[14], p0[15])};   \
          u32x4 w2_ = {cvtpk(p1[0], p1[1]), cvtpk(p1[2], p1[3]), cvtpk(p1[4], p1[5]), cvtpk(p1[6], p1[7])}, w3_ = {cvtpk(p1[8], p1[9]), cvtpk(p1[10], p1[11]), cvtpk(p1[12], p1[13]), cvtpk(p1[14], p1[15])};   \
          pa[0] = *reinterpret_cast<bf16x8*>(&w0_); pa[1] = *reinterpret_cast<bf16x8*>(&w1_); pa[2] = *reinterpret_cast<bf16x8*>(&w2_); pa[3] = *reinterpret_cast<bf16x8*>(&w3_); }   \
        SBAR(); } while (0)
#define MSEG(t, KB, VB) do { SBAR(); if ((t) > 0) pv_tile<VB>(o, ol, vb0, pa); SBAR(); qkt<KB>(p0, p1, ci, lds, r32, hi, qrofs, S.qr); SBAR(); } while (0)
#define STEP(t, KB, VB) do { MSEG(t, KB, VB); BAR(); SLOT((t) + grp); SMSEG(t); BAR(); } while (0)
#pragma unroll
    for (int f = 0; f < 4; ++f) *(bf16x8*)(lds + OFF_QR + qrofs + f * 1024) = S.qr[8 + f];
    if (grp) { SLOT(0); BAR(); }
    int t = 0;
    for (; t + 1 < NT; t += 2) { STEP(t, 0, 1); STEP(t + 1, 1, 0); }
    if (t < NT) { STEP(t, 0, 1); }
    int tid_t = tid; asm volatile("" : "+v"(tid_t));
    Blk nb2 = nb; LAUNDER_BLK(nb2); Ref nxt; mk(nb2, nxt);
    const int kbn0 = nxt.dir ? ((nxt.P0 + QB - 1) / KVBLK) * KVBLK : 0, kbn1 = nxt.dir ? kbn0 - KVBLK : kbn0 + KVBLK;
    const unsigned tokn = (unsigned)((tid_t >> 4) * nxt.ks + (tid_t & 15) * 8), tovn = (unsigned)(VROW(tid_t) * nxt.ks + VCH(tid_t) * 8);
    if (((NT - 1) & 1) != 0) pv_tile<1>(o, ol, vb0, pa); else pv_tile<0>(o, ol, vb0, pa);
    SBAR(); SLOAD_K(nxt, kbn0, tokn, tid_t); SBAR(); QLOAD(nxt, tid_t & 31, (tid_t >> 5) & 1); SBAR();
    BAR();
    VMWN(12); SWRITE_HK(0, tid_t); SBAR(); SLOAD_K(nxt, kbn1, tokn, tid_t); SLOAD_V(nxt, kbn0, tovn); SBAR();
    BAR();
    if (grp == 0) BAR();
    Blk cb2 = cb; LAUNDER_BLK(cb2); Ref ce; mk(cb2, ce);
    const int qt_ = tid_t & 31, ht_ = (tid_t >> 5) & 1;
    bf16_t* Ow = ce.O + (size_t)(wid * QBLK) * ce.os; const bf16_t* Zw = ce.Z + (size_t)(wid * QBLK) * ce.zs;
    const float rl = __builtin_amdgcn_rcpf(ol[0]);
    const unsigned ooff = (unsigned)(qt_ * ce.os + 4 * ht_), zoff = (unsigned)(qt_ * ce.zs + 4 * ht_);
#pragma unroll
    for (int c = 0; c < 4; ++c) {
        uint2 zz[4];
#pragma unroll
        for (int rr = 0; rr < 4; ++rr) zz[rr] = *(const uint2*)(Zw + zoff + 32 * c + 8 * rr);
#pragma unroll
        for (int rr = 0; rr < 4; ++rr) {
            const float z0 = __uint_as_float(zz[rr].x << 16), z1 = __uint_as_float(zz[rr].x & 0xffff0000u), z2 = __uint_as_float(zz[rr].y << 16), z3 = __uint_as_float(zz[rr].y & 0xffff0000u);
            const float v0 = o[c][4 * rr] * rl, v1 = o[c][4 * rr + 1] * rl, v2 = o[c][4 * rr + 2] * rl, v3 = o[c][4 * rr + 3] * rl;
            uint2 w; w.x = cvtpk(v0 * z0 / (1.f + __expf(-z0)), v1 * z1 / (1.f + __expf(-z1))); w.y = cvtpk(v2 * z2 / (1.f + __expf(-z2)), v3 * z3 / (1.f + __expf(-z3)));
            *(uint2*)(Ow + ooff + 32 * c + 8 * rr) = w; }
    }
    BAR();
#undef KBASE
#undef SLOT
#undef SMSEG
#undef MSEG
#undef STEP
}
#undef SBAR
#undef SGB
#undef MF32
#undef VMW
#undef VMWN
#undef BAR
#undef LAUNDER_BLK
#undef KWS
#undef KRWS
#undef VROW
#undef VCH
#undef VWS
#undef SLOAD_K
#undef SLOAD_V
#undef SWRITE_HK
#undef QLOAD
}

#define GAS __attribute__((address_space(1)))
#define LAS __attribute__((address_space(3)))
typedef unsigned short bf16;
typedef unsigned v4u __attribute__((ext_vector_type(4)));
typedef float f32x4 __attribute__((ext_vector_type(4)));
typedef short bf16x8 __attribute__((ext_vector_type(8)));
typedef GAS unsigned gu32;
typedef GAS unsigned long long gu64;
#define RLX_AGENT __ATOMIC_RELAXED, __HIP_MEMORY_SCOPE_AGENT
#define LDS_WAIT() asm volatile("s_waitcnt lgkmcnt(0)" ::: "memory")
#define VM_WAIT() asm volatile("s_waitcnt vmcnt(0)" ::: "memory")
__device__ __forceinline__ unsigned long long rt() { return __builtin_amdgcn_s_memrealtime(); }
__device__ __forceinline__ unsigned f2bf(float f) { unsigned u = __builtin_bit_cast(unsigned, f); return (u + 0x7fffu + ((u >> 16) & 1u)) >> 16; }
__device__ __forceinline__ unsigned pk2(float lo, float hi) { return f2bf(lo) | (f2bf(hi) << 16); }

#define XB_TMO      128
#define XB_XCNT(j)  (256  + 64 * (j))
#define XB_XSUB(j)  (1280 + 64 * (j))
#define XB_XGEN(j)  (2304 + 64 * (j))
#define XB_TOP      3328
#define XB_TOPGEN   3392
#define XCD_BAR_WORDS 3456
#define XB_SPIN_CAP (1u << 18)

__device__ __forceinline__ unsigned xb_ld(unsigned* p)              { return __hip_atomic_load(p, __ATOMIC_RELAXED, __HIP_MEMORY_SCOPE_AGENT); }
__device__ __forceinline__ unsigned xb_add(unsigned* p, unsigned v) { return __hip_atomic_fetch_add(p, v, __ATOMIC_RELAXED, __HIP_MEMORY_SCOPE_AGENT); }
__device__ __forceinline__ unsigned xb_xcc_id() { return (unsigned)__builtin_amdgcn_s_getreg((3 << 11) | 20) & 0xFu; }
#define XB_SPIN(cond, bar) do { unsigned _sp = 0; while (cond) { __builtin_amdgcn_s_sleep(1); \
    if ((++_sp & 255u) == 0u) { if (xb_ld(&(bar)[XB_TMO])) break; if (_sp > XB_SPIN_CAP) { atomicAdd(&(bar)[XB_TMO], 1u); break; } } } } while (0)

struct XcdBarrier {
    unsigned* bar; unsigned x;
    volatile LAS unsigned* st;
};

__device__ __forceinline__ XcdBarrier xcd_barrier_post(unsigned* bar, volatile LAS unsigned* st) {
    XcdBarrier b; b.bar = bar; b.x = xb_xcc_id(); b.st = st;
    if (threadIdx.x == 0) (void)xb_add(&bar[XB_XCNT(b.x)], 1u);
    return b;
}
__device__ __forceinline__ void xcd_barrier_complete(unsigned* bar, unsigned x, unsigned& nloc, unsigned& nx) {
    const unsigned G = gridDim.x * gridDim.y * gridDim.z;
    unsigned sum, cnt, mine, sp = 0u;
    for (;;) {
        sum = 0u; cnt = 0u; mine = 0u;
#pragma unroll
        for (unsigned j = 0; j < 16; ++j) { const unsigned c = xb_ld(&bar[XB_XCNT(j)]); sum += c; cnt += (c > 0u) ? 1u : 0u; mine = (j == x) ? c : mine; }
        if (sum == G) break;
        __builtin_amdgcn_s_sleep(1);
        if ((++sp & 255u) == 0u) { if (xb_ld(&bar[XB_TMO])) break; if (sp > XB_SPIN_CAP) { atomicAdd(&bar[XB_TMO], 1u); break; } }
    }
    nloc = mine > 0u ? mine : 1u; nx = cnt > 0u ? cnt : 1u;
}

__device__ __forceinline__ void xcd_barrier(const XcdBarrier& b) {
    asm volatile("s_waitcnt vmcnt(0)" ::: "memory");
    __syncthreads();
    if (threadIdx.x == 0) {
        unsigned* bar = b.bar;
        __builtin_amdgcn_s_waitcnt(0);
        unsigned nloc = b.st[0], nx = b.st[1];
        if (nloc == 0u) { xcd_barrier_complete(bar, b.x, nloc, nx); b.st[0] = nloc; b.st[1] = nx; }
        const unsigned old = xb_add(&bar[XB_XSUB(b.x)], 1u);
        const unsigned gen = old / nloc;
        if (old + 1u == (gen + 1u) * nloc) {
            __builtin_amdgcn_fence(__ATOMIC_RELEASE, "agent");
            asm volatile("s_waitcnt vmcnt(0)" ::: "memory");
            const unsigned og = xb_add(&bar[XB_TOP], 1u);
            const unsigned tg = og / nx;
            if (og + 1u == (tg + 1u) * nx) xb_add(&bar[XB_TOPGEN], 1u);
            else XB_SPIN(xb_ld(&bar[XB_TOPGEN]) == tg, bar);
            __builtin_amdgcn_fence(__ATOMIC_ACQUIRE, "agent");
            xb_add(&bar[XB_XGEN(b.x)], 1u);
            asm volatile("s_waitcnt vmcnt(0)" ::: "memory");
        } else {
            XB_SPIN(xb_ld(&bar[XB_XGEN(b.x)]) == gen, bar);
            __builtin_amdgcn_fence(__ATOMIC_ACQUIRE, "agent");
            asm volatile("s_waitcnt vmcnt(0)" ::: "memory");
        }
    }
    __syncthreads();
}

constexpr int BATCH = 2, SEQ = 8192, DM = 4096, M = BATCH * SEQ, HD = 128;
constexpr int NHA = 16, NHB = 16, NHC = 32;
constexpr int IN_EVEN = 16400, IN_ODD = 5696, Q_LORA = 1024, KV_LORA = 512, QK_ROPE = 64;
constexpr int N0 = 16384;
constexpr int C_QA = 0, C_KA = 2048, C_VA = 4096, C_QB = 6144, C_KB = 8192, C_VB = 10240, C_Z0 = 12288;
constexpr int N1 = 5888;
constexpr int C1_Z = 0, C1_CQ = 4096, C1_CKV = 5120, C1_KR = 5632;
constexpr int NQ = 6144;
constexpr int NKV = 8192;
constexpr float EPS = 1e-6f;
constexpr int NWAVES = 8;
#ifndef MK_PER_PHASE
#define MK_PER_PHASE 0
#endif
constexpr int N_PHASES = 13;

constexpr size_t MiB = 1u << 20;
constexpr size_t WS_CTL = 0, CTL_ZERO_BYTES = 1 * MiB;
constexpr size_t WS_MOD = 1 * MiB;
constexpr size_t WS_FLOGIT = 2 * MiB;
constexpr size_t WS_CS = 4 * MiB;
constexpr size_t WS_LSE = 8 * MiB;
constexpr size_t WS_WFT = 12 * MiB;
constexpr size_t WS_BT0 = 16 * MiB;
constexpr size_t WS_WO0 = 144 * MiB;
constexpr size_t WS_BT1 = 176 * MiB;
constexpr size_t WS_WQB = 222 * MiB;
constexpr size_t WS_WKVB = 234 * MiB;
constexpr size_t WS_WO1 = 242 * MiB;
constexpr size_t WS_XN = 274 * MiB;
constexpr size_t WS_PROJ0 = 402 * MiB;
constexpr size_t WS_OP = 914 * MiB;
constexpr size_t WS_G = 1106 * MiB;
constexpr size_t WS_END = 1234 * MiB;
constexpr size_t WS_Y1 = 16 * MiB, WS_Y2 = 828 * MiB;
constexpr size_t WS_PROJ1 = 402 * MiB;
constexpr size_t WS_CQN = 586 * MiB;
constexpr size_t WS_CKVN = 618 * MiB;
constexpr size_t WS_KROPE = 634 * MiB;
constexpr size_t WS_QBUF = 636 * MiB;
constexpr size_t WS_KVBUF = 828 * MiB;
static_assert(WS_KVBUF + (size_t)M * NKV * 2 <= WS_G && WS_PROJ1 + (size_t)M * N1 * 2 <= WS_CQN && WS_QBUF + (size_t)M * NQ * 2 <= WS_KVBUF, "d_ws map");
constexpr int CW_BAR = 4096;
constexpr int CW_QUEUE = 64;
constexpr size_t WS_NRMQ = 256 * 1024, WS_NRMK = 320 * 1024;

constexpr int RING_OFF = 0, RING_BYTES = 131072;
constexpr int LDSCTL_OFF = RING_BYTES, MISC_OFF = LDSCTL_OFF + 320;
constexpr int LDS_BYTES = 147456;
static_assert(MISC_OFF + 128 <= LDS_BYTES && at::LDS_BYTES <= RING_BYTES && t32::LDS_BYTES <= RING_BYTES && pg8::STAGE_BYTES <= RING_BYTES, "LDS map");

struct Args { const void* in[17]; float* out; unsigned char* ws; int ph_lo, ph_hi; };

struct Ctx {
    LAS unsigned char* lds; int tid, lane, wave, vcu, G;
    const __attribute__((address_space(4))) Args* A;
    float* out; unsigned char* ws;
};
__device__ __forceinline__ const __attribute__((address_space(4))) Args* late(const __attribute__((address_space(4))) Args* a) { asm volatile("" : "+s"(a)); return a; }
#define IN_X(F)        ((const float*)late((F).A)->in[0])
#define IN_C(F)        ((const float*)late((F).A)->in[1])
#define IN_POS(F)      ((const int*)late((F).A)->in[2])
#define IN_GNORM(F)    ((const float*)late((F).A)->in[3])
#define IN_WADA(F)     ((const float*)late((F).A)->in[4])
#define IN_BADA(F)     ((const float*)late((F).A)->in[5])
#define IN_RELB(F)     ((const float*)late((F).A)->in[6])
#define IN_WINE(F)     ((const float*)late((F).A)->in[7])
#define IN_BF(F)       ((const float*)late((F).A)->in[8])
#define IN_WOE(F)      ((const float*)late((F).A)->in[9])
#define IN_WINO(F)     ((const float*)late((F).A)->in[10])
#define IN_GQ(F)       ((const float*)late((F).A)->in[11])
#define IN_GKV(F)      ((const float*)late((F).A)->in[12])
#define IN_WQB(F)      ((const float*)late((F).A)->in[13])
#define IN_WKVB(F)     ((const float*)late((F).A)->in[14])
#define IN_WOO(F)      ((const float*)late((F).A)->in[15])
#define IN_GFIN(F)     ((const float*)late((F).A)->in[16])
__device__ __forceinline__ float wave_sum(float v) {
#pragma unroll
    for (int o = 1; o < 64; o <<= 1) v += __shfl_xor(v, o);
    return v;
}
__device__ __forceinline__ float bf2f(unsigned short h) { return __uint_as_float(((unsigned)h) << 16); }
__device__ __forceinline__ float silu_f(float z) { return z / (1.f + __expf(-z)); }

__device__ __forceinline__ void transpose_item(const float* W, int ldw, int K, int kb, int n0, bf16* WT, int drow0, int rmul, LAS float* scr, int lane) {
    const int k0 = 64 * kb;
#pragma unroll 8
    for (int i = 0; i < 32; ++i) { const int kk = 2 * i + (lane >> 5); scr[kk * 33 + (lane & 31)] = W[(size_t)(k0 + kk) * ldw + n0 + (lane & 31)]; }
    LDS_WAIT(); asm volatile("" ::: "memory");
    const int cch = lane & 7;
#pragma unroll
    for (int j = 0; j < 4; ++j) { const int n = (lane >> 3) + 8 * j; const LAS float* s = scr + (8 * cch) * 33 + n;
        v4u o; o.x = pk2(s[0 * 33], s[1 * 33]); o.y = pk2(s[2 * 33], s[3 * 33]); o.z = pk2(s[4 * 33], s[5 * 33]); o.w = pk2(s[6 * 33], s[7 * 33]);
        *(GAS v4u*)(WT + (size_t)(drow0 + rmul * n) * K + k0 + 8 * cch) = o; }
    LDS_WAIT(); asm volatile("" ::: "memory");
}
__device__ __forceinline__ void map_in_odd(int nb, int& drow0, int& rmul) { rmul = 1;
    if (nb < 32) drow0 = C1_CQ + 32 * nb; else if (nb < 48) drow0 = C1_CKV + 32 * (nb - 32); else if (nb < 50) { drow0 = C1_KR + (nb - 48); rmul = 2; } else drow0 = C1_Z + 32 * (nb - 50); }
__device__ __forceinline__ void map_qb(int nb, int& drow0, int& rmul) { const int h = nb / 6, part = nb % 6; rmul = 1;
    if (part < 4) drow0 = h * 128 + part * 32; else { drow0 = 4096 + h * 64 + (part - 4); rmul = 2; } }
__device__ __forceinline__ void map_kvb(int nb, int& drow0, int& rmul) { const int h = nb / 8, part = nb % 8; rmul = 1;
    drow0 = part < 4 ? h * 128 + part * 32 : 4096 + h * 128 + (part - 4) * 32; }

__device__ __forceinline__ void p0_prologue(Ctx& F) {
    const int gw = F.vcu * NWAVES + F.wave, NGW = F.G * NWAVES, gt = gw * 64 + F.lane, NGT = NGW * 64;
    float* cs = (float*)(F.ws + WS_CS);
    for (int i = gt; i < M * 32; i += NGT) { const int row = i >> 5, j = i & 31;
        const float inv = powf(10000.0f, -(float)j / 32.0f); const float ang = (float)IN_POS(F)[row] * inv; float sn, cn; sincosf(ang, &sn, &cn);
        cs[(size_t)row * 64 + j] = cn; cs[(size_t)row * 64 + 32 + j] = sn; }
    bf16* wft = (bf16*)(F.ws + WS_WFT);
    for (int i = gt; i < 16 * DM; i += NGT) { const int n = i >> 12, k = i & 4095; wft[i] = (bf16)f2bf(IN_WINE(F)[(size_t)k * IN_EVEN + N0 + n]); }
    { v4u* pad = (v4u*)((bf16*)(F.ws + WS_BT1) + (size_t)IN_ODD * DM); const int npad = (N1 - IN_ODD) * DM / 8;
      for (int i = gt; i < npad; i += NGT) pad[i] = (v4u){0u, 0u, 0u, 0u}; }
    LAS float* scr = (LAS float*)(F.lds + RING_OFF + F.wave * 16384);
    constexpr int KB4 = DM / 64;
    constexpr int I_IN0 = KB4 * (N0 / 32), I_WO = KB4 * (DM / 32), I_IN1 = KB4 * (IN_ODD / 32), I_QB = (Q_LORA / 64) * (NQ / 32), I_KVB = (KV_LORA / 64) * (NKV / 32);
    constexpr int NITEMS = I_IN0 + 2 * I_WO + I_IN1 + I_QB + I_KVB;
    for (int it = gw; it < NITEMS; it += NGW) {
        int r = it, drow0, rmul;
        if (r < I_IN0) { const int nblk = N0 / 32; transpose_item(IN_WINE(F), IN_EVEN, DM, r / nblk, 32 * (r % nblk), (bf16*)(F.ws + WS_BT0), 32 * (r % nblk), 1, scr, F.lane); continue; } r -= I_IN0;
        if (r < I_WO) { const int nblk = DM / 32; transpose_item(IN_WOE(F), DM, DM, r / nblk, 32 * (r % nblk), (bf16*)(F.ws + WS_WO0), 32 * (r % nblk), 1, scr, F.lane); continue; } r -= I_WO;
        if (r < I_WO) { const int nblk = DM / 32; transpose_item(IN_WOO(F), DM, DM, r / nblk, 32 * (r % nblk), (bf16*)(F.ws + WS_WO1), 32 * (r % nblk), 1, scr, F.lane); continue; } r -= I_WO;
        if (r < I_IN1) { const int nblk = IN_ODD / 32; map_in_odd(r % nblk, drow0, rmul); transpose_item(IN_WINO(F), IN_ODD, DM, r / nblk, 32 * (r % nblk), (bf16*)(F.ws + WS_BT1), drow0, rmul, scr, F.lane); continue; } r -= I_IN1;
        if (r < I_QB) { const int nblk = NQ / 32; map_qb(r % nblk, drow0, rmul); transpose_item(IN_WQB(F), NQ, Q_LORA, r / nblk, 32 * (r % nblk), (bf16*)(F.ws + WS_WQB), drow0, rmul, scr, F.lane); continue; } r -= I_QB;
        { const int nblk = NKV / 32; map_kvb(r % nblk, drow0, rmul); transpose_item(IN_WKVB(F), NKV, KV_LORA, r / nblk, 32 * (r % nblk), (bf16*)(F.ws + WS_WKVB), drow0, rmul, scr, F.lane); }
    }
    __syncthreads();
    LAS float* sc = (LAS float*)(F.lds + RING_OFF);
    LAS float* red = (LAS float*)(F.lds + RING_OFF + 32768);
    for (int i = F.tid; i < BATCH * DM; i += NWAVES * 64) sc[i] = silu_f(IN_C(F)[i]);
    __syncthreads();
    float* mod = (float*)(F.ws + WS_MOD);
    const int c4 = F.tid & 7, kl = F.tid >> 3;
    for (int it = F.vcu; it < 2 * (3 * DM / 32); it += F.G) {
        const int l = it / (3 * DM / 32), n0 = 32 * (it % (3 * DM / 32));
        const float* wp = IN_WADA(F) + ((size_t)l * DM) * (3 * DM) + n0 + 4 * c4;
        f32x4 a0 = (f32x4){0.f, 0.f, 0.f, 0.f}, a1 = a0;
#pragma unroll 8
        for (int i = 0; i < 64; ++i) { const int k = kl + 64 * i; const f32x4 w = *(const GAS f32x4*)(wp + (size_t)k * (3 * DM)); a0 += w * sc[k]; a1 += w * sc[DM + k]; }
        LAS float* rp = red + (kl * 8 + c4) * 8;
        rp[0] = a0[0]; rp[1] = a0[1]; rp[2] = a0[2]; rp[3] = a0[3]; rp[4] = a1[0]; rp[5] = a1[1]; rp[6] = a1[2]; rp[7] = a1[3];
        __syncthreads();
        if (F.tid < 64) { const int b = F.tid >> 5, n = F.tid & 31; float s = 0.f;
            for (int q = 0; q < 64; ++q) s += red[(q * 8 + (n >> 2)) * 8 + b * 4 + (n & 3)];
            mod[((size_t)l * BATCH + b) * (3 * DM) + n0 + n] = s + IN_BADA(F)[(size_t)l * (3 * DM) + n0 + n]; }
        __syncthreads();
    }
}

__device__ __forceinline__ void adaln_rows(Ctx& F, const float* X, const float* g, const float* mod  , bf16* XN) {
    const int gw = F.vcu * NWAVES + F.wave, NGW = F.G * NWAVES;
    for (int m = gw; m < M; m += NGW) {
        const int b = m / SEQ;
        const GAS f32x4* xr = (const GAS f32x4*)(X + (size_t)m * DM) + F.lane;
        f32x4 v[16]; float s = 0.f;
#pragma unroll
        for (int j = 0; j < 16; ++j) { v[j] = xr[64 * j]; s += (v[j].x * v[j].x + v[j].y * v[j].y) + (v[j].z * v[j].z + v[j].w * v[j].w); }
        const float rstd = 1.0f / sqrtf(wave_sum(s) * (1.f / DM) + EPS);
        const f32x4* g4 = (const f32x4*)g + F.lane; const f32x4* sh4 = (const f32x4*)(mod + (size_t)b * 3 * DM) + F.lane; const f32x4* sc4 = (const f32x4*)(mod + (size_t)b * 3 * DM + DM) + F.lane;
        GAS unsigned long long* o8 = (GAS unsigned long long*)(XN + (size_t)m * DM) + F.lane;
#pragma unroll
        for (int j = 0; j < 16; ++j) { const f32x4 y = (v[j] * rstd) * g4[64 * j] * (sc4[64 * j] + 1.0f) + sh4[64 * j];
            o8[64 * j] = (unsigned long long)pk2(y.x, y.y) | ((unsigned long long)pk2(y.z, y.w) << 32); }
    }
}
__device__ __forceinline__ void adaln_add_rows(Ctx& F, const float* X, const bf16* Y, const float* g, const float* mod  , bf16* XN) {
    const int gw = F.vcu * NWAVES + F.wave, NGW = F.G * NWAVES;
    for (int m = gw; m < M; m += NGW) {
        const int b = m / SEQ;
        const GAS f32x4* xr = (const GAS f32x4*)(X + (size_t)m * DM) + F.lane; const GAS unsigned long long* yr = (const GAS unsigned long long*)(Y + (size_t)m * DM) + F.lane;
        f32x4 v[16]; float s = 0.f;
#pragma unroll
        for (int j = 0; j < 16; ++j) { const unsigned long long y8 = yr[64 * j]; const unsigned ylo = (unsigned)y8, yhi = (unsigned)(y8 >> 32);
            v[j] = xr[64 * j] + (f32x4){__uint_as_float(ylo << 16), __uint_as_float(ylo & 0xffff0000u), __uint_as_float(yhi << 16), __uint_as_float(yhi & 0xffff0000u)};
            s += (v[j].x * v[j].x + v[j].y * v[j].y) + (v[j].z * v[j].z + v[j].w * v[j].w); }
        const float rstd = 1.0f / sqrtf(wave_sum(s) * (1.f / DM) + EPS);
        const f32x4* g4 = (const f32x4*)g + F.lane; const f32x4* sh4 = (const f32x4*)(mod + (size_t)b * 3 * DM) + F.lane; const f32x4* sc4 = (const f32x4*)(mod + (size_t)b * 3 * DM + DM) + F.lane;
        GAS unsigned long long* o8 = (GAS unsigned long long*)(XN + (size_t)m * DM) + F.lane;
#pragma unroll
        for (int j = 0; j < 16; ++j) { const f32x4 y = (v[j] * rstd) * g4[64 * j] * (sc4[64 * j] + 1.0f) + sh4[64 * j];
            o8[64 * j] = (unsigned long long)pk2(y.x, y.y) | ((unsigned long long)pk2(y.z, y.w) << 32); }
    }
}
__device__ __forceinline__ void final_rows(Ctx& F) {
    const int gw = F.vcu * NWAVES + F.wave, NGW = F.G * NWAVES;
    int ln = threadIdx.x; asm volatile("" : "+v"(ln)); ln &= 63;
    for (int m = gw; m < M; m += NGW) {
        GAS f32x4* xr = (GAS f32x4*)(F.out + (size_t)m * DM) + ln; const GAS f32x4* xin = (const GAS f32x4*)(IN_X(F) + (size_t)m * DM) + ln;
        const GAS unsigned long long* yr = (const GAS unsigned long long*)((const bf16*)(F.ws + WS_Y2) + (size_t)m * DM) + ln; const GAS unsigned long long* y1r = (const GAS unsigned long long*)((const bf16*)(F.ws + WS_Y1) + (size_t)m * DM) + ln;
        f32x4 v[16]; float s = 0.f;
#pragma unroll
        for (int j = 0; j < 16; ++j) { const unsigned long long y8 = yr[64 * j], z8 = y1r[64 * j]; const unsigned ylo = (unsigned)y8, yhi = (unsigned)(y8 >> 32), zlo = (unsigned)z8, zhi = (unsigned)(z8 >> 32);
            v[j] = (xin[64 * j] + (f32x4){__uint_as_float(zlo << 16), __uint_as_float(zlo & 0xffff0000u), __uint_as_float(zhi << 16), __uint_as_float(zhi & 0xffff0000u)})
                 + (f32x4){__uint_as_float(ylo << 16), __uint_as_float(ylo & 0xffff0000u), __uint_as_float(yhi << 16), __uint_as_float(yhi & 0xffff0000u)};
            s += (v[j].x * v[j].x + v[j].y * v[j].y) + (v[j].z * v[j].z + v[j].w * v[j].w); }
        const float rstd = 1.0f / sqrtf(wave_sum(s) * (1.f / DM) + EPS);
        const f32x4* g4 = (const f32x4*)IN_GFIN(F) + ln;
#pragma unroll
        for (int j = 0; j < 16; ++j) xr[64 * j] = (v[j] * rstd) * g4[64 * j];
    }
}
__device__ __forceinline__ void flogit_rows(Ctx& F) {
    typedef float f4 __attribute__((ext_vector_type(4)));
    const bf16* XN = (const bf16*)(F.ws + WS_XN); const bf16* WFT = (const bf16*)(F.ws + WS_WFT); float* FL = (float*)(F.ws + WS_FLOGIT);
    LAS f4* red = (LAS f4*)(F.lds + RING_OFF);
    const int r = F.lane & 15, kg = F.lane >> 4, kh = F.wave >> 2;
    for (int c0 = F.vcu; c0 < M / 64; c0 += F.G) {
        const int row0 = c0 * 64 + 16 * (F.wave & 3);
        const bf16* ap = XN + (size_t)(row0 + r) * DM + kh * 2048 + 8 * kg; const bf16* bp = WFT + (size_t)r * DM + kh * 2048 + 8 * kg;
        f4 acc = (f4){0.f, 0.f, 0.f, 0.f};
#pragma unroll 8
        for (int s = 0; s < 64; ++s) { const bf16x8 a = *(const GAS bf16x8*)(ap + 32 * s), b = *(const GAS bf16x8*)(bp + 32 * s);
            acc = __builtin_amdgcn_mfma_f32_16x16x32_bf16(a, b, acc, 0, 0, 0); }
        if (kh == 1) red[(F.wave & 3) * 64 + F.lane] = acc;
        __syncthreads();
        if (kh == 0) { const f4 o = acc + red[(F.wave & 3) * 64 + F.lane];
#pragma unroll
            for (int v = 0; v < 4; ++v) FL[(size_t)(row0 + 4 * kg + v) * 16 + r] = o[v]; }
        __syncthreads();
    }
}
__device__ __forceinline__ void combine_rows(Ctx& F) {
    const int gw = F.vcu * NWAVES + F.wave, NGW = F.G * NWAVES;
    const bf16* OP = (const bf16*)(F.ws + WS_OP); const float* LSE = (const float*)(F.ws + WS_LSE); const bf16* PR = (const bf16*)(F.ws + WS_PROJ0); bf16* G = (bf16*)(F.ws + WS_G);
    for (int m = gw; m < M; m += NGW) {
#pragma unroll
        for (int cc = 0; cc < 4; ++cc) { const int col = (cc * 64 + F.lane) * 8, h = col >> 7;
            const float l0 = LSE[(size_t)m * 16 + h], l1 = LSE[((size_t)M + m) * 16 + h], l2 = LSE[((size_t)2 * M + m) * 16 + h];
            const float mx = fmaxf(l0, fmaxf(l1, l2)); const float e0 = __expf(l0 - mx), e1 = __expf(l1 - mx), e2 = __expf(l2 - mx); const float inv = 1.f / (e0 + e1 + e2);
            const float w0 = e0 * inv, w1 = e1 * inv, w2 = e2 * inv;
            const v4u a = *(const GAS v4u*)(OP + (size_t)m * 2048 + col), b = *(const GAS v4u*)(OP + ((size_t)M + m) * 2048 + col), c = *(const GAS v4u*)(OP + ((size_t)2 * M + m) * 2048 + col);
            const v4u z = *(const GAS v4u*)(PR + (size_t)m * N0 + C_Z0 + col);
            v4u o;
#pragma unroll
            for (int q = 0; q < 4; ++q) { const unsigned ua = a[q], ub = b[q], uc = c[q], uz = z[q];
                const float lo = w0 * __uint_as_float(ua << 16) + w1 * __uint_as_float(ub << 16) + w2 * __uint_as_float(uc << 16);
                const float hi = w0 * __uint_as_float(ua & 0xffff0000u) + w1 * __uint_as_float(ub & 0xffff0000u) + w2 * __uint_as_float(uc & 0xffff0000u);
                o[q] = pk2(lo * silu_f(__uint_as_float(uz << 16)), hi * silu_f(__uint_as_float(uz & 0xffff0000u))); }
            *(GAS v4u*)(G + (size_t)m * DM + col) = o; }
    }
}
__device__ __forceinline__ void mla_norm_rows(Ctx& F) {
    const int gw = F.vcu * NWAVES + F.wave, NGW = F.G * NWAVES;
    const bf16* PR = (const bf16*)(F.ws + WS_PROJ1); bf16* CQN = (bf16*)(F.ws + WS_CQN); bf16* CKVN = (bf16*)(F.ws + WS_CKVN); bf16* KR = (bf16*)(F.ws + WS_KROPE); const float* cs = (const float*)(F.ws + WS_CS);
    const float* gq = IN_GQ(F); const float* gkv = IN_GKV(F);
    for (int m = gw; m < M; m += NGW) {
        const bf16* pr = PR + (size_t)m * N1;
        const v4u q0 = *(const GAS v4u*)(pr + C1_CQ + 8 * F.lane), q1 = *(const GAS v4u*)(pr + C1_CQ + 512 + 8 * F.lane), kv = *(const GAS v4u*)(pr + C1_CKV + 8 * F.lane);
        float fq[16], fk[8]; float sq = 0.f, sk = 0.f;
#pragma unroll
        for (int i = 0; i < 4; ++i) { fq[2 * i] = __uint_as_float(q0[i] << 16); fq[2 * i + 1] = __uint_as_float(q0[i] & 0xffff0000u); fq[8 + 2 * i] = __uint_as_float(q1[i] << 16); fq[8 + 2 * i + 1] = __uint_as_float(q1[i] & 0xffff0000u);
            fk[2 * i] = __uint_as_float(kv[i] << 16); fk[2 * i + 1] = __uint_as_float(kv[i] & 0xffff0000u); }
#pragma unroll
        for (int i = 0; i < 16; ++i) sq += fq[i] * fq[i];
#pragma unroll
        for (int i = 0; i < 8; ++i) sk += fk[i] * fk[i];
        const float rq = 1.0f / sqrtf(wave_sum(sq) * (1.f / Q_LORA) + EPS), rk = 1.0f / sqrtf(wave_sum(sk) * (1.f / KV_LORA) + EPS);
        const f32x4 g0a = *(const f32x4*)(gq + 8 * F.lane), g0b = *(const f32x4*)(gq + 8 * F.lane + 4), g1a = *(const f32x4*)(gq + 512 + 8 * F.lane), g1b = *(const f32x4*)(gq + 512 + 8 * F.lane + 4);
        const f32x4 gka = *(const f32x4*)(gkv + 8 * F.lane), gkb = *(const f32x4*)(gkv + 8 * F.lane + 4);
        v4u o0, o1, ok;
        o0.x = pk2(fq[0] * rq * g0a[0], fq[1] * rq * g0a[1]); o0.y = pk2(fq[2] * rq * g0a[2], fq[3] * rq * g0a[3]); o0.z = pk2(fq[4] * rq * g0b[0], fq[5] * rq * g0b[1]); o0.w = pk2(fq[6] * rq * g0b[2], fq[7] * rq * g0b[3]);
        o1.x = pk2(fq[8] * rq * g1a[0], fq[9] * rq * g1a[1]); o1.y = pk2(fq[10] * rq * g1a[2], fq[11] * rq * g1a[3]); o1.z = pk2(fq[12] * rq * g1b[0], fq[13] * rq * g1b[1]); o1.w = pk2(fq[14] * rq * g1b[2], fq[15] * rq * g1b[3]);
        ok.x = pk2(fk[0] * rk * gka[0], fk[1] * rk * gka[1]); ok.y = pk2(fk[2] * rk * gka[2], fk[3] * rk * gka[3]); ok.z = pk2(fk[4] * rk * gkb[0], fk[5] * rk * gkb[1]); ok.w = pk2(fk[6] * rk * gkb[2], fk[7] * rk * gkb[3]);
        *(GAS v4u*)(CQN + (size_t)m * Q_LORA + 8 * F.lane) = o0; *(GAS v4u*)(CQN + (size_t)m * Q_LORA + 512 + 8 * F.lane) = o1; *(GAS v4u*)(CKVN + (size_t)m * KV_LORA + 8 * F.lane) = ok;
        if (F.lane < 32) { const unsigned u = *(const GAS unsigned*)(pr + C1_KR + 2 * F.lane); const float x1 = __uint_as_float(u << 16), x2 = __uint_as_float(u & 0xffff0000u);
            const float cn = cs[(size_t)m * 64 + F.lane], sn = cs[(size_t)m * 64 + 32 + F.lane];
            *(GAS unsigned*)(KR + (size_t)m * 64 + 2 * F.lane) = pk2(x1 * cn - x2 * sn, x1 * sn + x2 * cn); }
    }
}

__device__ __forceinline__ int t5_bucket(int n) {
    if (n < 16) return n;
    const float nf = (float)(n > 1 ? n : 1);
    int large = 16 + (int)(logf(nf / 16.0f) / 4.852030263919617f * 16.0f);
    return large < 31 ? large : 31;
}
__device__ __forceinline__ void dil_ref(unsigned char* ws, int id, at::Ref& R) {
    const int j = id & 31, h = (id >> 5) & 15, b = (id >> 9) & 1, p = id >> 10; const int d = p == 0 ? 1 : (p == 1 ? 4 : 16);
    const int nblk = 32 / d, res = j / nblk, n = j % nblk;
    const at::bf16_t* pr = (const at::bf16_t*)(ws + WS_PROJ0) + ((size_t)b * SEQ + res) * N0 + h * HD;
    const long st = (long)d * N0;
    R.K = pr + C_KA; R.V = pr + C_VA; R.Q = pr + C_QA + (size_t)(256 * n) * st; R.Qr = nullptr; R.Kr = nullptr; R.qs = (int)st; R.ks = (int)st; R.P0 = 256 * n; R.dir = 0; R.jlo = 0;
    const size_t orow = (size_t)b * SEQ + res + (size_t)d * 256 * n;
    R.O = (at::bf16_t*)(ws + WS_OP) + ((size_t)p * M + orow) * 2048 + h * HD; R.os = d * 2048; R.Z = nullptr; R.zs = 0;
    R.LSE = (float*)(ws + WS_LSE) + ((size_t)p * M + orow) * 16 + h; R.ls = d * 16;
}
struct MkDil { unsigned char* ws; __device__ __forceinline__ void operator()(const at::Blk& k, at::Ref& R) const { dil_ref(ws, k.a, R); } };
__device__ __forceinline__ void dilated_phase(Ctx& F) {
    char* lds = (char*)F.lds + RING_OFF;
    const int total = 3 * BATCH * NHA * 32, chunk = (total + F.G - 1) / F.G; int id = F.vcu * chunk; const int end = (id + chunk < total) ? id + chunk : total;
    if (id >= end) return;
    const MkDil mk{F.ws}; int key = -1;
    at::Seam<at::K_DIL> S;
    at::attn_prime<at::K_DIL>(at::Blk{id, 0, 0}, mk, at::DIL_W, lds, S);
    for (;;) {
        const int kcur = ((id >> 10) << 4) | ((id >> 5) & 15);
        if (kcur != key) {
            key = kcur; const int p = key >> 4, h = key & 15, d = p == 0 ? 1 : (p == 1 ? 4 : 16);
            float* tbl = (float*)(lds + at::OFF_BIAS); const float* relb = IN_RELB(F);
            for (int u = F.tid; u < at::TBL_N; u += NWAVES * 64) { const int dist = at::TBL_TOP - u;
                tbl[u] = (dist >= 0 && dist <= 128) ? relb[t5_bucket(dist * d) * NHA + h] * 11.313708498984761f : -__builtin_inff(); }
            __syncthreads();
        }
        const bool last = id + 1 >= end;
        const int dcur = (id >> 10) == 0 ? 1 : ((id >> 10) == 1 ? 4 : 16);
        at::attn_block<at::K_DIL, 0>(at::Blk{id, 0, 0}, at::Blk{last ? id : id + 1, 0, 0}, mk, SEQ / dcur, at::DIL_W, lds, S);
        if (last) break;
        ++id;
    }
}
__device__ __forceinline__ bool causal_sched(const Ctx& F, int s, int npairs_total, int& bh, int& qb, int& dir) {
    if (F.G == 256) { const int x = F.vcu >> 5, i = F.vcu & 31, per = npairs_total / 8, r = s >> 1; if (r >= per) return false;
        bh = 2 * (x * per + r) + (s & 1); qb = (s & 1) ? 31 - i : i; dir = s & 1; return true; }
    const int item = F.vcu + (s >> 1) * F.G; if (item >= npairs_total * 32) return false;
    bh = item >> 4; qb = (s & 1) ? 31 - (item & 15) : (item & 15); dir = 0; return true;
}
__device__ __forceinline__ void fox_ref(unsigned char* ws, int bh, int qb, int jlo, at::Ref& R) {
    const int b = bh >> 4, h = bh & 15;
    const at::bf16_t* pr = (const at::bf16_t*)(ws + WS_PROJ0) + (size_t)b * SEQ * N0 + h * HD;
    R.K = pr + C_KB; R.V = pr + C_VB; R.Q = pr + C_QB + (size_t)(256 * qb) * N0; R.Qr = nullptr; R.Kr = nullptr; R.qs = N0; R.ks = N0; R.P0 = 256 * qb; R.dir = 1  ; R.jlo = jlo;
    const size_t orow = (size_t)b * SEQ + 256 * qb;
    R.O = (at::bf16_t*)(ws + WS_G) + orow * DM + 2048 + h * HD; R.os = DM; R.Z = pr + C_Z0 + 2048 + (size_t)(256 * qb) * N0; R.zs = N0; R.LSE = nullptr; R.ls = 0;
}
struct MkFox { unsigned char* ws; __device__ __forceinline__ void operator()(const at::Blk& k, at::Ref& R) const { fox_ref(ws, k.a, k.b, k.c, R); } };
__device__ __forceinline__ void fox_bias(Ctx& F, int bh, char* lds) {
    int tl = F.tid; asm volatile("" : "+v"(tl));
    const int ll = tl & 63;
    const int b = bh >> 4, h = bh & 15; const float* fl = (const float*)(F.ws + WS_FLOGIT) + ((size_t)b * SEQ + 16 * tl) * 16 + h; const float bf = IN_BF(F)[h];
    float ls[16]; double run = 0.0;
#pragma unroll
    for (int i = 0; i < 16; ++i) { const float xv = fl[i * 16] + bf; ls[i] = (xv >= 0.f) ? -log1pf(expf(-xv)) : xv - log1pf(expf(xv)); run += (double)ls[i]; }
    double inc = run;
#pragma unroll
    for (int o = 1; o < 64; o <<= 1) { const double t = __shfl_up(inc, o); if (ll >= o) inc += t; }
    LAS double* wt = (LAS double*)(lds + at::OFF_WS);
    if (ll == 63) wt[F.wave] = inc;
    __syncthreads();
    double pre = inc - run;
    for (int w = 0; w < F.wave; ++w) pre += wt[w];
    float* bias = (float*)(lds + at::OFF_BIAS) + 16 * tl;
#pragma unroll
    for (int i = 0; i < 16; ++i) { pre += (double)ls[i]; bias[i] = (float)(-pre * 11.313708498984761); }
    __syncthreads();
}
__device__ __forceinline__ int fox_jlo(Ctx& F, int bh, int qb, char* lds) {
    int tl = F.tid; asm volatile("" : "+v"(tl));
    const unsigned* nk = (const unsigned*)(F.ws + WS_NRMK) + (size_t)bh * 512;
    const float* bias = (const float*)(lds + at::OFF_BIAS);
    LAS float* sc = (LAS float*)(lds + at::OFF_WS);
    float sd = 3.0e38f, qn = 0.f;
    if (tl < 256) { const int b = bh >> 4, h = bh & 15;
        const at::bf16_t* rowp = (const at::bf16_t*)(F.ws + WS_PROJ0) + ((size_t)b * SEQ + 256 * qb + tl) * N0 + h * HD;
        float a = 0.f;
#pragma unroll
        for (int c = 0; c < 16; ++c) { const v4u q8 = *(const GAS v4u*)(rowp + C_QB + 8 * c), k8 = *(const GAS v4u*)(rowp + C_KB + 8 * c);
#pragma unroll
            for (int e = 0; e < 4; ++e) { const float ql = __uint_as_float(q8[e] << 16), qh = __uint_as_float(q8[e] & 0xffff0000u);
                a += ql * __uint_as_float(k8[e] << 16); a += qh * __uint_as_float(k8[e] & 0xffff0000u); qn += ql * ql; qn += qh * qh; } }
        sd = a;
#pragma unroll
        for (int o = 1; o < 64; o <<= 1) { sd = fminf(sd, __shfl_xor(sd, o)); qn = fmaxf(qn, __shfl_xor(qn, o)); }
        if ((tl & 63) == 0) { sc[4 + (tl >> 6)] = sd; sc[8 + (tl >> 6)] = qn; } }
    __syncthreads();
    int first = 999; float e = 0.f; bool cand = false;
    if (tl < 128) { const float smin = fminf(fminf(sc[4], sc[5]), fminf(sc[6], sc[7]));
        const uint4 wk = *(const uint4*)(nk + 4 * tl); const float k2 = __uint_as_float(wk.x) + __uint_as_float(wk.y) + __uint_as_float(wk.z) + __uint_as_float(wk.w);
        const float q2 = fmaxf(fmaxf(sc[8], sc[9]), fmaxf(sc[10], sc[11]));
        const float qk = (1.02f * sqrtf(q2) * sqrtf(k2) - smin) * 0.08838834764831845f + 0.01f;
        const float Ft0 = -bias[256 * qb] * 0.08838834764831845f, Fe = -bias[64 * tl + 63] * 0.08838834764831845f;
        cand = tl < 4 * qb;
        e = cand ? 64.0f * __expf(fminf(qk + (Ft0 - Fe), 0.f)) : 1.0f;
#pragma unroll
        for (int o = 1; o < 64; o <<= 1) { const float v = __shfl_up(e, o); if ((tl & 63) >= o) e += v; }
        if ((tl & 63) == 63) sc[12 + (tl >> 6)] = e; }
    __syncthreads();
    if (tl < 128) { const float pre = e + ((tl >> 6) ? sc[12] : 0.f);
        const bool prune = cand && pre < 5.0e-8f;
        const unsigned long long keep = __ballot(!prune);
        first = (tl & 64) + (keep ? __ffsll((long long)keep) - 1 : 64);
        if ((tl & 63) == 0) sc[2 + (tl >> 6)] = __int_as_float(first); }
    __syncthreads();
    const int f0 = __float_as_int(sc[2]), f1 = __float_as_int(sc[3]);
    const int jlo = f0 < 64 ? f0 : f1;
    __syncthreads();
    return __builtin_amdgcn_readfirstlane(jlo);
}
__device__ __forceinline__ void fox_phase(Ctx& F) {
    char* lds = (char*)F.lds + RING_OFF;
    int bias_bh = -1;
    const MkFox mk{F.ws};
    at::Seam<at::K_FOX> S;
    gu32* qh = (gu32*)(F.ws + WS_CTL) + CW_QUEUE;
    LAS int* tick = (LAS int*)(lds + at::OFF_WS + 64);
    for (;;) {
        if (F.tid == 0) *tick = (int)__hip_atomic_fetch_add(qh, 1u, __ATOMIC_RELAXED, __HIP_MEMORY_SCOPE_AGENT);
        __syncthreads();
        const int t = __builtin_amdgcn_readfirstlane(*tick);
        __syncthreads();
        if (t >= BATCH * NHB * 32) break;
        const int qb = 31 - (t >> 5), bh = t & 31;
        if (bh != bias_bh) { fox_bias(F, bh, lds); bias_bh = bh; }
        const int jlo = fox_jlo(F, bh, qb, lds);
        const at::Blk cur{bh, qb, jlo};
        at::attn_prime<at::K_FOX>(cur, mk, 1 << 30, lds, S);
        at::attn_block<at::K_FOX, 0>(cur, cur, mk, SEQ, 1 << 30, lds, S);
    }
}
template <int VAR>
__device__ __forceinline__ void mla_ref(unsigned char* ws, int bh, int qb, int dir, at::Ref& R) {
    const int b = bh >> 5, h = bh & 31;
    const at::bf16_t* qp = (const at::bf16_t*)(ws + WS_QBUF) + ((size_t)b * SEQ + 256 * qb) * NQ; const at::bf16_t* kvp = (const at::bf16_t*)(ws + WS_KVBUF) + (size_t)b * SEQ * NKV;
    R.Q = qp + h * HD; R.Qr = qp + 4096 + h * 64; R.K = kvp + h * HD; R.V = kvp + 4096 + h * HD; R.Kr = (const at::bf16_t*)(ws + WS_KROPE) + (size_t)b * SEQ * 64; R.qs = NQ; R.ks = NKV; R.P0 = 256 * qb; R.dir = dir; R.jlo = 0;
    const size_t orow = (size_t)b * SEQ + 256 * qb;
    R.O = (at::bf16_t*)(ws + WS_G) + orow * DM + h * HD; R.os = DM; R.Z = (const at::bf16_t*)(ws + WS_PROJ1) + orow * N1 + C1_Z + h * HD; R.zs = N1; R.LSE = nullptr; R.ls = 0;
}
template <int VAR> struct MkMla { unsigned char* ws; __device__ __forceinline__ void operator()(const at::Blk& k, at::Ref& R) const { mla_ref<VAR>(ws, k.a, k.b, k.c, R); } };
template <int VAR>
__device__ __forceinline__ void mla_phase(Ctx& F) {
    char* lds = (char*)F.lds + RING_OFF;
    int s = 0; at::Blk cur, nxt;
    if (!causal_sched(F, 0, BATCH * NHC / 2, cur.a, cur.b, cur.c)) return;
    const MkMla<VAR> mk{F.ws};
    t32::Seam S;
    t32::attn_prime(cur, mk, lds, S);
    for (;;) {
        const bool last = !causal_sched(F, s + 1, BATCH * NHC / 2, nxt.a, nxt.b, nxt.c);
        if (last) nxt = cur;
        t32::attn_block(cur, nxt, mk, SEQ, lds, S);
        if (last) break;
        cur = nxt; ++s;
    }
}

__global__ void __launch_bounds__(NWAVES * 64, 2) fwd_kernel(Args args) {
    extern __shared__ __attribute__((aligned(16))) unsigned char lds[];
    Ctx F;
    F.lds = (LAS unsigned char*)lds;
    volatile LAS unsigned* MISC = (volatile LAS unsigned*)(F.lds + MISC_OFF);
    F.tid = threadIdx.x; F.lane = F.tid & 63; F.wave = __builtin_amdgcn_readfirstlane(F.tid >> 6);
    F.G = gridDim.x; { const int bx = blockIdx.x; F.vcu = (F.G % 8 == 0) ? (bx % 8) * (F.G / 8) + bx / 8 : bx; }
    F.A = (const __attribute__((address_space(4))) Args*)__builtin_amdgcn_kernarg_segment_ptr();
    F.out = args.out; F.ws = args.ws;
    unsigned char* ws = args.ws;
    gu32* ctl = (gu32*)(ws + WS_CTL);
    for (int u = F.tid; u < (LDS_BYTES - LDSCTL_OFF) / 4; u += NWAVES * 64) ((LAS unsigned*)(F.lds + LDSCTL_OFF))[u] = 0u;
    __syncthreads();
    XcdBarrier bar; bar.bar = (unsigned*)(ctl + CW_BAR); bar.x = 0; bar.st = nullptr;
    if (!MK_PER_PHASE) bar = xcd_barrier_post((unsigned*)(ctl + CW_BAR), MISC + 8);
    const int lo = args.ph_lo, hi = args.ph_hi;
#define IN(k) (lo <= (k) && (k) < hi)
#define SEAM(k) do { if (IN(k) && IN((k) + 1)) xcd_barrier(bar); } while (0)
    float* mod = (float*)(ws + WS_MOD);
    bf16* XN = (bf16*)(ws + WS_XN); bf16* G = (bf16*)(ws + WS_G);

#define PH0 { p0_prologue(F); }
#define PH1 { adaln_rows(F, IN_X(F), IN_GNORM(F), mod, XN); }
#define PH2 { flogit_rows(F); \
        pg8::Gemm g{XN, (const bf16*)(ws + WS_BT0), M, N0, DM}; pg8::StaticOrder S; S.init(M, N0, F.G, (int)blockIdx.x); \
        pg8::EpiBf16Nrm E{(bf16*)(ws + WS_PROJ0), N0, (unsigned*)(ws + WS_NRMQ), (unsigned*)(ws + WS_NRMK), 1 << 20  , C_KB / 256, SEQ}; \
        pg8::gemm_phase<pg8::EpiBf16Nrm, pg8::StaticOrder, true, true>(F.lds + RING_OFF, g, S, E); }
#define PH3 { dilated_phase(F); __syncthreads(); fox_phase(F); }
#define PH4 { combine_rows(F); }
#define PH5 { pg8::Gemm g{G, (const bf16*)(ws + WS_WO0), M, DM, DM}; pg8::StaticOrder S; S.init(M, DM, F.G, (int)blockIdx.x); \
        pg8::EpiGateBf16 E{(bf16*)(ws + WS_Y1), DM, mod + 2 * DM, 3 * DM, SEQ}; \
        pg8::gemm_phase<pg8::EpiGateBf16, pg8::StaticOrder, true, true>(F.lds + RING_OFF, g, S, E); }
#define PH6 { adaln_add_rows(F, IN_X(F), (const bf16*)(ws + WS_Y1), IN_GNORM(F) + DM, mod + BATCH * 3 * DM, XN); }
#define PH7 { pg8::Gemm g{XN, (const bf16*)(ws + WS_BT1), M, N1, DM}; pg8::StaticOrder S; S.init(M, N1, F.G, (int)blockIdx.x); \
        pg8::EpiBf16<0> E{(bf16*)(ws + WS_PROJ1), N1, nullptr, 0, 0, 1.f}; \
        pg8::gemm_phase<pg8::EpiBf16<0>, pg8::StaticOrder, true, true>(F.lds + RING_OFF, g, S, E); }
#define PH8 { mla_norm_rows(F); }
#define PH9 { { pg8::Gemm g{(const bf16*)(ws + WS_CQN), (const bf16*)(ws + WS_WQB), M, NQ, Q_LORA}; pg8::StaticOrder S; S.init(M, NQ, F.G, (int)blockIdx.x); \
          pg8::EpiQRope E{(bf16*)(ws + WS_QBUF), NQ, (const float*)(ws + WS_CS), 4096, t32::QMUL}; \
          pg8::gemm_phase<pg8::EpiQRope, pg8::StaticOrder, true, true>(F.lds + RING_OFF, g, S, E); } \
        __syncthreads(); \
        { pg8::Gemm g{(const bf16*)(ws + WS_CKVN), (const bf16*)(ws + WS_WKVB), M, NKV, KV_LORA}; pg8::StaticOrder S; S.init(M, NKV, F.G, (int)blockIdx.x); \
          pg8::EpiBf16<0> E{(bf16*)(ws + WS_KVBUF), NKV, nullptr, 0, 0, 1.f}; \
          pg8::gemm_phase<pg8::EpiBf16<0>, pg8::StaticOrder, true, true>(F.lds + RING_OFF, g, S, E); } }
#define PH10 { mla_phase<0>(F); }
#define PH11 { pg8::Gemm g{G, (const bf16*)(ws + WS_WO1), M, DM, DM}; pg8::StaticOrder S; S.init(M, DM, F.G, (int)blockIdx.x); \
        pg8::EpiGateBf16 E{(bf16*)(ws + WS_Y2), DM, mod + BATCH * 3 * DM + 2 * DM, 3 * DM, SEQ}; \
        pg8::gemm_phase<pg8::EpiGateBf16, pg8::StaticOrder, true, true>(F.lds + RING_OFF, g, S, E); }
#define PH12 { final_rows(F); }
#define RUN(k, BODY) do { if (IN(k)) { BODY } SEAM(k); } while (0)
    RUN(0, PH0); RUN(1, PH1); RUN(2, PH2); RUN(3, PH3); RUN(4, PH4); RUN(5, PH5); RUN(6, PH6); RUN(7, PH7); RUN(8, PH8); RUN(9, PH9); RUN(10, PH10);
    if (IN(11)) PH11 SEAM(11);
    if (IN(12)) PH12
#undef IN
#undef SEAM
}

extern "C" void kernel_launch(void* const* d_in, const int* in_sizes, int n_in, void* d_out, int out_size, void* d_ws, size_t ws_size, hipStream_t stream) {
    static int grid = 0;
    if (grid == 0) {
        if (n_in != 17 || in_sizes[0] != M * DM || out_size != M * DM || ws_size < WS_END) { fprintf(stderr, "kernel_launch: unexpected shapes (n_in %d, in0 %d, out %d, ws %zu, need %zu); nothing launched\n", n_in, n_in > 0 ? in_sizes[0] : -1, out_size, ws_size, (size_t)WS_END); grid = -1; return; }
        int dev = 0, cus = 0, per_cu = 0;
        if (hipGetDevice(&dev) != hipSuccess || hipDeviceGetAttribute(&cus, hipDeviceAttributeMultiprocessorCount, dev) != hipSuccess) { grid = -1; return; }
        if (hipFuncSetAttribute((const void*)fwd_kernel, hipFuncAttributeMaxDynamicSharedMemorySize, LDS_BYTES) != hipSuccess) { fprintf(stderr, "kernel_launch: hipFuncSetAttribute failed\n"); grid = -1; return; }
        if (hipOccupancyMaxActiveBlocksPerMultiprocessor(&per_cu, (const void*)fwd_kernel, NWAVES * 64, LDS_BYTES) != hipSuccess || per_cu < 1) { fprintf(stderr, "kernel_launch: occupancy query says %d\n", per_cu); }
        (void)hipGetLastError();
        grid = cus;
    }
    if (grid < 0) return;
    if (hipMemsetAsync((char*)d_ws + WS_CTL, 0, CTL_ZERO_BYTES, stream) != hipSuccess) return;
    Args a{};
    for (int i = 0; i < 17; ++i) a.in[i] = d_in[i];
    a.out = (float*)d_out; a.ws = (unsigned char*)d_ws;
#if MK_PER_PHASE
    for (int p = 0; p < N_PHASES; ++p) { a.ph_lo = p; a.ph_hi = p + 1; hipLaunchKernelGGL(fwd_kernel, dim3(grid), dim3(NWAVES * 64), LDS_BYTES, stream, a); }
#else
    a.ph_lo = 0; a.ph_hi = N_PHASES;
    hipLaunchKernelGGL(fwd_kernel, dim3(grid), dim3(NWAVES * 64), LDS_BYTES, stream, a);
#endif
    const hipError_t le = hipPeekAtLastError();
    if (le != hipSuccess) fprintf(stderr, "kernel_launch: launch failed: %s\n", hipGetErrorName(le));
}
```
